# Optimizing an MI355X kernel written in HIP

```python
import jax
import jax.numpy as jnp
from jax import lax
import numpy as np

D_MODEL = 2048
BATCH = 8
SEQ = 2048
DEPTH = 2

HEAD_DIM = 128
HEADS = 4
GROUP_W = HEADS * HEAD_DIM
D_MIX = 4 * GROUP_W
N_SOFTMAX_HEADS = 2 * HEADS

MLSTM_CHUNK = 64
MLSTM_CONV = 4
MOBA_BLOCK = 256
MOBA_TOPK = 3
MOBA_QC = 16
RET_CHUNK = 128
NSA_CMP_LEN = 32
NSA_CMP_STRIDE = 16
NSA_SEL_BLOCK = 64
NSA_SEL_TOPN = 4
NSA_WINDOW = 512
NSA_QC = 32
WIN_QBLOCK = 128
N_GROUPS = 4
EXPERTS_PER_GROUP = 8
N_EXPERTS = N_GROUPS * EXPERTS_PER_GROUP
TOP_K_IN_GROUP = 2
D_EXPERT = 512
MOE_BLOCK = 128

NORM_EPS = 1e-6
NEG = -1e30
BIG = 1e9

IN_LAYOUT = (
    ('m_q', GROUP_W), ('m_k', GROUP_W), ('m_v', GROUP_W), ('m_o', GROUP_W), ('m_i', HEADS), ('m_f', HEADS),
    ('b_q', GROUP_W), ('b_k', GROUP_W), ('b_v', GROUP_W),
    ('r_q', GROUP_W), ('r_k', GROUP_W), ('r_v', GROUP_W), ('r_g', GROUP_W),
    ('n_q', GROUP_W), ('n_kc', GROUP_W), ('n_vc', GROUP_W), ('n_ks', GROUP_W), ('n_vs', GROUP_W),
    ('n_kw', GROUP_W), ('n_vw', GROUP_W), ('n_g', 3 * HEADS),
)
D_IN = sum(w for _, w in IN_LAYOUT)

kernel_name = 'hybrid_mlstm_moba_retnet_nsa_hmoe'


def _rms(z, g):
    zf = z.astype(jnp.float32)
    zf = zf * lax.rsqrt(jnp.mean(zf * zf, axis=-1, keepdims=True) + NORM_EPS)
    return zf * g.astype(jnp.float32)


def to_heads(z):
    b, t, _ = z.shape
    return z.reshape(b, t, -1, HEAD_DIM).transpose(0, 2, 1, 3)


def from_heads(z):
    b, h, t, d = z.shape
    return z.transpose(0, 2, 1, 3).reshape(b, t, h * d)


def alibi_slopes():
    n = N_SOFTMAX_HEADS
    return jnp.exp2(-8.0 * jnp.arange(1, n + 1, dtype=jnp.float32) / n)


def causal_dwconv(x, w):
    k = w.shape[0]
    return lax.conv_general_dilated(
        x, w.astype(x.dtype)[:, None, :], window_strides=(1,), padding=((k - 1, 0),),
        dimension_numbers=('NWC', 'WIO', 'NWC'), feature_group_count=x.shape[-1])


def mlstm_mixer(q, k, v, o, ig, fg, conv_w, gate_b, out_g):
    f32 = jnp.float32
    qk = jax.nn.silu(causal_dwconv(jnp.concatenate([q, k], axis=-1), conv_w))
    q, k = jnp.split(qk, 2, axis=-1)
    q = to_heads(q).astype(f32) * HEAD_DIM ** -0.5
    k = to_heads(k).astype(f32)
    v = to_heads(v).astype(f32)
    i_pre = jnp.swapaxes((ig + gate_b[0]).astype(f32), 1, 2)
    log_f = jax.nn.log_sigmoid(jnp.swapaxes((fg + gate_b[1]).astype(f32), 1, 2))
    b, h, t, d = q.shape
    nc = t // MLSTM_CHUNK
    causal = jnp.tril(jnp.ones((MLSTM_CHUNK, MLSTM_CHUNK), dtype=bool))

    def chunked(z):
        return jnp.moveaxis(z.reshape(b, h, nc, MLSTM_CHUNK, *z.shape[3:]), 2, 0)

    def step(carry, inp):
        c_st, n_st, m_st = carry
        qc, kc, vc, ic, fc = inp
        a = jnp.cumsum(fc, axis=-1)
        log_d = jnp.where(causal, a[..., :, None] - a[..., None, :] + ic[..., None, :], NEG)
        m_inter = a + m_st[..., None]
        m_row = jnp.maximum(m_inter, jnp.max(log_d, axis=-1))
        s = jnp.einsum('bhjd,bhsd->bhjs', qc, kc) * jnp.exp(log_d - m_row[..., None])
        w_inter = jnp.exp(m_inter - m_row)
        num = (jnp.einsum('bhjs,bhse->bhje', s, vc)
               + w_inter[..., None] * jnp.einsum('bhjd,bhde->bhje', qc, c_st))
        den = jnp.sum(s, axis=-1) + w_inter * jnp.einsum('bhjd,bhd->bhj', qc, n_st)
        h_out = num / jnp.maximum(jnp.abs(den), jnp.exp(-m_row))[..., None]
        a_last = a[..., -1]
        w_log = a_last[..., None] - a + ic
        m_new = jnp.maximum(a_last + m_st, jnp.max(w_log, axis=-1))
        w = jnp.exp(w_log - m_new[..., None])
        decay = jnp.exp(a_last + m_st - m_new)
        c_st = decay[..., None, None] * c_st + jnp.einsum('bhs,bhsd,bhse->bhde', w, kc, vc)
        n_st = decay[..., None] * n_st + jnp.einsum('bhs,bhsd->bhd', w, kc)
        return (c_st, n_st, m_new), h_out

    carry0 = (jnp.zeros((b, h, d, d), f32), jnp.zeros((b, h, d), f32), jnp.zeros((b, h), f32))
    _, hs = lax.scan(step, carry0, (chunked(q), chunked(k), chunked(v), chunked(i_pre), chunked(log_f)))
    hs = jnp.moveaxis(hs, 0, 2).reshape(b, h, t, d)
    return from_heads(_rms(hs, out_g)) * jax.nn.sigmoid(o.astype(f32))


def moba_mixer(q, k, v, qk_g, slopes):
    f32 = jnp.float32
    q = _rms(to_heads(q), qk_g[0])
    k = _rms(to_heads(k), qk_g[1])
    v = to_heads(v).astype(f32)
    b, h, t, d = q.shape
    scale = d ** -0.5
    nb = -(-t // MOBA_BLOCK)
    tp = nb * MOBA_BLOCK
    padw = ((0, 0), (0, 0), (0, tp - t), (0, 0))
    q, k, v = jnp.pad(q, padw), jnp.pad(k, padw), jnp.pad(v, padw)
    kb = k.reshape(b, h, nb, MOBA_BLOCK, d)
    vb = v.reshape(b, h, nb, MOBA_BLOCK, d)
    qblk = jnp.arange(tp, dtype=jnp.int32) // MOBA_BLOCK
    blk = jnp.arange(nb, dtype=jnp.int32)
    gate = jnp.einsum('bhtd,bhnd->bhtn', q, jnp.mean(kb, axis=3))
    gate = jnp.where(blk[None, :] < qblk[:, None], gate, NEG)
    n_sel = min(MOBA_TOPK, nb)
    _, sel = lax.top_k(gate, n_sel)
    nq = tp // MOBA_QC
    q_ch = jnp.moveaxis(q.reshape(b, h, nq, MOBA_QC, d), 2, 0)
    sel_ch = jnp.moveaxis(sel.reshape(b, h, nq, MOBA_QC, n_sel), 2, 0)
    starts = jnp.arange(nq, dtype=jnp.int32) * MOBA_QC
    bi = jnp.arange(b)[:, None, None, None]
    hi = jnp.arange(h)[None, :, None, None]
    slope = slopes[None, :, None, None]
    offs = jnp.arange(MOBA_BLOCK, dtype=jnp.int32)

    def chunk_attn(args):
        qc, sc, start = args
        tq = start + jnp.arange(MOBA_QC, dtype=jnp.int32)
        own = start // MOBA_BLOCK
        k_own = lax.dynamic_index_in_dim(kb, own, axis=2, keepdims=False)
        v_own = lax.dynamic_index_in_dim(vb, own, axis=2, keepdims=False)
        dist_own = (tq[:, None] - (own * MOBA_BLOCK + offs)[None, :]).astype(f32)
        s_own = jnp.einsum('bhqd,bhkd->bhqk', qc, k_own) * scale - slope * dist_own
        s_own = jnp.where(dist_own >= 0, s_own, NEG)
        k_sel = kb[bi, hi, sc]
        v_sel = vb[bi, hi, sc]
        dist_sel = (tq[None, None, :, None, None] - (sc[..., None] * MOBA_BLOCK + offs)).astype(f32)
        s_sel = jnp.einsum('bhqd,bhqnkd->bhqnk', qc, k_sel) * scale - slope[..., None] * dist_sel
        s_sel = jnp.where((sc < own)[..., None], s_sel, NEG)
        s_all = jnp.concatenate([s_own, s_sel.reshape(b, h, MOBA_QC, n_sel * MOBA_BLOCK)], axis=-1)
        p = jax.nn.softmax(s_all, axis=-1)
        p_own = p[..., :MOBA_BLOCK]
        p_sel = p[..., MOBA_BLOCK:].reshape(b, h, MOBA_QC, n_sel, MOBA_BLOCK)
        return (jnp.einsum('bhqk,bhkd->bhqd', p_own, v_own)
                + jnp.einsum('bhqnk,bhqnkd->bhqd', p_sel, v_sel))

    out = lax.map(chunk_attn, (q_ch, sel_ch, starts))
    out = jnp.moveaxis(out, 0, 2).reshape(b, h, tp, d)[:, :, :t]
    return from_heads(out)


def retention_mixer(q, k, v, g, out_g):
    f32 = jnp.float32
    q = to_heads(q).astype(f32)
    k = to_heads(k).astype(f32) * HEAD_DIM ** -0.5
    v = to_heads(v).astype(f32)
    b, h, t, d = q.shape
    lg = jnp.log(1.0 - jnp.exp2(-5.0 - jnp.arange(h, dtype=f32)))
    cl = RET_CHUNK
    nc = t // cl
    qc = q.reshape(b, h, nc, cl, d)
    kc = k.reshape(b, h, nc, cl, d)
    vc = v.reshape(b, h, nc, cl, d)
    j = jnp.arange(cl, dtype=f32)
    diff = j[:, None] - j[None, :]
    decay_in = jnp.where(diff >= 0, jnp.exp(lg[:, None, None] * jnp.maximum(diff, 0.0)), 0.0)
    scores = jnp.einsum('bhcid,bhcjd->bhcij', qc, kc) * decay_in[None, :, None]
    o_intra = jnp.einsum('bhcij,bhcjd->bhcid', scores, vc)
    zeta = jnp.exp(lg[:, None] * (cl - 1 - j)[None, :])
    kv = jnp.einsum('bhcjd,hj,bhcje->bhcde', kc, zeta, vc)
    g_chunk = jnp.exp(lg * cl)[None, :, None, None]

    def step(r, kv_c):
        return g_chunk * r + kv_c, r

    _, r_prev = lax.scan(step, jnp.zeros((b, h, d, d), f32), jnp.moveaxis(kv, 2, 0))
    r_prev = jnp.moveaxis(r_prev, 0, 2)
    xi = jnp.exp(lg[:, None] * (j + 1.0)[None, :])
    o_cross = jnp.einsum('bhcid,bhcde->bhcie', qc, r_prev) * xi[None, :, None, :, None]
    o = (o_intra + o_cross).reshape(b, h, t, d)
    return from_heads(_rms(o, out_g)) * jax.nn.silu(g.astype(f32))


def nsa_mixer(q, kc, vc, ks, vs, kw, vw, gates, q_g, k_g, cmp_pos, cmp_w1, cmp_w2, slopes):
    f32 = jnp.float32
    q = _rms(to_heads(q), q_g)
    b, h, t, d = q.shape
    scale = d ** -0.5
    slope = slopes[None, :, None, None]
    pos = jnp.arange(t, dtype=jnp.int32)

    def compress(z, pe, w1, w2):
        nsub = t // NSA_CMP_STRIDE
        zs = z.reshape(b, h, nsub, NSA_CMP_STRIDE, d)
        blocks = jnp.concatenate([zs[:, :, :-1], zs[:, :, 1:]], axis=3) + pe
        hid = jax.nn.gelu(jnp.einsum('bhnf,fe->bhne', blocks.reshape(b, h, nsub - 1, NSA_CMP_LEN * d), w1))
        return jnp.einsum('bhne,ed->bhnd', hid, w2)

    k_cmp = _rms(compress(to_heads(kc).astype(f32), cmp_pos[0], cmp_w1[0], cmp_w2[0]), k_g[0])
    v_cmp = compress(to_heads(vc).astype(f32), cmp_pos[1], cmp_w1[1], cmp_w2[1])
    n_cmp = k_cmp.shape[2]
    cmp_end = jnp.arange(n_cmp, dtype=jnp.int32) * NSA_CMP_STRIDE + NSA_CMP_LEN - 1
    dist_c = (pos[:, None] - cmp_end[None, :]).astype(f32)
    ok_c = dist_c >= 0
    s_c = jnp.where(ok_c, jnp.einsum('bhtd,bhnd->bhtn', q, k_cmp) * scale - slope * dist_c, NEG)
    m_c = jnp.max(s_c, axis=-1, keepdims=True)
    e_c = jnp.where(ok_c, jnp.exp(s_c - m_c), 0.0)
    p_c = e_c / jnp.maximum(jnp.sum(e_c, axis=-1, keepdims=True), 1e-30)
    o_cmp = jnp.einsum('bhtn,bhnd->bhtd', p_c, v_cmp)

    n_sel = t // NSA_SEL_BLOCK
    ci = jnp.arange(n_cmp, dtype=jnp.int32)[:, None]
    sj = jnp.arange(n_sel, dtype=jnp.int32)[None, :]
    overlap = ((ci * NSA_CMP_STRIDE <= sj * NSA_SEL_BLOCK + NSA_SEL_BLOCK - 1)
               & (ci * NSA_CMP_STRIDE + NSA_CMP_LEN - 1 >= sj * NSA_SEL_BLOCK)).astype(f32)
    imp = jnp.einsum('bhtn,ns->bhts', p_c, overlap)
    cur = (pos // NSA_SEL_BLOCK)[:, None]
    imp = jnp.where(sj == cur, BIG, jnp.where(sj < cur, imp, NEG))
    n_top = min(NSA_SEL_TOPN, n_sel)
    _, sidx = lax.top_k(imp, n_top)
    ks_b = _rms(to_heads(ks), k_g[1]).reshape(b, h, n_sel, NSA_SEL_BLOCK, d)
    vs_b = to_heads(vs).astype(f32).reshape(b, h, n_sel, NSA_SEL_BLOCK, d)
    nq = t // NSA_QC
    q_ch = jnp.moveaxis(q.reshape(b, h, nq, NSA_QC, d), 2, 0)
    s_ch = jnp.moveaxis(sidx.reshape(b, h, nq, NSA_QC, n_top), 2, 0)
    starts = jnp.arange(nq, dtype=jnp.int32) * NSA_QC
    bi = jnp.arange(b)[:, None, None, None]
    hi = jnp.arange(h)[None, :, None, None]
    offs = jnp.arange(NSA_SEL_BLOCK, dtype=jnp.int32)

    def chunk_attn(args):
        qc, sc, start = args
        tq = start + jnp.arange(NSA_QC, dtype=jnp.int32)
        k_gth = ks_b[bi, hi, sc]
        v_gth = vs_b[bi, hi, sc]
        dist = (tq[None, None, :, None, None] - (sc[..., None] * NSA_SEL_BLOCK + offs)).astype(f32)
        s = jnp.einsum('bhqd,bhqnkd->bhqnk', qc, k_gth) * scale - slope[..., None] * dist
        s = jnp.where(dist >= 0, s, NEG).reshape(b, h, NSA_QC, n_top * NSA_SEL_BLOCK)
        p = jax.nn.softmax(s, axis=-1).reshape(b, h, NSA_QC, n_top, NSA_SEL_BLOCK)
        return jnp.einsum('bhqnk,bhqnkd->bhqd', p, v_gth)

    o_slc = lax.map(chunk_attn, (q_ch, s_ch, starts))
    o_slc = jnp.moveaxis(o_slc, 0, 2).reshape(b, h, t, d)

    qb = WIN_QBLOCK
    nqb = t // qb
    nprev = NSA_WINDOW // qb

    def band(z):
        zp = jnp.pad(z, ((0, 0), (0, 0), (nprev * qb, 0), (0, 0))).reshape(b, h, nqb + nprev, qb, d)
        return jnp.concatenate([zp[:, :, i:i + nqb] for i in range(nprev + 1)], axis=3)

    k_band = band(_rms(to_heads(kw), k_g[2]))
    v_band = band(to_heads(vw).astype(f32))
    blk_i = jnp.arange(nqb, dtype=jnp.int32)[:, None]
    qpos = blk_i * qb + jnp.arange(qb, dtype=jnp.int32)[None, :]
    kpos = blk_i * qb - nprev * qb + jnp.arange((nprev + 1) * qb, dtype=jnp.int32)[None, :]
    dist_w = qpos[:, :, None] - kpos[:, None, :]
    ok_w = (dist_w >= 0) & (dist_w < NSA_WINDOW) & (kpos[:, None, :] >= 0)
    s_w = (jnp.einsum('bhnqd,bhnkd->bhnqk', q.reshape(b, h, nqb, qb, d), k_band) * scale
           - slopes[None, :, None, None, None] * dist_w.astype(f32))
    p_w = jax.nn.softmax(jnp.where(ok_w, s_w, NEG), axis=-1)
    o_win = jnp.einsum('bhnqk,bhnkd->bhnqd', p_w, v_band).reshape(b, h, t, d)

    g = jax.nn.sigmoid(gates.astype(f32)).reshape(b, t, 3, h)
    g = jnp.transpose(g, (2, 0, 3, 1))[..., None]
    return from_heads(g[0] * o_cmp + g[1] * o_slc + g[2] * o_win)


def grouped_experts(xf, eid, gate, w1, w3, w2):
    n, dm = xf.shape
    na = eid.shape[0]
    tok = jnp.arange(na, dtype=jnp.int32) // TOP_K_IN_GROUP
    order = jnp.argsort(eid)
    se = eid[order]
    counts = jnp.bincount(eid, length=N_EXPERTS)
    pcounts = (counts + MOE_BLOCK - 1) // MOE_BLOCK * MOE_BLOCK
    starts = jnp.cumsum(counts) - counts
    pends = jnp.cumsum(pcounts)
    pstarts = pends - pcounts
    dest = pstarts[se] + (jnp.arange(na, dtype=jnp.int32) - starts[se])
    cap = (-(-na // MOE_BLOCK) + N_EXPERTS) * MOE_BLOCK
    nblk = cap // MOE_BLOCK
    buf_tok = jnp.full((cap,), n, dtype=jnp.int32).at[dest].set(tok[order])
    buf_gate = jnp.zeros((cap,), jnp.float32).at[dest].set(gate[order])
    blk_e = jnp.minimum(jnp.searchsorted(pends, jnp.arange(nblk, dtype=jnp.int32) * MOE_BLOCK, side='right'),
                        N_EXPERTS - 1)
    xpad = jnp.concatenate([xf, jnp.zeros((1, dm), xf.dtype)], axis=0)
    xb = xpad[buf_tok].reshape(nblk, MOE_BLOCK, dm)

    def expert_block(args):
        xblk, e = args
        return (jax.nn.silu(xblk @ w1[e]) * (xblk @ w3[e])) @ w2[e]

    yb = lax.map(expert_block, (xb, blk_e)).reshape(cap, dm)
    yb = yb * buf_gate[:, None].astype(yb.dtype)
    return jnp.zeros((n + 1, dm), yb.dtype).at[buf_tok].add(yb)[:n]


def hier_moe(h, wg, bg, we, be, w1, w3, w2):
    f32 = jnp.float32
    b, t, dm = h.shape
    n = b * t
    xf = h.reshape(n, dm)
    lg = (xf @ wg + bg).astype(f32)
    pg = jax.nn.softmax(lg, axis=-1)
    _, grp = lax.top_k(lg, 1)
    grp_1h = jax.nn.one_hot(grp[:, 0], N_GROUPS, dtype=f32)
    p_grp = jnp.sum(pg * grp_1h, axis=-1, keepdims=True)
    le = (xf @ we + be).astype(f32).reshape(n, N_GROUPS, EXPERTS_PER_GROUP)
    le_g = jnp.einsum('ng,nge->ne', grp_1h, le)
    top_p, top_i = lax.top_k(jax.nn.softmax(le_g, axis=-1), TOP_K_IN_GROUP)
    top_p = top_p / jnp.sum(top_p, axis=-1, keepdims=True)
    gate = p_grp * top_p
    eid = grp * EXPERTS_PER_GROUP + top_i
    y = grouped_experts(xf, eid.reshape(-1), gate.reshape(-1), w1, w3, w2)
    return y.reshape(b, t, dm)


def hybrid_layer(x, c, norm1_g, norm2_g, ada_w, ada_b, w_in, mlstm_gate_b, mlstm_conv_w, mlstm_out_g,
                 moba_qk_g, ret_out_g, nsa_q_g, nsa_k_g, nsa_cmp_pos, nsa_cmp_w1, nsa_cmp_w2, w_out,
                 router_g_w, router_g_b, router_e_w, router_e_b, exp_w1, exp_w3, exp_w2):
    dtype = x.dtype
    mod = jax.nn.silu(c) @ ada_w + ada_b
    sh1, sc1, g1, sh2, sc2, g2 = jnp.split(mod[:, None, :], 6, axis=-1)
    h = (_rms(x, norm1_g) * (1.0 + sc1) + sh1).astype(dtype)
    z = h @ w_in
    p = {}
    off = 0
    for name, width in IN_LAYOUT:
        p[name] = z[..., off:off + width]
        off += width
    slopes = alibi_slopes()
    y_m = mlstm_mixer(p['m_q'], p['m_k'], p['m_v'], p['m_o'], p['m_i'], p['m_f'],
                      mlstm_conv_w, mlstm_gate_b, mlstm_out_g)
    y_b = moba_mixer(p['b_q'], p['b_k'], p['b_v'], moba_qk_g, slopes[0::2])
    y_r = retention_mixer(p['r_q'], p['r_k'], p['r_v'], p['r_g'], ret_out_g)
    y_n = nsa_mixer(p['n_q'], p['n_kc'], p['n_vc'], p['n_ks'], p['n_vs'], p['n_kw'], p['n_vw'], p['n_g'],
                    nsa_q_g, nsa_k_g, nsa_cmp_pos, nsa_cmp_w1, nsa_cmp_w2, slopes[1::2])
    y = jnp.concatenate([y_m, y_b, y_r, y_n], axis=-1).astype(dtype) @ w_out
    x = x + g1 * y
    h2 = (_rms(x, norm2_g) * (1.0 + sc2) + sh2).astype(dtype)
    return x + g2 * hier_moe(h2, router_g_w, router_g_b, router_e_w, router_e_b, exp_w1, exp_w3, exp_w2)


def setup_inputs(seed: int = 0) -> dict:
    key = jax.random.key(seed)
    keys = iter(jax.random.split(key, 40))

    def nrm(shape, scale):
        return jax.random.normal(next(keys), shape, jnp.float32) * scale

    L, D, H, DH = DEPTH, D_MODEL, HEADS, HEAD_DIM
    f_bias = jnp.linspace(3.0, 6.0, H, dtype=jnp.float32)[None, :] + nrm((L, H), 0.1)
    return {
        'x': nrm((BATCH, SEQ, D), 1.0),
        'c': nrm((BATCH, D), 1.0),
        'norm1_g': 1.0 + nrm((L, D), 0.02),
        'norm2_g': 1.0 + nrm((L, D), 0.02),
        'ada_w': nrm((L, D, 6 * D), 0.5 * D ** -0.5),
        'ada_b': nrm((L, 6 * D), 0.01),
        'w_in': nrm((L, D, D_IN), D ** -0.5),
        'mlstm_gate_b': jnp.stack([nrm((L, H), 0.1), f_bias], axis=1),
        'mlstm_conv_w': nrm((L, MLSTM_CONV, 2 * GROUP_W), MLSTM_CONV ** -0.5),
        'mlstm_out_g': 1.0 + nrm((L, DH), 0.02),
        'moba_qk_g': 1.0 + nrm((L, 2, DH), 0.02),
        'ret_out_g': 1.0 + nrm((L, DH), 0.02),
        'nsa_q_g': 1.0 + nrm((L, DH), 0.02),
        'nsa_k_g': 1.0 + nrm((L, 3, DH), 0.02),
        'nsa_cmp_pos': nrm((L, 2, NSA_CMP_LEN, DH), 0.02),
        'nsa_cmp_w1': nrm((L, 2, NSA_CMP_LEN * DH, DH), (NSA_CMP_LEN * DH) ** -0.5),
        'nsa_cmp_w2': nrm((L, 2, DH, DH), DH ** -0.5),
        'w_out': nrm((L, D_MIX, D), D_MIX ** -0.5),
        'router_g_w': nrm((L, D, N_GROUPS), D ** -0.5),
        'router_g_b': nrm((L, N_GROUPS), 0.01),
        'router_e_w': nrm((L, D, N_EXPERTS), D ** -0.5),
        'router_e_b': nrm((L, N_EXPERTS), 0.01),
        'exp_w1': nrm((L, N_EXPERTS, D, D_EXPERT), D ** -0.5),
        'exp_w3': nrm((L, N_EXPERTS, D, D_EXPERT), D ** -0.5),
        'exp_w2': nrm((L, N_EXPERTS, D_EXPERT, D), D_EXPERT ** -0.5),
    }


def reference(x, c, norm1_g, norm2_g, ada_w, ada_b, w_in, mlstm_gate_b, mlstm_conv_w, mlstm_out_g,
              moba_qk_g, ret_out_g, nsa_q_g, nsa_k_g, nsa_cmp_pos, nsa_cmp_w1, nsa_cmp_w2, w_out,
              router_g_w, router_g_b, router_e_w, router_e_b, exp_w1, exp_w3, exp_w2):
    for l in range(DEPTH):
        x = hybrid_layer(x, c, norm1_g[l], norm2_g[l], ada_w[l], ada_b[l], w_in[l], mlstm_gate_b[l],
                         mlstm_conv_w[l], mlstm_out_g[l], moba_qk_g[l], ret_out_g[l], nsa_q_g[l], nsa_k_g[l],
                         nsa_cmp_pos[l], nsa_cmp_w1[l], nsa_cmp_w2[l], w_out[l], router_g_w[l], router_g_b[l],
                         router_e_w[l], router_e_b[l], exp_w1[l], exp_w3[l], exp_w2[l])
    return x
```

```cpp
#include <hip/hip_runtime.h>
#include <cstdio>
#include <cstdint>
#define MK_PER_PHASE 1
namespace pg8 {
#define PG8_LAS __attribute__((address_space(3)))
typedef unsigned short bf16_t;
typedef short bf16x8 __attribute__((ext_vector_type(8)));
typedef float f32x4 __attribute__((ext_vector_type(4)));
typedef unsigned u32x4 __attribute__((ext_vector_type(4)));
constexpr int BM = 256, BK = 64, HALF = 128, HTB = HALF * BK * 2  , STAGE_BYTES = 8 * HTB, NXCD = 8, WGM = 8;

__host__ __device__ __forceinline__ int lds_byte(int r, int c) { const int st = (r >> 4) * 2 + (c >> 5), rr = r & 15, cc = c & 31, ob = rr * 64 + cc * 2; return st * 1024 + (ob ^ (((ob >> 9) & 1) << 5)); }
__host__ __device__ __forceinline__ void stage_rc(int b, int& R, int& C) { const int st = b / 1024, sb = b % 1024, swz = sb ^ (((sb >> 9) & 1) << 5); R = (st >> 1) * 16 + swz / 64; C = (st & 1) * 32 + (swz % 64) / 2; }
__host__ __device__ __forceinline__ int perm32(int rho) { const int n = rho >> 4, i = rho & 15; return 8 * (i >> 2) + 4 * n + (i & 3); }

struct Unit { int pm, pn; };
struct Gemm { const bf16_t* A; const bf16_t* Bt; int M, N, K; };

struct StaticOrder {
    int nM, nN, nwg, G, c;
    __host__ __device__ void init(int M, int N, int G_, int c_) { nM = M / BM; nN = N / BM; nwg = nM * nN; G = G_; c = c_; }
    __host__ __device__ bool next(int i, Unit& u) const {
        const long L = (long)i * G + c; if (L >= nwg) return false;
        int wgid = (int)L; { const int q = nwg / NXCD, r = nwg % NXCD, xcd = wgid % NXCD, off = wgid / NXCD; wgid = (xcd < r ? xcd * (q + 1) : r * (q + 1) + (xcd - r) * q) + off; }
        const int nig = WGM * nN, gid = wgid / nig, fm = gid * WGM, gsz = (nM - fm) < WGM ? (nM - fm) : WGM;
        u.pm = fm + ((wgid % nig) % gsz); u.pn = (wgid % nig) / gsz; return true;
    }
    __device__ __forceinline__ void a_ready(const Unit&) const {}
    __device__ __forceinline__ void done(const Unit&) const {}
};

__device__ __forceinline__ unsigned cvt_pk_bf16(float lo, float hi) { unsigned r; asm volatile("v_cvt_pk_bf16_f32 %0, %1, %2" : "=v"(r) : "v"(lo), "v"(hi)); return r; }
__device__ __forceinline__ float silu_f(float v) { return v * __builtin_amdgcn_rcpf(1.0f + __expf(-v)); }

struct EpiZ {
    static constexpr bool PERM = true, AFTER_DRAIN = false;
    bf16_t* Z; float* Gt;
    __device__ __forceinline__ void operator()(const f32x4 (&acc)[2][2][4][2], const Unit& u, int wr, int wc, int fr, int fq) const {
        const int row0 = u.pm * BM + wr * 64 + fr;
        if (u.pn < 36) {
            const int col0 = u.pn * BM + wc * 32 + 8 * fq;
#pragma unroll
            for (int ai = 0; ai < 2; ++ai)
#pragma unroll
                for (int m = 0; m < 4; ++m) { bf16_t* rowp = Z + (size_t)(row0 + ai * HALF + m * 16) * 9216 + col0;
#pragma unroll
                    for (int bj = 0; bj < 2; ++bj) { const f32x4 v0 = acc[ai][bj][m][0], v1 = acc[ai][bj][m][1];
                        u32x4 w; w.x = cvt_pk_bf16(v0[0], v0[1]); w.y = cvt_pk_bf16(v0[2], v0[3]); w.z = cvt_pk_bf16(v1[0], v1[1]); w.w = cvt_pk_bf16(v1[2], v1[3]);
                        *(u32x4*)(rowp + bj * HALF) = w; } }
        } else if (wc == 0) {
#pragma unroll
            for (int ai = 0; ai < 2; ++ai)
#pragma unroll
                for (int m = 0; m < 4; ++m) { float* rowp = Gt + (size_t)(row0 + ai * HALF + m * 16) * 32 + 8 * fq;
                    *(f32x4*)(rowp) = acc[ai][0][m][0]; *(f32x4*)(rowp + 4) = acc[ai][0][m][1]; }
        }
    }
};
struct EpiX1 {
    static constexpr bool PERM = false, AFTER_DRAIN = false;
    const float* xin; float* out; const float* g1;
    __device__ __forceinline__ void operator()(const f32x4 (&acc)[2][2][4][2], const Unit& u, int wr, int wc, int fr, int fq) const {
        const int row0 = u.pm * BM + wr * 64 + fr, col0 = u.pn * BM + wc * 32 + 4 * fq;
        const float* gb = g1 + (size_t)(u.pm >> 3) * 12288 + col0;
        f32x4 gv[2][2];
#pragma unroll
        for (int bj = 0; bj < 2; ++bj)
#pragma unroll
            for (int n = 0; n < 2; ++n) gv[bj][n] = *(const f32x4*)(gb + bj * HALF + n * 16);
#pragma unroll
        for (int ai = 0; ai < 2; ++ai)
#pragma unroll
            for (int m = 0; m < 4; ++m) { const size_t off = (size_t)(row0 + ai * HALF + m * 16) * 2048 + col0;
#pragma unroll
                for (int bj = 0; bj < 2; ++bj)
#pragma unroll
                    for (int n = 0; n < 2; ++n) { const f32x4 xv = *(const f32x4*)(xin + off + bj * HALF + n * 16);
                        *(f32x4*)(out + off + bj * HALF + n * 16) = xv + gv[bj][n] * acc[ai][bj][m][n]; } }
    }
};
struct EpiH {
    static constexpr bool PERM = true, AFTER_DRAIN = false;
    bf16_t* H;
    __device__ __forceinline__ void operator()(const f32x4 (&acc)[2][2][4][2], const Unit& u, int wr, int wc, int fr, int fq) const {
        const int row0 = u.pm * BM + wr * 64 + fr, col0 = (u.pn & 3) * 128 + wc * 32 + 8 * fq;
#pragma unroll
        for (int ai = 0; ai < 2; ++ai)
#pragma unroll
            for (int m = 0; m < 4; ++m) { const f32x4 a0 = acc[ai][0][m][0], a1 = acc[ai][0][m][1], b0 = acc[ai][1][m][0], b1 = acc[ai][1][m][1];
                u32x4 w; w.x = cvt_pk_bf16(silu_f(a0[0]) * b0[0], silu_f(a0[1]) * b0[1]); w.y = cvt_pk_bf16(silu_f(a0[2]) * b0[2], silu_f(a0[3]) * b0[3]);
                w.z = cvt_pk_bf16(silu_f(a1[0]) * b1[0], silu_f(a1[1]) * b1[1]); w.w = cvt_pk_bf16(silu_f(a1[2]) * b1[2], silu_f(a1[3]) * b1[3]);
                *(u32x4*)(H + (size_t)(row0 + ai * HALF + m * 16) * 512 + col0) = w; }
    }
};
struct EpiY {
    static constexpr bool PERM = true, AFTER_DRAIN = false;
    bf16_t* Y;
    __device__ __forceinline__ void operator()(const f32x4 (&acc)[2][2][4][2], const Unit& u, int wr, int wc, int fr, int fq) const {
        const int row0 = u.pm * BM + wr * 64 + fr, col0 = (u.pn & 7) * BM + wc * 32 + 8 * fq;
#pragma unroll
        for (int ai = 0; ai < 2; ++ai)
#pragma unroll
            for (int m = 0; m < 4; ++m) { bf16_t* rowp = Y + (size_t)(row0 + ai * HALF + m * 16) * 2048 + col0;
#pragma unroll
                for (int bj = 0; bj < 2; ++bj) { const f32x4 v0 = acc[ai][bj][m][0], v1 = acc[ai][bj][m][1];
                    u32x4 w; w.x = cvt_pk_bf16(v0[0], v0[1]); w.y = cvt_pk_bf16(v0[2], v0[3]); w.z = cvt_pk_bf16(v1[0], v1[1]); w.w = cvt_pk_bf16(v1[2], v1[3]);
                    *(u32x4*)(rowp + bj * HALF) = w; } }
    }
};
struct GroupedOrder {
    int nU, NCT, G, c; const PG8_LAS int* tstart;
    __device__ __forceinline__ bool next(int i, Unit& u) const {
        const long L = (long)i * G + c; if (L >= nU) return false;
        int wgid = (int)L; { const int q = nU / NXCD, r = nU % NXCD, xcd = wgid % NXCD, off = wgid / NXCD; wgid = (xcd < r ? xcd * (q + 1) : r * (q + 1) + (xcd - r) * q) + off; }
        const int rt = wgid / NCT, ct = wgid - rt * NCT;
        int e = 0;
#pragma unroll
        for (int k = 1; k < 32; ++k) e += (tstart[k] <= rt) ? 1 : 0;
        e = __builtin_amdgcn_readfirstlane(e);
        u.pm = rt; u.pn = e * NCT + ct; return true;
    }
    __device__ __forceinline__ void a_ready(const Unit&) const {}
    __device__ __forceinline__ void done(const Unit&) const {}
};
template <class Epi, class Sched, bool ALIGN_EPI = false, bool SP2 = false>
__device__ __forceinline__ void gemm_phase(PG8_LAS unsigned char* lds, const Gemm g, const Sched& S, const Epi& E) {
    int tid_ = threadIdx.x; asm volatile("" : "+v"(tid_));
    const int tid = tid_, wid = __builtin_amdgcn_readfirstlane(tid >> 6), lane = tid & 63, wr = wid >> 2, wc = wid & 3, fr = lane & 15, fq = lane >> 4;
    const int K = g.K, nt = K / BK;
    unsigned voffA[2], voffB[2];
#pragma unroll
    for (int i = 0; i < 2; ++i) { int R, C; stage_rc(tid * 16 + i * 8192, R, C); const int Rb = Epi::PERM ? ((R & ~31) + perm32(R & 31)) : R;
        voffA[i] = (unsigned)(R * K + C) * 2u; voffB[i] = (unsigned)(Rb * K + C) * 2u; }
    const size_t kstep = (size_t)(BK * 2);
    const size_t hstep = (size_t)HALF * K * 2;
    const size_t tstep = 2 * hstep;
    const unsigned ldsw = (unsigned)wid * 1024u;
    const int aoff = lds_byte(wr * 64 + fr, fq * 8), boff = lds_byte(wc * 32 + fr, fq * 8);
#define PG8_SA(b, h) (((b) * 2 + (h)) * HTB)
#define PG8_SB(b, h) ((4 + (b) * 2 + (h)) * HTB)
#define PG8_STAGE(bufoff, gbase, voff) do { _Pragma("unroll") for (int _i = 0; _i < 2; ++_i) \
        __builtin_amdgcn_global_load_lds((const unsigned*)((const char*)(gbase) + (voff)[_i]), (PG8_LAS unsigned*)(lds + (bufoff) + ldsw + _i * 8192), 16, 0, 0); } while (0)
#define PG8_LDA(dst, b, h) do { _Pragma("unroll") for (int m = 0; m < 4; ++m) _Pragma("unroll") for (int k = 0; k < 2; ++k) dst[m][k] = *(const PG8_LAS bf16x8*)(lds + PG8_SA(b, h) + aoff + m * 2048 + k * 1024); } while (0)
#define PG8_LDB(dst, b, h) do { _Pragma("unroll") for (int n = 0; n < 2; ++n) _Pragma("unroll") for (int k = 0; k < 2; ++k) dst[n][k] = *(const PG8_LAS bf16x8*)(lds + PG8_SB(b, h) + boff + n * 2048 + k * 1024); } while (0)
#define PG8_MMA(ai, bj, At, Bt) do { __builtin_amdgcn_s_setprio(1); _Pragma("unroll") for (int m = 0; m < 4; ++m) _Pragma("unroll") for (int n = 0; n < 2; ++n) _Pragma("unroll") for (int k = 0; k < 2; ++k) \
        acc[ai][bj][m][n] = __builtin_amdgcn_mfma_f32_16x16x32_bf16(Bt[n][k], At[m][k], acc[ai][bj][m][n], 0, 0, 0); __builtin_amdgcn_s_setprio(0); } while (0)
#define PG8_WAIT_V(n) asm volatile("s_waitcnt vmcnt(" #n ")" ::: "memory")
#define PG8_WAIT_L(n) asm volatile("s_waitcnt lgkmcnt(" #n ")" ::: "memory")
#define PG8_BAR __builtin_amdgcn_s_barrier()
#define PG8_SCHED __builtin_amdgcn_sched_barrier(0)
    Unit cur, nxt; int ui = 0;
    if (!S.next(0, cur)) return;
    f32x4 acc[2][2][4][2];
#pragma unroll
    for (int a = 0; a < 2; ++a)
#pragma unroll
        for (int b = 0; b < 2; ++b)
#pragma unroll
            for (int m = 0; m < 4; ++m)
#pragma unroll
                for (int n = 0; n < 2; ++n) acc[a][b][m][n] = (f32x4){0.f, 0.f, 0.f, 0.f};
    bf16x8 At[4][2], B0[2][2], B1[2][2];
    const char* cA = (const char*)g.A + (size_t)cur.pm * tstep; const char* cB = (const char*)g.Bt + (size_t)cur.pn * tstep;
    S.a_ready(cur);
    if constexpr (SP2) {
        PG8_STAGE(PG8_SB(0, 0), cB, voffB); PG8_STAGE(PG8_SB(0, 1), cB + hstep, voffB); PG8_STAGE(PG8_SA(0, 0), cA, voffA); PG8_STAGE(PG8_SA(0, 1), cA + hstep, voffA);
        if (wr == 1) PG8_BAR;
        PG8_WAIT_V(2); PG8_BAR;
        PG8_STAGE(PG8_SB(1, 0), cB + kstep, voffB); PG8_STAGE(PG8_SA(1, 0), cA + kstep, voffA); PG8_STAGE(PG8_SB(1, 1), cB + hstep + kstep, voffB);
        PG8_WAIT_V(6); PG8_BAR;
    } else {
        PG8_STAGE(PG8_SB(0, 0), cB, voffB); PG8_STAGE(PG8_SA(0, 0), cA, voffA); PG8_STAGE(PG8_SB(0, 1), cB + hstep, voffB); PG8_STAGE(PG8_SA(0, 1), cA + hstep, voffA);
        if (wr == 1) PG8_BAR;
        PG8_WAIT_V(4); PG8_BAR;
        PG8_STAGE(PG8_SB(1, 0), cB + kstep, voffB); PG8_STAGE(PG8_SA(1, 0), cA + kstep, voffA); PG8_STAGE(PG8_SB(1, 1), cB + hstep + kstep, voffB);
        PG8_WAIT_V(6); PG8_BAR;
    }
    for (;;) {
        const bool has_next = S.next(ui + 1, nxt);
        const char* nA = has_next ? (const char*)g.A + (size_t)nxt.pm * tstep : cA; const char* nB = has_next ? (const char*)g.Bt + (size_t)nxt.pn * tstep : cB;
        for (int t = 0; t < nt; t += 2) {
            const bool last = (t == nt - 2);
            const char* a1 = cA + (size_t)(t + 1) * kstep;
            const char* a2 = last ? nA : cA + (size_t)(t + 2) * kstep; const char* b2 = last ? nB : cB + (size_t)(t + 2) * kstep;
            const char* a3 = a2 + kstep; const char* b3 = b2 + kstep;
            if (last && has_next) S.a_ready(nxt);
            if constexpr (SP2) {
            PG8_LDB(B0, 0, 0); PG8_LDB(B1, 0, 1); PG8_SCHED; PG8_LDA(At, 0, 0); PG8_STAGE(PG8_SA(1, 1), a1 + hstep, voffA);
            PG8_WAIT_V(8); PG8_WAIT_L(0); PG8_BAR; PG8_MMA(0, 0, At, B0); PG8_MMA(0, 1, At, B1); PG8_BAR; PG8_SCHED;
            PG8_LDA(At, 0, 1); PG8_STAGE(PG8_SB(0, 0), b2, voffB); PG8_STAGE(PG8_SB(0, 1), b2 + hstep, voffB); PG8_STAGE(PG8_SA(0, 0), a2, voffA);
            PG8_WAIT_V(8); PG8_WAIT_L(0); PG8_BAR; PG8_MMA(1, 0, At, B0); PG8_MMA(1, 1, At, B1); PG8_BAR; PG8_SCHED;
            PG8_LDB(B0, 1, 0); PG8_LDB(B1, 1, 1); PG8_SCHED; PG8_LDA(At, 1, 0); PG8_STAGE(PG8_SA(0, 1), a2 + hstep, voffA);
            PG8_WAIT_V(8); PG8_WAIT_L(0); PG8_BAR; PG8_MMA(0, 0, At, B0); PG8_MMA(0, 1, At, B1); PG8_BAR; PG8_SCHED;
            PG8_LDA(At, 1, 1); PG8_STAGE(PG8_SB(1, 0), b3, voffB); PG8_STAGE(PG8_SB(1, 1), b3 + hstep, voffB); PG8_STAGE(PG8_SA(1, 0), a3, voffA);
            PG8_WAIT_V(8); PG8_WAIT_L(0); PG8_BAR; PG8_MMA(1, 0, At, B0); PG8_MMA(1, 1, At, B1); PG8_BAR; PG8_SCHED;
            } else {
            PG8_LDB(B0, 0, 0); PG8_SCHED; PG8_LDA(At, 0, 0); PG8_STAGE(PG8_SA(1, 1), a1 + hstep, voffA);
            PG8_WAIT_L(8); PG8_BAR; PG8_WAIT_L(0); PG8_MMA(0, 0, At, B0); PG8_BAR; PG8_SCHED;
            PG8_LDB(B1, 0, 1); PG8_STAGE(PG8_SB(0, 0), b2, voffB);
            PG8_BAR; PG8_WAIT_L(0); PG8_MMA(0, 1, At, B1); PG8_BAR;
            PG8_LDA(At, 0, 1); PG8_STAGE(PG8_SA(0, 0), a2, voffA);
            PG8_BAR; PG8_WAIT_L(0); PG8_MMA(1, 0, At, B0); PG8_BAR; PG8_SCHED;
            PG8_STAGE(PG8_SB(0, 1), b2 + hstep, voffB);
            PG8_WAIT_V(6); PG8_BAR; PG8_MMA(1, 1, At, B1); PG8_BAR;
            PG8_LDB(B0, 1, 0); PG8_SCHED; PG8_LDA(At, 1, 0); PG8_STAGE(PG8_SA(0, 1), a2 + hstep, voffA);
            PG8_WAIT_L(8); PG8_BAR; PG8_WAIT_L(0); PG8_MMA(0, 0, At, B0); PG8_BAR; PG8_SCHED;
            PG8_LDB(B1, 1, 1); PG8_STAGE(PG8_SB(1, 0), b3, voffB);
            PG8_BAR; PG8_WAIT_L(0); PG8_MMA(0, 1, At, B1); PG8_BAR;
            PG8_LDA(At, 1, 1); PG8_STAGE(PG8_SA(1, 0), a3, voffA);
            PG8_BAR; PG8_WAIT_L(0); PG8_MMA(1, 0, At, B0); PG8_BAR; PG8_SCHED;
            PG8_STAGE(PG8_SB(1, 1), b3 + hstep, voffB);
            PG8_WAIT_V(6); PG8_BAR; PG8_MMA(1, 1, At, B1); PG8_BAR;
            }
        }
        if constexpr (ALIGN_EPI) { if (wr == 0) PG8_BAR; }
        if constexpr (!Epi::AFTER_DRAIN) { E(acc, cur, wr, wc, fr, fq); S.done(cur); }
        if (!has_next) break;
#pragma unroll
        for (int a = 0; a < 2; ++a)
#pragma unroll
            for (int b = 0; b < 2; ++b)
#pragma unroll
                for (int m = 0; m < 4; ++m)
#pragma unroll
                    for (int n = 0; n < 2; ++n) acc[a][b][m][n] = (f32x4){0.f, 0.f, 0.f, 0.f};
        cur = nxt; cA = nA; cB = nB; ++ui;
        if constexpr (ALIGN_EPI) { if (wr == 1) PG8_BAR; }
    }
    PG8_WAIT_V(0);
    if constexpr (!ALIGN_EPI) { if (wr == 0) PG8_BAR; }
    PG8_BAR;
    if constexpr (Epi::AFTER_DRAIN) { E.fused(acc, cur, wr, wc, fr, fq, lds, wid, lane); S.done(cur); }
#undef PG8_SA
#undef PG8_SB
#undef PG8_STAGE
#undef PG8_LDA
#undef PG8_LDB
#undef PG8_MMA
#undef PG8_WAIT_V
#undef PG8_WAIT_L
#undef PG8_BAR
#undef PG8_SCHED
}
}

constexpr int NWAVES = 8, NTHR = 512;
constexpr int BATCH = 8, T = 2048, D = 2048, M = BATCH * T, NL = 2;
constexpr int DIN = 9236, ZW = 9216, NZP = 9472;
constexpr int HD = 128, NH = 4;
constexpr int KO = 2560;
constexpr int NE = 32, DE = 512;
constexpr int SLOTS = 2 * M + NE * 256;
constexpr float EPS = 1e-6f;
constexpr float LOG2E = 1.4426950408889634f;
constexpr float SCALE = 0.088388347648318440f;
constexpr int Z_MQ = 0, Z_MK = 512, Z_MV = 1024, Z_MO = 1536, Z_BQ = 2048, Z_BK = 2560, Z_BV = 3072, Z_RQ = 3584, Z_RK = 4096, Z_RV = 4608, Z_RG = 5120,
              Z_NQ = 5632, Z_NKC = 6144, Z_NVC = 6656, Z_NKS = 7168, Z_NVS = 7680, Z_NKW = 8192, Z_NVW = 8704;
constexpr size_t MiB = 1u << 20;
constexpr size_t WS_CTL = 0, CTL_ZERO_BYTES = 1 * MiB;
constexpr size_t WS_MOD = 1 * MiB;
constexpr size_t WS_GT = 2 * MiB;
constexpr size_t WS_FQ = 4 * MiB;
constexpr size_t WS_GK = 4 * MiB + 512 * 1024;
constexpr size_t WS_KPART = 5 * MiB;
constexpr size_t WS_KCMP = 6 * MiB;
constexpr size_t WS_VCMP = 7 * MiB;
constexpr size_t WS_CB1 = 8 * MiB;
constexpr size_t WS_TOKE = 8 * MiB + 64 * 1024;
constexpr size_t WS_TOKP = WS_TOKE + 128 * 1024;
constexpr size_t WS_TOKG = WS_TOKP + 128 * 1024;
constexpr size_t WS_TOKS = WS_TOKG + 128 * 1024;
constexpr size_t WS_RTT = 9 * MiB;
constexpr size_t WS_CW1T = 10 * MiB;
constexpr size_t WS_CW2T = 14 * MiB;
constexpr size_t WS_WINT = 16 * MiB;
constexpr size_t WS_WOUTT = 90 * MiB;
constexpr size_t WS_W13T = 110 * MiB;
constexpr size_t WS_W2T = 366 * MiB;
constexpr size_t WS_HB = 500 * MiB;
constexpr size_t WS_Z = 564 * MiB;
constexpr size_t WS_QKM = 852 * MiB;
constexpr size_t WS_YCAT = 884 * MiB;
constexpr size_t WS_XS = 564 * MiB;
constexpr size_t WS_HBUF = 724 * MiB;
constexpr size_t WS_Y = 764 * MiB;
constexpr size_t WS_END = 964 * MiB;
constexpr int CW_BAR = 4096;
constexpr int CW_QUEUE = 8192;
constexpr int CW_CNT = 8192 + 1024;
constexpr int RING_OFF = 0, RING_BYTES = 131072;
constexpr int LDSCTL_OFF = RING_BYTES, MISC_OFF = LDSCTL_OFF + 320;
constexpr int LDS_BYTES = 147456;

#define GAS __attribute__((address_space(1)))
#define LAS __attribute__((address_space(3)))
typedef unsigned short bf16;
typedef unsigned v4u __attribute__((ext_vector_type(4)));
typedef unsigned v2u __attribute__((ext_vector_type(2)));
typedef float f32x4 __attribute__((ext_vector_type(4)));
typedef float f32x16 __attribute__((ext_vector_type(16)));
typedef short bf16x8 __attribute__((ext_vector_type(8)));
typedef short s16x4 __attribute__((ext_vector_type(4)));
typedef GAS unsigned gu32;
#define RLX_AGENT __ATOMIC_RELAXED, __HIP_MEMORY_SCOPE_AGENT
#define LDS_WAIT() asm volatile("s_waitcnt lgkmcnt(0)" ::: "memory")
#define VM_WAIT() asm volatile("s_waitcnt vmcnt(0)" ::: "memory")
__device__ __forceinline__ unsigned f2bf(float f) { unsigned u = __builtin_bit_cast(unsigned, f); return (u + 0x7fffu + ((u >> 16) & 1u)) >> 16; }
__device__ __forceinline__ unsigned pk2(float lo, float hi) { return f2bf(lo) | (f2bf(hi) << 16); }
__device__ __forceinline__ float bflo(unsigned w) { return __uint_as_float(w << 16); }
__device__ __forceinline__ float bfhi(unsigned w) { return __uint_as_float(w & 0xffff0000u); }
__device__ __forceinline__ float bf2f(bf16 b) { return __uint_as_float(((unsigned)b) << 16); }
__device__ __forceinline__ float wave_sum(float v) {
#pragma unroll
    for (int o = 1; o < 64; o <<= 1) v += __shfl_xor(v, o);
    return v;
}
__device__ __forceinline__ float sigmoid_f(float v) { return __builtin_amdgcn_rcpf(1.0f + __expf(-v)); }
__device__ __forceinline__ float silu2_f(float v) { return v * sigmoid_f(v); }

#ifndef PH_MASK2
#define PH_MASK2 0xFFFFu
#endif
#define EN2(j) ((PH_MASK2 >> (j)) & 1u)
#define XB_TMO      128
#define XB_XCNT(j)  (256  + 64 * (j))
#define XB_XSUB(j)  (1280 + 64 * (j))
#define XB_XGEN(j)  (2304 + 64 * (j))
#define XB_TOP      3328
#define XB_TOPGEN   3392
#define XCD_BAR_WORDS 3456
#define XB_SPIN_CAP (1u << 18)

__device__ __forceinline__ unsigned xb_ld(unsigned* p)              { return __hip_atomic_load(p, __ATOMIC_RELAXED, __HIP_MEMORY_SCOPE_AGENT); }
__device__ __forceinline__ unsigned xb_add(unsigned* p, unsigned v) { return __hip_atomic_fetch_add(p, v, __ATOMIC_RELAXED, __HIP_MEMORY_SCOPE_AGENT); }
__device__ __forceinline__ unsigned xb_xcc_id() { return (unsigned)__builtin_amdgcn_s_getreg((3 << 11) | 20) & 0xFu; }
#define XB_SPIN(cond, bar) do { unsigned _sp = 0; while (cond) { __builtin_amdgcn_s_sleep(1); \
    if ((++_sp & 255u) == 0u) { if (xb_ld(&(bar)[XB_TMO])) break; if (_sp > XB_SPIN_CAP) { atomicAdd(&(bar)[XB_TMO], 1u); break; } } } } while (0)

struct XcdBarrier {
    unsigned* bar; unsigned x;
    volatile LAS unsigned* st;
};

__device__ __forceinline__ XcdBarrier xcd_barrier_post(unsigned* bar, volatile LAS unsigned* st) {
    XcdBarrier b; b.bar = bar; b.x = xb_xcc_id(); b.st = st;
    if (threadIdx.x == 0) (void)xb_add(&bar[XB_XCNT(b.x)], 1u);
    return b;
}
__device__ __forceinline__ void xcd_barrier_complete(unsigned* bar, unsigned x, unsigned& nloc, unsigned& nx) {
    const unsigned G = gridDim.x * gridDim.y * gridDim.z;
    unsigned sum, cnt, mine, sp = 0u;
    for (;;) {
        sum = 0u; cnt = 0u; mine = 0u;
#pragma unroll
        for (unsigned j = 0; j < 16; ++j) { const unsigned c = xb_ld(&bar[XB_XCNT(j)]); sum += c; cnt += (c > 0u) ? 1u : 0u; mine = (j == x) ? c : mine; }
        if (sum == G) break;
        __builtin_amdgcn_s_sleep(1);
        if ((++sp & 255u) == 0u) { if (xb_ld(&bar[XB_TMO])) break; if (sp > XB_SPIN_CAP) { atomicAdd(&bar[XB_TMO], 1u); break; } }
    }
    nloc = mine > 0u ? mine : 1u; nx = cnt > 0u ? cnt : 1u;
}

__device__ __forceinline__ void xcd_barrier(const XcdBarrier& b) {
    asm volatile("s_waitcnt vmcnt(0)" ::: "memory");
    __syncthreads();
    if (threadIdx.x == 0) {
        unsigned* bar = b.bar;
        __builtin_amdgcn_s_waitcnt(0);
        unsigned nloc = b.st[0], nx = b.st[1];
        if (nloc == 0u) { xcd_barrier_complete(bar, b.x, nloc, nx); b.st[0] = nloc; b.st[1] = nx; }
        const unsigned old = xb_add(&bar[XB_XSUB(b.x)], 1u);
        const unsigned gen = old / nloc;
        if (old + 1u == (gen + 1u) * nloc) {
            __builtin_amdgcn_fence(__ATOMIC_RELEASE, "agent");
            asm volatile("s_waitcnt vmcnt(0)" ::: "memory");
            const unsigned og = xb_add(&bar[XB_TOP], 1u);
            const unsigned tg = og / nx;
            if (og + 1u == (tg + 1u) * nx) xb_add(&bar[XB_TOPGEN], 1u);
            else XB_SPIN(xb_ld(&bar[XB_TOPGEN]) == tg, bar);
            __builtin_amdgcn_fence(__ATOMIC_ACQUIRE, "agent");
            xb_add(&bar[XB_XGEN(b.x)], 1u);
            asm volatile("s_waitcnt vmcnt(0)" ::: "memory");
        } else {
            XB_SPIN(xb_ld(&bar[XB_XGEN(b.x)]) == gen, bar);
            __builtin_amdgcn_fence(__ATOMIC_ACQUIRE, "agent");
            asm volatile("s_waitcnt vmcnt(0)" ::: "memory");
        }
    }
    __syncthreads();
}
namespace att {
constexpr int SHM_V = 64 * 128 * 2, SHM_K = 64 * 128 * 2;
constexpr int OFF_WS = 65536;
constexpr int OFF_GT = OFF_WS + 4096;
constexpr int OFF_KM = OFF_GT + 512;
constexpr int OFF_UN = OFF_KM + 4096;
constexpr int OFF_HID = OFF_UN + 256;
constexpr float THR2 = 11.5f;
#define KSWZ(row, colB) ((row) * 256 + ((colB) ^ (((row) & 7) << 4)))
#define SBAR() __builtin_amdgcn_sched_barrier(0)
__device__ __forceinline__ constexpr int crc(int r) { return (r & 3) + 8 * (r >> 2); }
__device__ __forceinline__ int crow(int r, int hi) { return (r & 3) + 8 * (r >> 2) + 4 * hi; }
__device__ __forceinline__ unsigned cvtpk(float lo, float hi) { unsigned r; asm volatile("v_cvt_pk_bf16_f32 %0, %1, %2" : "=v"(r) : "v"(lo), "v"(hi)); return r; }
__device__ __forceinline__ float swap_max(float v) { auto rr = __builtin_amdgcn_permlane32_swap(__float_as_uint(v), __float_as_uint(v), false, false); return fmaxf(__uint_as_float(rr[0]), __uint_as_float(rr[1])); }
__device__ __forceinline__ float swap_sum(float v) { auto rr = __builtin_amdgcn_permlane32_swap(__float_as_uint(v), __float_as_uint(v), false, false); return __uint_as_float(rr[0]) + __uint_as_float(rr[1]); }

__device__ __forceinline__ void qkt(f32x16& p0, f32x16& p1, const LAS char* Ks, const bf16x8 (&qr)[8], int r32, int hi) {
    p0 = f32x16{}; p1 = f32x16{};
#pragma unroll
    for (int d0 = 0; d0 < 8; ++d0) { const int cb = (d0 * 16 + hi * 8) * 2;
        const bf16x8 b0 = *(const LAS bf16x8*)(Ks + KSWZ(r32, cb));
        const bf16x8 b1 = *(const LAS bf16x8*)(Ks + KSWZ(32 + r32, cb));
        p0 = __builtin_amdgcn_mfma_f32_32x32x16_bf16(b0, qr[d0], p0, 0, 0, 0);
        p1 = __builtin_amdgcn_mfma_f32_32x32x16_bf16(b1, qr[d0], p1, 0, 0, 0); }
}
__device__ __forceinline__ int v_st(int k, int c) { const int kk = (k & ~0xC) | ((k & 4) << 1) | ((k & 8) >> 1); return ((kk >> 3) * 4 + (c >> 5)) * 512 + ((kk & 7) * 32 + (c & 31)) * 2; }
__device__ __forceinline__ int v_rd_base(int lane) { return ((lane & 3) << 3) | (((lane >> 2) & 3) << 6) | (((lane >> 4) & 1) << 5) | (((lane >> 5) & 1) << 8); }
constexpr int v_rd_off(int d0, int ks, int half) { return d0 * 512 + ks * 4096 + half * 2048; }
template <int OFF> __device__ __forceinline__ s16x4 tr_read(int vb) { s16x4 r; asm volatile("ds_read_b64_tr_b16 %0, %1 offset:%2" : "=&v"(r) : "v"(vb), "i"(OFF) : "memory"); return r; }
template <int D0> __device__ __forceinline__ void pv_one(f32x16& od, int vb, bf16x8 pa0, bf16x8 pa1, bf16x8 pa2, bf16x8 pa3) {
    const s16x4 l0 = tr_read<v_rd_off(D0, 0, 0)>(vb), h0 = tr_read<v_rd_off(D0, 0, 1)>(vb), l1 = tr_read<v_rd_off(D0, 1, 0)>(vb), h1 = tr_read<v_rd_off(D0, 1, 1)>(vb);
    const s16x4 l2 = tr_read<v_rd_off(D0, 2, 0)>(vb), h2 = tr_read<v_rd_off(D0, 2, 1)>(vb), l3 = tr_read<v_rd_off(D0, 3, 0)>(vb), h3 = tr_read<v_rd_off(D0, 3, 1)>(vb);
    asm volatile("s_waitcnt lgkmcnt(0)" ::: "memory"); SBAR();
#define PKV(L, H) (bf16x8){L[0], L[1], L[2], L[3], H[0], H[1], H[2], H[3]}
    od = __builtin_amdgcn_mfma_f32_32x32x16_bf16(pa0, PKV(l0, h0), od, 0, 0, 0);
    od = __builtin_amdgcn_mfma_f32_32x32x16_bf16(pa1, PKV(l1, h1), od, 0, 0, 0);
    od = __builtin_amdgcn_mfma_f32_32x32x16_bf16(pa2, PKV(l2, h2), od, 0, 0, 0);
    od = __builtin_amdgcn_mfma_f32_32x32x16_bf16(pa3, PKV(l3, h3), od, 0, 0, 0);
#undef PKV
}
__device__ __forceinline__ void pv_d0(f32x16 (&o)[4], int vb, bf16x8 pa0, bf16x8 pa1, bf16x8 pa2, bf16x8 pa3) {
    pv_one<0>(o[0], vb, pa0, pa1, pa2, pa3); pv_one<1>(o[1], vb, pa0, pa1, pa2, pa3); pv_one<2>(o[2], vb, pa0, pa1, pa2, pa3); pv_one<3>(o[3], vb, pa0, pa1, pa2, pa3);
}
__device__ __forceinline__ void pack_p(const f32x16& p0, const f32x16& p1, bf16x8& pa0, bf16x8& pa1, bf16x8& pa2, bf16x8& pa3) {
#define PK4(P, BASE, OUT) do { unsigned a0 = cvtpk(P[BASE + 0], P[BASE + 1]), a1 = cvtpk(P[BASE + 2], P[BASE + 3]);   \
    unsigned b0 = cvtpk(P[BASE + 4], P[BASE + 5]), b1 = cvtpk(P[BASE + 6], P[BASE + 7]);                              \
    auto r0 = __builtin_amdgcn_permlane32_swap(a0, b0, false, false); auto r1 = __builtin_amdgcn_permlane32_swap(a1, b1, false, false); \
    v4u w = {r0[0], r1[0], r0[1], r1[1]}; OUT = __builtin_bit_cast(bf16x8, w); } while (0)
    PK4(p0, 0, pa0); PK4(p0, 8, pa1); PK4(p1, 0, pa2); PK4(p1, 8, pa3);
#undef PK4
}
__device__ __forceinline__ void rescale_o(f32x16 (&o)[4], float a, LAS float* al_l, int r32, int hi) {
    if (hi == 0) al_l[r32] = a;
    asm volatile("s_waitcnt lgkmcnt(0)" ::: "memory");
#pragma unroll
    for (int r = 0; r < 16; ++r) { const float f = al_l[crow(r, hi)];
#pragma unroll
        for (int d = 0; d < 4; ++d) o[d][r] *= f; }
}
__device__ __forceinline__ void row_bcast(float v, float (&out)[16], LAS float* sl, int r32, int hi) {
    asm volatile("s_waitcnt lgkmcnt(0)" ::: "memory");
    if (hi == 0) sl[r32] = v;
    asm volatile("s_waitcnt lgkmcnt(0)" ::: "memory");
#pragma unroll
    for (int r = 0; r < 16; ++r) out[r] = sl[crow(r, hi)];
    asm volatile("s_waitcnt lgkmcnt(0)" ::: "memory");
}

enum { MD_MLSTM = 0, MD_MOBA = 1, MD_RET = 2, MD_SEL = 3, MD_WIN = 4 };
struct LaneCtx { int tq; float a; float slope2; unsigned qmask; };

template <int MODE>
__device__ __forceinline__ void attn_pass(LAS char* lds, const bf16* __restrict__ Kh, int ldk, const bf16* __restrict__ Vh, int ldv, const float* __restrict__ Gk,
                                          unsigned tmask, unsigned wmask, int qb, const bf16x8 (&qr)[8], f32x16 (&o)[4], float& m_reg, float& l_reg, const LaneCtx& lc) {
    int tid_ = threadIdx.x; asm volatile("" : "+v"(tid_));
    const int tid = tid_, wid = __builtin_amdgcn_readfirstlane(tid >> 6), lane = tid & 63, r32 = lane & 31, hi = lane >> 5;
    LAS char* V_lds = lds; LAS char* K_lds = lds + 2 * SHM_V;
    LAS float* al_l = (LAS float*)(lds + OFF_WS) + wid * 128;
    LAS float* gtab = (LAS float*)(lds + OFF_GT);
    const int sr = tid >> 4, sc = (tid & 15) * 8, vst0 = v_st(sr, sc), vst1 = v_st(32 + sr, sc), kc = sc * 2;
    const int vb0 = (int)(unsigned)(uintptr_t)V_lds + v_rd_base(lane);
    bf16x8 ks0, ks1, vs0, vs1; float gst = 0.f;
#define SLOAD(k0) do { ks0 = *(const bf16x8*)(Kh + (size_t)((k0) + sr) * ldk + sc); ks1 = *(const bf16x8*)(Kh + (size_t)((k0) + 32 + sr) * ldk + sc); \
        vs0 = *(const bf16x8*)(Vh + (size_t)((k0) + sr) * ldv + sc); vs1 = *(const bf16x8*)(Vh + (size_t)((k0) + 32 + sr) * ldv + sc); \
        if (MODE == MD_MLSTM) { if (tid < 64) gst = Gk[(k0) + tid]; } } while (0)
#define SWRITE(b) do { *(LAS bf16x8*)(V_lds + (b) * SHM_V + vst0) = vs0; *(LAS bf16x8*)(V_lds + (b) * SHM_V + vst1) = vs1; \
        *(LAS bf16x8*)(K_lds + (b) * SHM_K + KSWZ(sr, kc)) = ks0; *(LAS bf16x8*)(K_lds + (b) * SHM_K + KSWZ(32 + sr, kc)) = ks1; \
        if (MODE == MD_MLSTM) { if (tid < 64) gtab[(b) * 64 + tid] = gst; } } while (0)
    if (tmask == 0u) return;
    unsigned rem = tmask; int j = __builtin_ctz(rem); rem &= rem - 1u;
    SLOAD(j * 64);
    int buf = 0;
    const int q0w = qb * 256 + wid * 32;
    constexpr float C1 = SCALE * LOG2E;
    for (;;) {
        VM_WAIT(); SWRITE(buf); __syncthreads();
        int jn = -1;
        if (rem) { jn = __builtin_ctz(rem); rem &= rem - 1u; SLOAD(jn * 64); }
        if ((wmask >> j) & 1u) {
            f32x16 p0, p1;
            qkt(p0, p1, K_lds + buf * SHM_K, qr, r32, hi);
            const int k0 = j * 64;
            const int base = lc.tq - k0 - 4 * hi;
            const float bias0 = -lc.slope2 * (float)base;
            if (MODE == MD_MOBA || MODE == MD_SEL || MODE == MD_WIN) {
                bool lane_ok = true, chk_c = false, chk_w = false;
                if (MODE == MD_MOBA) { const int blk = j >> 2; if (blk == qb) chk_c = (k0 + 63 > q0w); else lane_ok = (lc.qmask >> blk) & 1u; }
                if (MODE == MD_SEL) { lane_ok = (lc.qmask >> j) & 1u; chk_c = (k0 + 63 > q0w); }
                if (MODE == MD_WIN) { chk_c = (k0 + 63 > q0w); chk_w = (q0w + 31 - k0 >= 512); }
#pragma unroll
                for (int r = 0; r < 16; ++r) {
                    const int c0 = crc(r), c1 = crc(r) + 32;
                    float s0 = fmaf(p0[r], C1, fmaf(lc.slope2, (float)c0, bias0));
                    float s1 = fmaf(p1[r], C1, fmaf(lc.slope2, (float)c1, bias0));
                    bool v0 = lane_ok, v1 = lane_ok;
                    if (chk_c) { v0 = v0 && (c0 <= base); v1 = v1 && (c1 <= base); }
                    if (chk_w) { v0 = v0 && (base - c0 < 512); v1 = v1 && (base - c1 < 512); }
                    p0[r] = v0 ? s0 : -1e30f; p1[r] = v1 ? s1 : -1e30f;
                }
                float pmax = p0[0];
#pragma unroll
                for (int r = 1; r < 16; ++r) pmax = fmaxf(pmax, p0[r]);
#pragma unroll
                for (int r = 0; r < 16; ++r) pmax = fmaxf(pmax, p1[r]);
                pmax = swap_max(pmax);
                float mn, alpha; bool resc;
                if (__all(pmax - m_reg <= THR2)) { mn = m_reg; alpha = 1.f; resc = false; }
                else { mn = fmaxf(m_reg, pmax); alpha = __builtin_amdgcn_exp2f(m_reg - mn); m_reg = mn; resc = true; }
                float ps = 0.f;
#pragma unroll
                for (int r = 0; r < 16; ++r) { p0[r] = __builtin_amdgcn_exp2f(p0[r] - mn); p1[r] = __builtin_amdgcn_exp2f(p1[r] - mn); ps += p0[r] + p1[r]; }
                l_reg = l_reg * alpha + ps;
                if (resc) rescale_o(o, alpha, al_l, r32, hi);
            } else {
                const bool chk_c = (k0 + 63 > q0w);
                float ps = 0.f;
                if (MODE == MD_MLSTM) {
                    const LAS float* gt = gtab + buf * 64 + 4 * hi;
#pragma unroll
                    for (int a = 0; a < 4; ++a) {
                        const f32x4 g0 = *(const LAS f32x4*)(gt + 8 * a), g1 = *(const LAS f32x4*)(gt + 32 + 8 * a);
#pragma unroll
                        for (int i = 0; i < 4; ++i) { const int r = 4 * a + i; const int c0 = crc(r), c1 = crc(r) + 32;
                            float w0 = __builtin_amdgcn_exp2f(lc.a + g0[i]) * SCALE, w1 = __builtin_amdgcn_exp2f(lc.a + g1[i]) * SCALE;
                            if (chk_c) { w0 = (c0 <= base) ? w0 : 0.f; w1 = (c1 <= base) ? w1 : 0.f; }
                            p0[r] *= w0; p1[r] *= w1; ps += p0[r] + p1[r]; }
                    }
                    l_reg += ps;
                } else {
#pragma unroll
                    for (int r = 0; r < 16; ++r) { const int c0 = crc(r), c1 = crc(r) + 32;
                        float w0 = __builtin_amdgcn_exp2f(fmaf(lc.slope2, (float)c0, bias0)) * SCALE, w1 = __builtin_amdgcn_exp2f(fmaf(lc.slope2, (float)c1, bias0)) * SCALE;
                        if (chk_c) { w0 = (c0 <= base) ? w0 : 0.f; w1 = (c1 <= base) ? w1 : 0.f; }
                        p0[r] *= w0; p1[r] *= w1; }
                }
            }
            bf16x8 pa0, pa1, pa2, pa3;
            pack_p(p0, p1, pa0, pa1, pa2, pa3);
            pv_d0(o, vb0 + buf * SHM_V, pa0, pa1, pa2, pa3);
        }
        if (jn < 0) break;
        j = jn; buf ^= 1;
    }
    __syncthreads();
#undef SLOAD
#undef SWRITE
}

template <bool ACCUM = false>
__device__ __forceinline__ void store_o(const f32x16 (&o)[4], const float (&fr)[16], bf16* Yp, int ldy, int r32, int hi) {
    bf16* Yl = Yp + (size_t)(4 * hi) * ldy + r32;
#pragma unroll
    for (int r = 0; r < 16; ++r) { bf16* rowp = Yl; asm volatile("" : "+v"(rowp)); rowp += (size_t)crc(r) * ldy;
        float pv[4] = {0.f, 0.f, 0.f, 0.f};
        if (ACCUM) {
#pragma unroll
            for (int d = 0; d < 4; ++d) pv[d] = bf2f(rowp[d * 32]); }
#pragma unroll
        for (int d = 0; d < 4; ++d) rowp[d * 32] = (bf16)f2bf(o[d][r] * fr[r] + pv[d]); }
}
template <int GACT>
__device__ __forceinline__ void store_rms_gate(f32x16 (&o)[4], const float (&fr)[16], const float* __restrict__ gain, const bf16* __restrict__ gate, int ldg, bf16* Yp, int ldy, int r32, int hi) {
    float gn[4];
#pragma unroll
    for (int d = 0; d < 4; ++d) gn[d] = gain[d * 32 + r32];
    const bf16* Gl = gate + (size_t)(4 * hi) * ldg + r32; bf16* Yl = Yp + (size_t)(4 * hi) * ldy + r32;
#pragma unroll
    for (int r = 0; r < 16; ++r) {
        const bf16* gp = Gl; bf16* yp = Yl; asm volatile("" : "+v"(gp), "+v"(yp)); gp += (size_t)crc(r) * ldg; yp += (size_t)crc(r) * ldy;
        float gv[4];
#pragma unroll
        for (int d = 0; d < 4; ++d) gv[d] = bf2f(gp[d * 32]);
        float ss = 0.f;
#pragma unroll
        for (int d = 0; d < 4; ++d) { o[d][r] *= fr[r]; ss += o[d][r] * o[d][r]; }
#pragma unroll
        for (int x = 1; x < 32; x <<= 1) ss += __shfl_xor(ss, x);
        const float rn = __builtin_amdgcn_rsqf(ss * (1.0f / 128.0f) + EPS);
#pragma unroll
        for (int d = 0; d < 4; ++d) { const float ga = GACT == 0 ? sigmoid_f(gv[d]) : silu2_f(gv[d]);
            yp[d * 32] = (bf16)f2bf(o[d][r] * rn * gn[d] * ga); }
    }
}
__device__ __forceinline__ void load_q(bf16x8 (&qr)[8], const bf16* Qw) {
#pragma unroll
    for (int d0 = 0; d0 < 8; ++d0) qr[d0] = *(const bf16x8*)(Qw + d0 * 16);
}
__device__ __forceinline__ unsigned wave_or(unsigned m) {
#pragma unroll
    for (int x = 1; x < 64; x <<= 1) m |= (unsigned)__shfl_xor((int)m, x);
    return m;
}
__device__ __forceinline__ unsigned causal_tiles(int qlast) { const int n = (qlast >> 6) + 1; return n >= 32 ? 0xffffffffu : ((1u << n) - 1u); }
}
struct Args { const float* in[25]; float* out; unsigned char* ws; int ph_lo, ph_hi; };
typedef const __attribute__((address_space(4))) Args* KArgs;
struct Frame {
    LAS unsigned char* lds; volatile LAS unsigned* MISC; gu32* ctl;
    int tid, lane, wave, G, bx;
    unsigned char* ws; float* out;
};
#define WSP(T, off) ((T*)(F.ws + (off)))

__device__ __forceinline__ int maprow(int mode, int n, int arg) {
    if (mode == 0) return n + arg;
    if (mode == 1) {
        if (n < 2048) return n;
        if (n < 2056) return ZW + (n - 2048);
        if (n < 9224) return n - 8;
        return ZW + 8 + (n - 9224);
    }
    return ((n >> 7) << 8) + (n & 127) + arg;
}
__device__ __forceinline__ void tr_item(const float* __restrict__ W, int N, bf16* __restrict__ WT, int ldd, int koff, int mode, int arg, LAS float* scr, int item, int lane) {
    const int nblk = (N + 31) >> 5, kb = item / nblk, nb = item - kb * nblk, k0 = 64 * kb, n0 = 32 * nb;
    const int nn = n0 + (lane & 31); const bool nok = nn < N;
#pragma unroll 8
    for (int i = 0; i < 32; ++i) { const int kk = 2 * i + (lane >> 5); scr[kk * 33 + (lane & 31)] = nok ? W[(size_t)(k0 + kk) * N + nn] : 0.f; }
    LDS_WAIT(); asm volatile("" ::: "memory");
    const int c = lane & 7;
#pragma unroll
    for (int j = 0; j < 4; ++j) { const int n = (lane >> 3) + 8 * j; const LAS float* s = scr + (8 * c) * 33 + n;
        v4u o; o.x = pk2(s[0 * 33], s[1 * 33]); o.y = pk2(s[2 * 33], s[3 * 33]); o.z = pk2(s[4 * 33], s[5 * 33]); o.w = pk2(s[6 * 33], s[7 * 33]);
        if (n0 + n < N) *(GAS v4u*)(WT + (size_t)maprow(mode, n0 + n, arg) * ldd + koff + k0 + 8 * c) = o; }
    LDS_WAIT(); asm volatile("" ::: "memory");
}
__device__ __forceinline__ void mod_item(const float* __restrict__ cin, const float* __restrict__ aw, const float* __restrict__ ab, float* __restrict__ mod, int item, int lane) {
    const int l = item / 384, ch = item - l * 384, n0 = ch * 32, cg = lane & 7, rs = lane >> 3;
    const float* W = aw + (size_t)l * 2048 * 12288 + n0 + 4 * cg;
    f32x4 acc[8];
#pragma unroll
    for (int b = 0; b < 8; ++b) acc[b] = (f32x4){0.f, 0.f, 0.f, 0.f};
#pragma unroll 4
    for (int i = 0; i < 256; ++i) { const int k = rs + 8 * i;
        const f32x4 w = *(const f32x4*)(W + (size_t)k * 12288);
#pragma unroll
        for (int b = 0; b < 8; ++b) { const float cv = cin[b * 2048 + k]; const float s = silu2_f(cv); acc[b] += w * s; } }
#pragma unroll
    for (int b = 0; b < 8; ++b)
#pragma unroll
        for (int x = 8; x < 64; x <<= 1) { acc[b].x += __shfl_xor(acc[b].x, x); acc[b].y += __shfl_xor(acc[b].y, x); acc[b].z += __shfl_xor(acc[b].z, x); acc[b].w += __shfl_xor(acc[b].w, x); }
    if (rs == 0) { const f32x4 bv = *(const f32x4*)(ab + (size_t)l * 12288 + n0 + 4 * cg);
#pragma unroll
        for (int b = 0; b < 8; ++b) *(f32x4*)(mod + ((size_t)l * 8 + b) * 12288 + n0 + 4 * cg) = acc[b] + bv; }
}
__device__ __forceinline__ void p0_prologue(Frame& F, KArgs A) {
    LAS float* scr = (LAS float*)(F.lds + RING_OFF + F.wave * 8448);
    const int gw = F.bx * NWAVES + F.wave, NGW = F.G * NWAVES;
    constexpr int J1 = 32 * 289, J2 = 32 * 64, J3 = 8 * 64, J4 = 32 * 512, J5 = J4, J6 = 32 * 512, J7 = 2 * 256, J8 = 2 * 8, J9 = 64;
    constexpr int JL = J1 + J2 + J3 + J4 + J5 + J6 + J7 + J8 + J9;
    constexpr int N_CB = 8, N_MOD = 768, NITEMS = N_CB + N_MOD + 2 * JL;
    for (int it = gw; it < NITEMS; it += NGW) {
        int r = it;
        if (r < N_CB) {
            const int lk = r >> 1, e = (r & 1) * 64 + F.lane;
            const float* pe = A->in[14] + (size_t)lk * 4096; const float* w1 = A->in[15] + (size_t)lk * 4096 * 128 + e;
            float s = 0.f;
#pragma unroll 8
            for (int f = 0; f < 4096; ++f) s = fmaf(pe[f], w1[(size_t)f * 128], s);
            WSP(float, WS_CB1)[lk * 128 + e] = s; continue; }
        r -= N_CB;
        if (r < N_MOD) { mod_item(A->in[1], A->in[4], A->in[5], WSP(float, WS_MOD), r, F.lane); continue; }
        r -= N_MOD;
        const int l = r / JL; r -= l * JL;
        if (r < J1) { tr_item(A->in[6] + (size_t)l * 2048 * DIN, DIN, WSP(bf16, WS_WINT) + (size_t)l * NZP * 2048, 2048, 0, 1, 0, scr, r, F.lane); continue; } r -= J1;
        if (r < J2) { tr_item(A->in[17] + (size_t)l * 2048 * 2048, 2048, WSP(bf16, WS_WOUTT) + (size_t)l * 2048 * KO, KO, 0, 0, 0, scr, r, F.lane); continue; } r -= J2;
        if (r < J3) { tr_item(A->in[17] + (size_t)l * 2048 * 2048 + (size_t)1536 * 2048, 2048, WSP(bf16, WS_WOUTT) + (size_t)l * 2048 * KO, KO, 2048, 0, 0, scr, r, F.lane); continue; } r -= J3;
        if (r < J4) { const int e = r >> 9; tr_item(A->in[22] + ((size_t)l * NE + e) * 2048 * DE, DE, WSP(bf16, WS_W13T) + ((size_t)l * NE + e) * 1024 * 2048, 2048, 0, 2, 0, scr, r & 511, F.lane); continue; } r -= J4;
        if (r < J5) { const int e = r >> 9; tr_item(A->in[23] + ((size_t)l * NE + e) * 2048 * DE, DE, WSP(bf16, WS_W13T) + ((size_t)l * NE + e) * 1024 * 2048, 2048, 0, 2, 128, scr, r & 511, F.lane); continue; } r -= J5;
        if (r < J6) { const int e = r >> 9; tr_item(A->in[24] + ((size_t)l * NE + e) * DE * 2048, 2048, WSP(bf16, WS_W2T) + ((size_t)l * NE + e) * 2048 * DE, DE, 0, 0, 0, scr, r & 511, F.lane); continue; } r -= J6;
        if (r < J7) { const int kv = r >> 8; tr_item(A->in[15] + ((size_t)l * 2 + kv) * 4096 * 128, 128, WSP(bf16, WS_CW1T) + ((size_t)l * 2 + kv) * 128 * 4096, 4096, 0, 0, 0, scr, r & 255, F.lane); continue; } r -= J7;
        if (r < J8) { const int kv = r >> 3; tr_item(A->in[16] + ((size_t)l * 2 + kv) * 128 * 128, 128, WSP(bf16, WS_CW2T) + ((size_t)l * 2 + kv) * 128 * 128, 128, 0, 0, 0, scr, r & 7, F.lane); continue; } r -= J8;
        if (r < 32) { tr_item(A->in[18] + (size_t)l * 2048 * 4, 4, WSP(bf16, WS_RTT) + (size_t)l * 48 * 2048, 2048, 0, 0, 0, scr, r, F.lane); continue; } r -= 32;
        tr_item(A->in[20] + (size_t)l * 2048 * 32, 32, WSP(bf16, WS_RTT) + (size_t)l * 48 * 2048, 2048, 0, 0, 4, scr, r, F.lane);
    }
}

template <bool COMBINE, bool NORM>
__device__ __forceinline__ void norm_phase(Frame& F, const float* xin, float* xout, const float* gain, const float* modsh, const float* modsc, const float* modg2) {
    const int gw = F.bx * NWAVES + F.wave, NGW = F.G * NWAVES, lane = F.lane;
    bf16* HB = WSP(bf16, WS_HB);
    for (int m = gw; m < M; m += NGW) {
        const int b = m >> 11;
        const f32x4* xr = (const f32x4*)(xin + (size_t)m * D) + lane;
        f32x4 v[8];
#pragma unroll
        for (int j = 0; j < 8; ++j) v[j] = xr[64 * j];
        if (COMBINE) {
            const int sa = WSP(int, WS_TOKS)[2 * m], sb = WSP(int, WS_TOKS)[2 * m + 1];
            const float ga = WSP(float, WS_TOKG)[2 * m], gb = WSP(float, WS_TOKG)[2 * m + 1];
            const v2u* ya = (const v2u*)(WSP(bf16, WS_Y) + (size_t)sa * D) + lane; const v2u* yb = (const v2u*)(WSP(bf16, WS_Y) + (size_t)sb * D) + lane;
            const f32x4* g2 = (const f32x4*)(modg2 + (size_t)b * 12288) + lane;
            f32x4* xo = (f32x4*)(xout + (size_t)m * D) + lane;
#pragma unroll
            for (int j = 0; j < 8; ++j) { const v2u a = ya[64 * j], bb = yb[64 * j]; const f32x4 g = g2[64 * j];
                f32x4 y; y.x = ga * bflo(a.x) + gb * bflo(bb.x); y.y = ga * bfhi(a.x) + gb * bfhi(bb.x); y.z = ga * bflo(a.y) + gb * bflo(bb.y); y.w = ga * bfhi(a.y) + gb * bfhi(bb.y);
                v[j] = v[j] + g * y; xo[64 * j] = v[j]; }
        }
        if (NORM) {
            float ss = 0.f;
#pragma unroll
            for (int j = 0; j < 8; ++j) ss += (v[j].x * v[j].x + v[j].y * v[j].y) + (v[j].z * v[j].z + v[j].w * v[j].w);
            const float rstd = __builtin_amdgcn_rsqf(wave_sum(ss) * (1.0f / D) + EPS);
            const f32x4* gn = (const f32x4*)gain + lane; const f32x4* sc = (const f32x4*)(modsc + (size_t)b * 12288) + lane; const f32x4* sh = (const f32x4*)(modsh + (size_t)b * 12288) + lane;
            v2u* o8 = (v2u*)(HB + (size_t)m * D) + lane;
#pragma unroll
            for (int j = 0; j < 8; ++j) { const f32x4 g = gn[64 * j], s = sc[64 * j], h = sh[64 * j];
                const f32x4 y = v[j] * rstd * g * (s + 1.0f) + h;
                v2u w; w.x = pk2(y.x, y.y); w.y = pk2(y.z, y.w); o8[64 * j] = w; }
        }
    }
}

__device__ __forceinline__ float gelu_tanh(float x) { const float u = 0.7978845608028654f * (x + 0.044715f * x * x * x); const float e = __expf(2.0f * u); const float t = 1.0f - 2.0f * __builtin_amdgcn_rcpf(e + 1.0f); return 0.5f * x * (1.0f + t); }
__device__ __forceinline__ void compress_item(Frame& F, KArgs A, int l, int item) {
    const int b = item >> 3, h = (item >> 1) & 3, kv = item & 1, lane = F.lane, w = F.wave;
    const bf16* Z = WSP(bf16, WS_Z) + (size_t)b * T * ZW + (kv ? Z_NVC : Z_NKC) + h * HD;
    const bf16* W1 = WSP(bf16, WS_CW1T) + ((size_t)l * 2 + kv) * 128 * 4096;
    const bf16* W2 = WSP(bf16, WS_CW2T) + ((size_t)l * 2 + kv) * 128 * 128;
    const float* cb1 = WSP(float, WS_CB1) + (l * 2 + kv) * 128;
    const int lr = lane & 15, lq = lane >> 4;
    const int n = 16 * w + lr;
    f32x4 acc[8];
#pragma unroll
    for (int i = 0; i < 8; ++i) acc[i] = (f32x4){0.f, 0.f, 0.f, 0.f};
    for (int ks = 0; ks < 128; ++ks) {
        const int p = ks >> 2, d = (ks & 3) * 32 + 8 * lq; int tok = 16 * n + p; tok = tok > T - 1 ? T - 1 : tok;
        const bf16x8 a = *(const bf16x8*)(Z + (size_t)tok * ZW + d);
#pragma unroll
        for (int nt = 0; nt < 8; ++nt) { const bf16x8 bw = *(const bf16x8*)(W1 + (size_t)(nt * 16 + lr) * 4096 + ks * 32 + 8 * lq);
            acc[nt] = __builtin_amdgcn_mfma_f32_16x16x32_bf16(a, bw, acc[nt], 0, 0, 0); }
    }
    LAS bf16* hid = (LAS bf16*)(F.lds + att::OFF_HID + w * 4352);
#pragma unroll
    for (int nt = 0; nt < 8; ++nt) { const float bb = cb1[nt * 16 + lr];
#pragma unroll
        for (int g = 0; g < 4; ++g) hid[(4 * lq + g) * 136 + nt * 16 + lr] = (bf16)f2bf(gelu_tanh(acc[nt][g] + bb)); }
    LDS_WAIT(); asm volatile("" ::: "memory");
    f32x4 ac2[8];
#pragma unroll
    for (int i = 0; i < 8; ++i) ac2[i] = (f32x4){0.f, 0.f, 0.f, 0.f};
#pragma unroll
    for (int ks = 0; ks < 4; ++ks) { const bf16x8 a = *(const LAS bf16x8*)(hid + lr * 136 + ks * 32 + 8 * lq);
#pragma unroll
        for (int nt = 0; nt < 8; ++nt) { const bf16x8 bw = *(const bf16x8*)(W2 + (size_t)(nt * 16 + lr) * 128 + ks * 32 + 8 * lq);
            ac2[nt] = __builtin_amdgcn_mfma_f32_16x16x32_bf16(a, bw, ac2[nt], 0, 0, 0); } }
    LDS_WAIT();
    bf16* O = WSP(bf16, kv ? WS_VCMP : WS_KCMP) + (size_t)(b * 4 + h) * 128 * 128;
    float rn[4] = {1.f, 1.f, 1.f, 1.f};
    if (kv == 0) {
#pragma unroll
        for (int g = 0; g < 4; ++g) { float ss = 0.f;
#pragma unroll
            for (int nt = 0; nt < 8; ++nt) ss += ac2[nt][g] * ac2[nt][g];
#pragma unroll
            for (int x = 1; x < 16; x <<= 1) ss += __shfl_xor(ss, x);
            rn[g] = __builtin_amdgcn_rsqf(ss * (1.0f / 128.0f) + EPS); }
    }
    const float* kg = A->in[13] + (size_t)l * 3 * 128;
#pragma unroll
    for (int nt = 0; nt < 8; ++nt) { const float g0 = kv == 0 ? kg[nt * 16 + lr] : 1.0f;
#pragma unroll
        for (int g = 0; g < 4; ++g) O[(size_t)(16 * w + 4 * lq + g) * 128 + nt * 16 + lr] = (bf16)f2bf(ac2[nt][g] * rn[g] * g0); }
}
__device__ __forceinline__ void cumsum_item(Frame& F, KArgs A, int l, int b) {
    if (F.wave >= 4) return;
    const int h = F.wave, lane = F.lane;
    const float* Gt = WSP(float, WS_GT) + (size_t)b * T * 32;
    const float bi = A->in[7][(l * 2 + 0) * 4 + h], bf_ = A->in[7][(l * 2 + 1) * 4 + h];
    float lf[32]; float run = 0.f;
#pragma unroll
    for (int i = 0; i < 32; ++i) { const float x = Gt[(size_t)(lane * 32 + i) * 32 + 4 + h] + bf_;
        const float ls = fminf(x, 0.f) - log1pf(__expf(-fabsf(x))); run += ls; lf[i] = run; }
    float tot = run, inc = run;
#pragma unroll
    for (int x = 1; x < 64; x <<= 1) { const float t = __shfl_up(inc, x); if (lane >= x) inc += t; }
    const float excl = inc - tot;
    float* Fq = WSP(float, WS_FQ) + (size_t)(b * 4 + h) * T; float* Gk = WSP(float, WS_GK) + (size_t)(b * 4 + h) * T;
#pragma unroll
    for (int i = 0; i < 32; ++i) { const int t = lane * 32 + i; const float f = excl + lf[i]; const float ig = Gt[(size_t)t * 32 + h] + bi;
        Fq[t] = f * LOG2E; Gk[t] = (ig - f) * LOG2E; }
}
__device__ __forceinline__ void rms_seg(bf16* p, const float* __restrict__ g, int lane, float (&y)[8]) {
    const v4u w = *(const v4u*)(p + 8 * lane);
    float x[8] = {bflo(w.x), bfhi(w.x), bflo(w.y), bfhi(w.y), bflo(w.z), bfhi(w.z), bflo(w.w), bfhi(w.w)};
    float ss = 0.f;
#pragma unroll
    for (int i = 0; i < 8; ++i) ss += x[i] * x[i];
#pragma unroll
    for (int s = 1; s < 16; s <<= 1) ss += __shfl_xor(ss, s);
    const float rn = __builtin_amdgcn_rsqf(ss * (1.0f / 128.0f) + EPS);
    const f32x4 g0 = *(const f32x4*)(g + 8 * (lane & 15)), g1 = *(const f32x4*)(g + 8 * (lane & 15) + 4);
    y[0] = x[0] * rn * g0.x; y[1] = x[1] * rn * g0.y; y[2] = x[2] * rn * g0.z; y[3] = x[3] * rn * g0.w;
    y[4] = x[4] * rn * g1.x; y[5] = x[5] * rn * g1.y; y[6] = x[6] * rn * g1.z; y[7] = x[7] * rn * g1.w;
    v4u o; o.x = pk2(y[0], y[1]); o.y = pk2(y[2], y[3]); o.z = pk2(y[4], y[5]); o.w = pk2(y[6], y[7]);
    *(v4u*)(p + 8 * lane) = o;
}
__device__ __forceinline__ void token_item(Frame& F, KArgs A, int l, int item) {
    const int lane = F.lane, w = F.wave;
    const int m0 = item * 64 + w * 8, b = m0 >> 11, t0 = m0 & (T - 1);
    bf16* Z = WSP(bf16, WS_Z); bf16* QKM = WSP(bf16, WS_QKM);
    const float* cw = A->in[8] + (size_t)l * 4 * 1024;
    float wq[4][8], wk[4][8];
#pragma unroll
    for (int j = 0; j < 4; ++j)
#pragma unroll
        for (int i = 0; i < 8; ++i) { wq[j][i] = cw[j * 1024 + 8 * lane + i]; wk[j][i] = cw[j * 1024 + 512 + 8 * lane + i]; }
    float hq[3][8], hk[3][8];
#pragma unroll
    for (int j = 0; j < 3; ++j) { const int tt = t0 - 3 + j;
        if (tt >= 0) { const v4u a = *(const v4u*)(Z + (size_t)(m0 - 3 + j) * ZW + Z_MQ + 8 * lane), c = *(const v4u*)(Z + (size_t)(m0 - 3 + j) * ZW + Z_MK + 8 * lane);
            hq[j][0] = bflo(a.x); hq[j][1] = bfhi(a.x); hq[j][2] = bflo(a.y); hq[j][3] = bfhi(a.y); hq[j][4] = bflo(a.z); hq[j][5] = bfhi(a.z); hq[j][6] = bflo(a.w); hq[j][7] = bfhi(a.w);
            hk[j][0] = bflo(c.x); hk[j][1] = bfhi(c.x); hk[j][2] = bflo(c.y); hk[j][3] = bfhi(c.y); hk[j][4] = bflo(c.z); hk[j][5] = bfhi(c.z); hk[j][6] = bflo(c.w); hk[j][7] = bfhi(c.w); }
        else {
#pragma unroll
            for (int i = 0; i < 8; ++i) { hq[j][i] = 0.f; hk[j][i] = 0.f; } } }
    const float* g_bq = A->in[10] + (size_t)l * 256; const float* g_bk = g_bq + 128;
    const float* g_nq = A->in[12] + (size_t)l * 128; const float* g_nks = A->in[13] + (size_t)l * 384 + 128; const float* g_nkw = A->in[13] + (size_t)l * 384 + 256;
    float ksum[8];
#pragma unroll
    for (int i = 0; i < 8; ++i) ksum[i] = 0.f;
#pragma unroll 1
    for (int tk = 0; tk < 8; ++tk) {
        const int m = m0 + tk; bf16* zr = Z + (size_t)m * ZW;
        const v4u a = *(const v4u*)(zr + Z_MQ + 8 * lane), c = *(const v4u*)(zr + Z_MK + 8 * lane);
        float cq[8] = {bflo(a.x), bfhi(a.x), bflo(a.y), bfhi(a.y), bflo(a.z), bfhi(a.z), bflo(a.w), bfhi(a.w)};
        float ck[8] = {bflo(c.x), bfhi(c.x), bflo(c.y), bfhi(c.y), bflo(c.z), bfhi(c.z), bflo(c.w), bfhi(c.w)};
        float oq[8], ok[8];
#pragma unroll
        for (int i = 0; i < 8; ++i) { oq[i] = silu2_f(wq[0][i] * hq[0][i] + wq[1][i] * hq[1][i] + wq[2][i] * hq[2][i] + wq[3][i] * cq[i]);
            ok[i] = silu2_f(wk[0][i] * hk[0][i] + wk[1][i] * hk[1][i] + wk[2][i] * hk[2][i] + wk[3][i] * ck[i]);
            hq[0][i] = hq[1][i]; hq[1][i] = hq[2][i]; hq[2][i] = cq[i]; hk[0][i] = hk[1][i]; hk[1][i] = hk[2][i]; hk[2][i] = ck[i]; }
        v4u o; o.x = pk2(oq[0], oq[1]); o.y = pk2(oq[2], oq[3]); o.z = pk2(oq[4], oq[5]); o.w = pk2(oq[6], oq[7]);
        *(v4u*)(QKM + (size_t)m * 1024 + 8 * lane) = o;
        o.x = pk2(ok[0], ok[1]); o.y = pk2(ok[2], ok[3]); o.z = pk2(ok[4], ok[5]); o.w = pk2(ok[6], ok[7]);
        *(v4u*)(QKM + (size_t)m * 1024 + 512 + 8 * lane) = o;
        float y[8];
        rms_seg(zr + Z_BQ, g_bq, lane, y);
        rms_seg(zr + Z_BK, g_bk, lane, y);
#pragma unroll
        for (int i = 0; i < 8; ++i) ksum[i] += y[i];
        rms_seg(zr + Z_NQ, g_nq, lane, y);
        rms_seg(zr + Z_NKS, g_nks, lane, y);
        rms_seg(zr + Z_NKW, g_nkw, lane, y);
    }
    LAS float* ka = (LAS float*)(F.lds + RING_OFF);
#pragma unroll
    for (int i = 0; i < 8; ++i) ka[w * 512 + 8 * lane + i] = ksum[i];
    __syncthreads();
    { const int col = F.tid; float s = 0.f;
#pragma unroll
      for (int ww = 0; ww < 8; ++ww) s += ka[ww * 512 + col];
      const int t64 = (item * 64) & (T - 1), blk = t64 >> 8, sub = (t64 >> 6) & 3, h = col >> 7, d = col & 127;
      WSP(float, WS_KPART)[((((size_t)(item >> 5) * 4 + h) * 8 + blk) * 4 + sub) * 128 + d] = s; }
    __syncthreads();
}
__device__ __forceinline__ void prep_phase(Frame& F, KArgs A, int l) {
    constexpr int N_CMP = 64, N_CUM = 8, N_TOK = M / 64;
    if (EN2(0)) for (int it = F.bx; it < N_CMP; it += F.G) { compress_item(F, A, l, it); __syncthreads(); }
    if (EN2(1)) for (int it = F.bx - N_CMP; it < N_CUM; it += F.G) { if (it >= 0) cumsum_item(F, A, l, it); }
    if (EN2(2)) for (int it = F.G - 1 - F.bx; it < N_TOK; it += F.G) token_item(F, A, l, it);
}
__device__ __forceinline__ unsigned range_mask(int lo, int hi) {
    const unsigned a = hi >= 31 ? 0xffffffffu : ((1u << (hi + 1)) - 1u); return a & ~((1u << lo) - 1u);
}
#define ATT_IDS() int tid_ = threadIdx.x; asm volatile("" : "+v"(tid_)); const int tid = tid_, wid = __builtin_amdgcn_readfirstlane(tid >> 6), lane = tid & 63, r32 = lane & 31, hi = lane >> 5; (void)tid; (void)lane
template <int TYPE>
__device__ __forceinline__ void unit_linear(Frame& F, KArgs A, int l, int b, int h, int qb) {
    using namespace att; ATT_IDS();
    LAS char* lds = (LAS char*)F.lds;
    const int q0 = qb * 256, q0w = q0 + wid * 32;
    bf16* Z = WSP(bf16, WS_Z) + (size_t)b * T * ZW;
    const bf16* QKM = WSP(bf16, WS_QKM) + (size_t)b * T * 1024;
    bf16x8 qr[8]; LaneCtx lc; lc.tq = q0w + r32; lc.qmask = 0u; lc.a = 0.f; lc.slope2 = 0.f;
    const bf16 *Kh, *Vh; int ldk; const float* Gk = nullptr;
    if (TYPE == 0) { load_q(qr, QKM + (size_t)lc.tq * 1024 + h * HD + hi * 8); Kh = QKM + 512 + h * HD; ldk = 1024; Vh = Z + Z_MV + h * HD;
        Gk = WSP(float, WS_GK) + (size_t)(b * 4 + h) * T; lc.a = WSP(float, WS_FQ)[(size_t)(b * 4 + h) * T + lc.tq]; }
    else { load_q(qr, Z + (size_t)lc.tq * ZW + Z_RQ + h * HD + hi * 8); Kh = Z + Z_RK + h * HD; ldk = ZW; Vh = Z + Z_RV + h * HD;
        lc.slope2 = -log2f(1.0f - exp2f(-5.0f - (float)h)); }
    f32x16 o[4] = {}; float m_reg = -1e29f, l_reg = 0.f;
    const unsigned tmask = causal_tiles(q0 + 255), wmask = causal_tiles(q0w + 31);
    attn_pass<TYPE == 0 ? MD_MLSTM : MD_RET>(lds, Kh, ldk, Vh, ZW, Gk, tmask, wmask, qb, qr, o, m_reg, l_reg, lc);
    LAS float* sl = (LAS float*)(lds + OFF_WS) + wid * 128 + 64;
    float fr[16];
    if (TYPE == 0) { const float den = l_reg + __shfl_xor(l_reg, 32); const float inv = __builtin_amdgcn_rcpf(fmaxf(fabsf(den), 1.0f)); row_bcast(inv, fr, sl, r32, hi); }
    else {
#pragma unroll
        for (int r = 0; r < 16; ++r) fr[r] = 1.0f; }
    bf16* Yp = WSP(bf16, WS_YCAT) + ((size_t)b * T + q0w) * KO + (TYPE == 0 ? 0 : 1024) + h * HD;
    const bf16* gate = Z + (size_t)q0w * ZW + (TYPE == 0 ? Z_MO : Z_RG) + h * HD;
    const float* gain = (TYPE == 0 ? A->in[9] : A->in[11]) + (size_t)l * HD;
    store_rms_gate<TYPE == 0 ? 0 : 1>(o, fr, gain, gate, ZW, Yp, KO, r32, hi);
}
__device__ __forceinline__ void unit_moba(Frame& F, KArgs A, int l, int b, int h, int qb) {
    using namespace att; ATT_IDS();
    LAS char* lds = (LAS char*)F.lds;
    const int q0 = qb * 256, q0w = q0 + wid * 32;
    const bf16* Z = WSP(bf16, WS_Z) + (size_t)b * T * ZW;
    bf16x8 qr[8]; LaneCtx lc; lc.tq = q0w + r32; lc.a = 0.f; lc.slope2 = exp2f(-(float)(2 * h + 1)) * LOG2E; lc.qmask = 0u;
    load_q(qr, Z + (size_t)lc.tq * ZW + Z_BQ + h * HD + hi * 8);
    LAS float* km = (LAS float*)(lds + OFF_KM); LAS unsigned* un = (LAS unsigned*)(lds + OFF_UN);
    const float* kp = WSP(float, WS_KPART) + (size_t)(b * 4 + h) * 8 * 4 * 128;
    for (int idx = tid; idx < qb * 128; idx += NTHR) { const int blk = idx >> 7, d = idx & 127; const float* p = kp + (size_t)blk * 512 + d;
        km[idx] = ((p[0] + p[128]) + (p[256] + p[384])) * (1.0f / 256.0f); }
    if (tid == 0) un[0] = 0u;
    __syncthreads();
    float gv[7];
#pragma unroll
    for (int blk = 0; blk < 7; ++blk) { float g = 0.f;
        if (blk < qb) {
#pragma unroll
            for (int d0 = 0; d0 < 8; ++d0) { const f32x4 k0 = *(const LAS f32x4*)(km + blk * 128 + d0 * 16 + hi * 8), k1 = *(const LAS f32x4*)(km + blk * 128 + d0 * 16 + hi * 8 + 4);
                g += bf2f((bf16)qr[d0][0]) * k0.x + bf2f((bf16)qr[d0][1]) * k0.y + bf2f((bf16)qr[d0][2]) * k0.z + bf2f((bf16)qr[d0][3]) * k0.w
                   + bf2f((bf16)qr[d0][4]) * k1.x + bf2f((bf16)qr[d0][5]) * k1.y + bf2f((bf16)qr[d0][6]) * k1.z + bf2f((bf16)qr[d0][7]) * k1.w; }
            g += __shfl_xor(g, 32); }
        gv[blk] = g; }
    unsigned sel = 0u;
#pragma unroll
    for (int pass = 0; pass < 3; ++pass) { float best = -3.0e38f; int bi = -1;
#pragma unroll
        for (int blk = 0; blk < 7; ++blk) if (blk < qb && !((sel >> blk) & 1u) && gv[blk] > best) { best = gv[blk]; bi = blk; }
        if (bi >= 0) sel |= 1u << bi; }
    lc.qmask = sel;
    const unsigned wsel = wave_or(sel);
    if (lane == 0 && wsel) __hip_atomic_fetch_or(un, wsel, __ATOMIC_RELAXED, __HIP_MEMORY_SCOPE_WORKGROUP);
    __syncthreads();
    const unsigned usel = un[0];
    unsigned tmask = 0xFu << (4 * qb), wmask = causal_tiles(q0w + 31) & (0xFu << (4 * qb));
#pragma unroll
    for (int blk = 0; blk < 7; ++blk) { if ((usel >> blk) & 1u) tmask |= 0xFu << (4 * blk); if ((wsel >> blk) & 1u) wmask |= 0xFu << (4 * blk); }
    f32x16 o[4] = {}; float m_reg = -1e29f, l_reg = 0.f;
    attn_pass<MD_MOBA>(lds, Z + Z_BK + h * HD, ZW, Z + Z_BV + h * HD, ZW, nullptr, tmask, wmask, qb, qr, o, m_reg, l_reg, lc);
    LAS float* sl = (LAS float*)(lds + OFF_WS) + wid * 128 + 64;
    const float lsum = l_reg + __shfl_xor(l_reg, 32);
    float fr[16]; row_bcast(__builtin_amdgcn_rcpf(lsum), fr, sl, r32, hi);
    store_o(o, fr, WSP(bf16, WS_YCAT) + ((size_t)b * T + q0w) * KO + 512 + h * HD, KO, r32, hi);
}
__device__ __forceinline__ void unit_nsa_win(Frame& F, KArgs A, int l, int b, int h, int qb) {
    using namespace att; ATT_IDS();
    LAS char* lds = (LAS char*)F.lds;
    const int q0 = qb * 256, q0w = q0 + wid * 32;
    const bf16* Z = WSP(bf16, WS_Z) + (size_t)b * T * ZW;
    bf16x8 qr[8]; LaneCtx lc; lc.tq = q0w + r32; lc.a = 0.f; lc.slope2 = exp2f(-(float)(2 * h + 2)) * LOG2E; lc.qmask = 0u;
    load_q(qr, Z + (size_t)lc.tq * ZW + Z_NQ + h * HD + hi * 8);
    const int tlo = q0 >= 511 ? (q0 - 511) >> 6 : 0, wlo = q0w >= 511 ? (q0w - 511) >> 6 : 0;
    const unsigned tmask = range_mask(tlo, (q0 + 255) >> 6), wmask = range_mask(wlo, (q0w + 31) >> 6);
    f32x16 o[4] = {}; float m_reg = -1e29f, l_reg = 0.f;
    attn_pass<MD_WIN>(lds, Z + Z_NKW + h * HD, ZW, Z + Z_NVW + h * HD, ZW, nullptr, tmask, wmask, qb, qr, o, m_reg, l_reg, lc);
    LAS float* sl = (LAS float*)(lds + OFF_WS) + wid * 128 + 64;
    const float lsum = l_reg + __shfl_xor(l_reg, 32);
    const float g2 = sigmoid_f(WSP(float, WS_GT)[((size_t)b * T + lc.tq) * 32 + 8 + 2 * 4 + h]);
    float fr[16]; row_bcast(g2 * __builtin_amdgcn_rcpf(lsum), fr, sl, r32, hi);
    store_o(o, fr, WSP(bf16, WS_YCAT) + ((size_t)b * T + q0w) * KO + 2048 + h * HD, KO, r32, hi);
}
__device__ __forceinline__ void unit_nsa_cs(Frame& F, KArgs A, int l, int b, int h, int qb) {
    using namespace att; ATT_IDS();
    LAS char* lds = (LAS char*)F.lds;
    const int q0 = qb * 256, q0w = q0 + wid * 32;
    const bf16* Z = WSP(bf16, WS_Z) + (size_t)b * T * ZW;
    bf16x8 qr[8]; LaneCtx lc; lc.tq = q0w + r32; lc.a = 0.f; lc.slope2 = exp2f(-(float)(2 * h + 2)) * LOG2E; lc.qmask = 0u;
    load_q(qr, Z + (size_t)lc.tq * ZW + Z_NQ + h * HD + hi * 8);
    LAS char* V_lds = lds; LAS char* K_lds = lds + 2 * SHM_V; LAS unsigned* un = (LAS unsigned*)(lds + OFF_UN);
    LAS float* sl = (LAS float*)(lds + OFF_WS) + wid * 128 + 64;
    const float* gt = WSP(float, WS_GT) + ((size_t)b * T + lc.tq) * 32 + 8 + h;
    const float g0 = sigmoid_f(gt[0]), g1 = sigmoid_f(gt[4]);
    f32x16 o[4] = {};
    bf16* Yn = WSP(bf16, WS_YCAT) + ((size_t)b * T + q0w) * KO + 1536 + h * HD;
    {
        const bf16* Kc = WSP(bf16, WS_KCMP) + (size_t)(b * 4 + h) * 128 * 128; const bf16* Vc = WSP(bf16, WS_VCMP) + (size_t)(b * 4 + h) * 128 * 128;
        const int sr = tid >> 4, sc = (tid & 15) * 8, vst0 = v_st(sr, sc), vst1 = v_st(32 + sr, sc), kc = sc * 2;
        if (tid == 0) un[0] = 0u;
#pragma unroll
        for (int t2 = 0; t2 < 2; ++t2) {
            const bf16x8 ks0 = *(const bf16x8*)(Kc + (size_t)(t2 * 64 + sr) * 128 + sc), ks1 = *(const bf16x8*)(Kc + (size_t)(t2 * 64 + 32 + sr) * 128 + sc);
            const bf16x8 vs0 = *(const bf16x8*)(Vc + (size_t)(t2 * 64 + sr) * 128 + sc), vs1 = *(const bf16x8*)(Vc + (size_t)(t2 * 64 + 32 + sr) * 128 + sc);
            *(LAS bf16x8*)(V_lds + t2 * SHM_V + vst0) = vs0; *(LAS bf16x8*)(V_lds + t2 * SHM_V + vst1) = vs1;
            *(LAS bf16x8*)(K_lds + t2 * SHM_K + KSWZ(sr, kc)) = ks0; *(LAS bf16x8*)(K_lds + t2 * SHM_K + KSWZ(32 + sr, kc)) = ks1; }
        __syncthreads();
        f32x16 sA0, sA1, sB0, sB1;
        qkt(sA0, sA1, K_lds, qr, r32, hi); qkt(sB0, sB1, K_lds + SHM_K, qr, r32, hi);
        constexpr float C1 = SCALE * LOG2E;
        const int basec = lc.tq - 31 - 64 * hi;
        const float biasc = -lc.slope2 * (float)basec;
        float mx = -1e30f;
#pragma unroll
        for (int r = 0; r < 16; ++r) { const int c = crc(r);
            const float s0 = fmaf(sA0[r], C1, fmaf(lc.slope2, 16.0f * (float)c, biasc)), s1 = fmaf(sA1[r], C1, fmaf(lc.slope2, 16.0f * (float)(c + 32), biasc));
            const float s2 = fmaf(sB0[r], C1, fmaf(lc.slope2, 16.0f * (float)(c + 64), biasc)), s3 = fmaf(sB1[r], C1, fmaf(lc.slope2, 16.0f * (float)(c + 96), biasc));
            sA0[r] = (16 * c <= basec) ? s0 : -1e30f; sA1[r] = (16 * (c + 32) <= basec) ? s1 : -1e30f;
            sB0[r] = (16 * (c + 64) <= basec) ? s2 : -1e30f; sB1[r] = (16 * (c + 96) <= basec && (c + 96 + 4 * hi) < 127) ? s3 : -1e30f;
            mx = fmaxf(fmaxf(mx, fmaxf(sA0[r], sA1[r])), fmaxf(sB0[r], sB1[r])); }
        mx = fmaxf(swap_max(mx), -1e29f);
        float ps = 0.f;
#pragma unroll
        for (int r = 0; r < 16; ++r) { sA0[r] = __builtin_amdgcn_exp2f(sA0[r] - mx); sA1[r] = __builtin_amdgcn_exp2f(sA1[r] - mx); sB0[r] = __builtin_amdgcn_exp2f(sB0[r] - mx); sB1[r] = __builtin_amdgcn_exp2f(sB1[r] - mx);
            ps += (sA0[r] + sA1[r]) + (sB0[r] + sB1[r]); }
        const float lc_sum = swap_sum(ps);
        const int vb0 = (int)(unsigned)(uintptr_t)V_lds + v_rd_base(lane);
        float Gs[16], last[16];
#pragma unroll
        for (int a = 0; a < 4; ++a) {
            Gs[a] = (sA0[4 * a] + sA0[4 * a + 1]) + (sA0[4 * a + 2] + sA0[4 * a + 3]); last[a] = sA0[4 * a + 3];
            Gs[4 + a] = (sA1[4 * a] + sA1[4 * a + 1]) + (sA1[4 * a + 2] + sA1[4 * a + 3]); last[4 + a] = sA1[4 * a + 3];
            Gs[8 + a] = (sB0[4 * a] + sB0[4 * a + 1]) + (sB0[4 * a + 2] + sB0[4 * a + 3]); last[8 + a] = sB0[4 * a + 3];
            Gs[12 + a] = (sB1[4 * a] + sB1[4 * a + 1]) + (sB1[4 * a + 2] + sB1[4 * a + 3]); last[12 + a] = sB1[4 * a + 3]; }
        bf16x8 pA0, pA1, pA2, pA3, pB0, pB1, pB2, pB3;
        pack_p(sA0, sA1, pA0, pA1, pA2, pA3); pack_p(sB0, sB1, pB0, pB1, pB2, pB3);
        asm volatile("" : "+v"(pA0), "+v"(pA1), "+v"(pA2), "+v"(pA3), "+v"(pB0), "+v"(pB1), "+v"(pB2), "+v"(pB3));
        const int cur = lc.tq >> 6;
        float val[16]; float prevo = 0.f;
#pragma unroll
        for (int i = 0; i < 16; ++i) { const float ol = __shfl_xor(last[i], 32); const float add = hi ? ol : prevo; prevo = ol;
            val[i] = (2 * i + hi < cur) ? (Gs[i] + add) : -1.0f; }
        float cv[6]; int cj[6];
#pragma unroll
        for (int pass = 0; pass < 3; ++pass) { float best = -0.5f; int bi = 64;
#pragma unroll
            for (int i = 0; i < 16; ++i) if (val[i] > best) { best = val[i]; bi = 2 * i + hi; }
            cv[pass] = bi < 64 ? best : -1.0f; cj[pass] = bi;
#pragma unroll
            for (int i = 0; i < 16; ++i) if (2 * i + hi == bi) val[i] = -2.0f; }
#pragma unroll
        for (int k = 0; k < 3; ++k) { cv[3 + k] = __shfl_xor(cv[k], 32); cj[3 + k] = __shfl_xor(cj[k], 32); }
        unsigned sel = 0u;
#pragma unroll
        for (int pass = 0; pass < 3; ++pass) { float best = -0.5f; int bj = 64;
#pragma unroll
            for (int k = 0; k < 6; ++k) if (cv[k] > best || (cv[k] == best && cv[k] >= 0.f && cj[k] < bj)) { best = cv[k]; bj = cj[k]; }
            if (bj < 64) { sel |= 1u << bj;
#pragma unroll
                for (int k = 0; k < 6; ++k) if (cj[k] == bj) cv[k] = -2.0f; } }
        lc.qmask = sel | (1u << cur);
        pv_d0(o, vb0, pA0, pA1, pA2, pA3); pv_d0(o, vb0 + SHM_V, pB0, pB1, pB2, pB3);
        float fr[16]; row_bcast(lc_sum > 0.f ? g0 * __builtin_amdgcn_rcpf(lc_sum) : 0.f, fr, sl, r32, hi);
        store_o(o, fr, Yn, KO, r32, hi);
    }
    const unsigned wsel = wave_or(lc.qmask);
    if (lane == 0) __hip_atomic_fetch_or(un, wsel, __ATOMIC_RELAXED, __HIP_MEMORY_SCOPE_WORKGROUP);
    __syncthreads();
    const unsigned usel = un[0];
#pragma unroll
    for (int d = 0; d < 4; ++d) o[d] = f32x16{};
    float m_reg = -1e29f, l_reg = 0.f;
    attn_pass<MD_SEL>(lds, Z + Z_NKS + h * HD, ZW, Z + Z_NVS + h * HD, ZW, nullptr, usel, wsel, qb, qr, o, m_reg, l_reg, lc);
    const float lsum = l_reg + __shfl_xor(l_reg, 32);
    float fr[16]; row_bcast(g1 * __builtin_amdgcn_rcpf(lsum), fr, sl, r32, hi);
    store_o<true>(o, fr, Yn, KO, r32, hi);
}
#define MIXER_QUEUE(kind, CALL) do { for (;;) { __syncthreads(); \
        if (F.tid == 0) uq[0] = (int)__hip_atomic_fetch_add((unsigned*)(F.ctl + CW_QUEUE + 64 * (l * 8 + (kind))), 1u, RLX_AGENT); \
        __syncthreads(); const int u = __builtin_amdgcn_readfirstlane(uq[0]); if (u >= 256) break; \
        const int qb = 7 - (u >> 5), bh = u & 31, b = bh >> 2, h = bh & 3; CALL; } } while (0)
__device__ __forceinline__ void mixer_phase(Frame& F, KArgs A, int l) {
    LAS int* uq = (LAS int*)(F.lds + att::OFF_UN + 64);
    if (EN2(3)) MIXER_QUEUE(0, unit_linear<0>(F, A, l, b, h, qb));
    if (EN2(4)) MIXER_QUEUE(1, unit_moba(F, A, l, b, h, qb));
    if (EN2(5)) MIXER_QUEUE(2, unit_linear<2>(F, A, l, b, h, qb));
    if (EN2(6)) MIXER_QUEUE(3, unit_nsa_cs(F, A, l, b, h, qb));
    if (EN2(7)) MIXER_QUEUE(4, unit_nsa_win(F, A, l, b, h, qb));
}
__device__ __forceinline__ void router_phase(Frame& F, KArgs A, int l) {
    const int lane = F.lane, w = F.wave, lr = lane & 15, lq = lane >> 4;
    LAS float* lg = (LAS float*)(F.lds) + w * 16 * 52;
    LAS int* hist = (LAS int*)(F.lds + 32768);
    const bf16* HB = WSP(bf16, WS_HB); const bf16* RT = WSP(bf16, WS_RTT) + (size_t)l * 48 * 2048;
    const float* bg = A->in[19] + l * 4; const float* be = A->in[21] + l * 32;
    for (int grp = F.bx; grp < M / 64; grp += F.G) {
        if (F.tid < 64) hist[F.tid] = 0;
        __syncthreads();
        int e0 = 0, e1 = 0, p0 = 0, p1 = 0; float ga = 0.f, gb = 0.f;
        const int t0 = grp * 64 + w * 16;
        if (w < 4) {
            f32x4 acc[3];
#pragma unroll
            for (int i = 0; i < 3; ++i) acc[i] = (f32x4){0.f, 0.f, 0.f, 0.f};
#pragma unroll 4
            for (int ks = 0; ks < 64; ++ks) { const bf16x8 a = *(const bf16x8*)(HB + (size_t)(t0 + lr) * D + ks * 32 + 8 * lq);
#pragma unroll
                for (int nt = 0; nt < 3; ++nt) { const bf16x8 bw = *(const bf16x8*)(RT + (size_t)(nt * 16 + lr) * D + ks * 32 + 8 * lq);
                    acc[nt] = __builtin_amdgcn_mfma_f32_16x16x32_bf16(a, bw, acc[nt], 0, 0, 0); } }
#pragma unroll
            for (int nt = 0; nt < 3; ++nt)
#pragma unroll
                for (int g = 0; g < 4; ++g) lg[(4 * lq + g) * 52 + nt * 16 + lr] = acc[nt][g];
            LDS_WAIT(); asm volatile("" ::: "memory");
            if (lane < 16) {
                const LAS float* row = lg + lane * 52;
                float g4[4]; int gi = 0; float gm = -3.0e38f;
#pragma unroll
                for (int i = 0; i < 4; ++i) { g4[i] = row[i] + bg[i]; if (g4[i] > gm) { gm = g4[i]; gi = i; } }
                float gs = 0.f;
#pragma unroll
                for (int i = 0; i < 4; ++i) gs += __expf(g4[i] - gm);
                const float pgrp = 1.0f / gs;
                float la = -3.0e38f, lb = -3.0e38f; int ia = 0, ib = 0;
#pragma unroll
                for (int i = 0; i < 8; ++i) { const float v = row[4 + gi * 8 + i] + be[gi * 8 + i];
                    if (v > la) { lb = la; ib = ia; la = v; ia = i; } else if (v > lb) { lb = v; ib = i; } }
                const float eb = __expf(lb - la), inv = 1.0f / (1.0f + eb);
                ga = pgrp * inv; gb = pgrp * eb * inv; e0 = gi * 8 + ia; e1 = gi * 8 + ib;
                p0 = __hip_atomic_fetch_add(hist + e0, 1, __ATOMIC_RELAXED, __HIP_MEMORY_SCOPE_WORKGROUP);
                p1 = __hip_atomic_fetch_add(hist + e1, 1, __ATOMIC_RELAXED, __HIP_MEMORY_SCOPE_WORKGROUP);
            }
        }
        __syncthreads();
        if (F.tid < 32) { const int c = hist[F.tid]; int base = 0; if (c) base = (int)__hip_atomic_fetch_add((unsigned*)(F.ctl + CW_CNT + l * 32 + F.tid), (unsigned)c, RLX_AGENT); hist[32 + F.tid] = base; }
        __syncthreads();
        if (w < 4 && lane < 16) { const int m = t0 + lane;
            WSP(int, WS_TOKE)[2 * m] = e0; WSP(int, WS_TOKE)[2 * m + 1] = e1;
            WSP(int, WS_TOKP)[2 * m] = hist[32 + e0] + p0; WSP(int, WS_TOKP)[2 * m + 1] = hist[32 + e1] + p1;
            WSP(float, WS_TOKG)[2 * m] = ga; WSP(float, WS_TOKG)[2 * m + 1] = gb; }
        __syncthreads();
    }
}
__device__ __forceinline__ void expert_starts(Frame& F, int l, LAS int* st, int shift) {
    if (F.tid == 0) { int run = 0;
        for (int e = 0; e < NE; ++e) { st[e] = run; const int c = (int)__hip_atomic_load(F.ctl + CW_CNT + l * 32 + e, RLX_AGENT); run += ((c + 255) >> 8) << (8 - shift); }
        st[NE] = run; }
    __syncthreads();
}
__device__ __forceinline__ void scatter_phase(Frame& F, int l) {
    LAS int* st = (LAS int*)(F.lds + LDSCTL_OFF);
    expert_starts(F, l, st, 0);
    const int gw = F.bx * NWAVES + F.wave, NGW = F.G * NWAVES, lane = F.lane;
    const bf16* HB = WSP(bf16, WS_HB); bf16* XS = WSP(bf16, WS_XS);
    for (int m = gw; m < M; m += NGW) {
        const int e0 = WSP(int, WS_TOKE)[2 * m], e1 = WSP(int, WS_TOKE)[2 * m + 1];
        const int s0 = st[e0] + WSP(int, WS_TOKP)[2 * m], s1 = st[e1] + WSP(int, WS_TOKP)[2 * m + 1];
        const v4u* src = (const v4u*)(HB + (size_t)m * D) + lane; v4u* d0 = (v4u*)(XS + (size_t)s0 * D) + lane; v4u* d1 = (v4u*)(XS + (size_t)s1 * D) + lane;
#pragma unroll
        for (int j = 0; j < 4; ++j) { const v4u v = src[64 * j]; d0[64 * j] = v; d1[64 * j] = v; }
        if (lane == 0) { WSP(int, WS_TOKS)[2 * m] = s0; WSP(int, WS_TOKS)[2 * m + 1] = s1; }
    }
    __syncthreads();
}

constexpr int NPHASE = 22;
#ifndef PH_MASK
#define PH_MASK 0xFFFFu
#endif
#define EN(j) ((PH_MASK >> (j)) & 1u)
#define SITE_FRAME() KArgs A = (KArgs)__builtin_amdgcn_kernarg_segment_ptr(); asm volatile("" : "+s"(A)); Frame F; \
    F.lds = (LAS unsigned char*)lds; F.MISC = (volatile LAS unsigned*)(F.lds + MISC_OFF); F.tid = threadIdx.x; asm volatile("" : "+v"(F.tid)); F.lane = F.tid & 63; F.wave = __builtin_amdgcn_readfirstlane(F.tid >> 6); \
    F.G = gridDim.x; F.bx = blockIdx.x; F.ws = A->ws; F.out = A->out; F.ctl = (gu32*)(F.ws + WS_CTL)
__global__ void __launch_bounds__(NTHR, 2) fwd_kernel(Args args) {
    extern __shared__ __attribute__((aligned(16))) unsigned char lds[];
    int lo, hi;
    {
        SITE_FRAME();
        for (int u = F.tid; u < (LDS_BYTES - LDSCTL_OFF) / 4; u += NTHR) ((LAS unsigned*)(F.lds + LDSCTL_OFF))[u] = 0u;
        __syncthreads();
        lo = A->ph_lo; hi = A->ph_hi;
        if (hi - lo > 1) (void)xcd_barrier_post((unsigned*)(F.ctl + CW_BAR), F.MISC + 8);
    }
#define IN(k) (lo <= (k) && (k) < hi)
#define SEAM(k) do { if (IN(k) && IN((k) + 1)) { SITE_FRAME(); XcdBarrier bar; bar.bar = (unsigned*)(F.ctl + CW_BAR); bar.x = xb_xcc_id(); bar.st = F.MISC + 8; xcd_barrier(bar); } } while (0)
    if (EN(10) && IN(0)) { SITE_FRAME(); p0_prologue(F, A); __syncthreads(); }
    SEAM(0);
    for (int l = 0; l < NL; ++l) {
        const int pb = 1 + 10 * l;
        if (EN(0) && IN(pb + 0)) {
            SITE_FRAME(); const float* modl = WSP(float, WS_MOD) + (size_t)l * 8 * 12288;
            if (l == 0) norm_phase<false, true>(F, A->in[0], nullptr, A->in[2], modl, modl + 2048, nullptr);
            else norm_phase<true, true>(F, F.out, F.out, A->in[2] + (size_t)l * D, modl, modl + 2048, modl - 8 * 12288 + 5 * 2048);
        }
        SEAM(pb + 0);
        if (EN(1) && IN(pb + 1)) {
            SITE_FRAME();
            pg8::Gemm g{WSP(bf16, WS_HB), WSP(bf16, WS_WINT) + (size_t)l * NZP * 2048, M, NZP, D}; pg8::StaticOrder S; S.init(M, NZP, F.G, F.bx);
            pg8::EpiZ E{WSP(bf16, WS_Z), WSP(float, WS_GT)};
            pg8::gemm_phase<pg8::EpiZ, pg8::StaticOrder, true, true>(F.lds + RING_OFF, g, S, E);
        }
        SEAM(pb + 1);
        if (EN(2) && IN(pb + 2)) { SITE_FRAME(); prep_phase(F, A, l); }
        SEAM(pb + 2);
        if (EN(3) && IN(pb + 3)) { SITE_FRAME(); mixer_phase(F, A, l); }
        SEAM(pb + 3);
        if (EN(4) && IN(pb + 4)) {
            SITE_FRAME(); const float* modl = WSP(float, WS_MOD) + (size_t)l * 8 * 12288;
            pg8::Gemm g{WSP(bf16, WS_YCAT), WSP(bf16, WS_WOUTT) + (size_t)l * 2048 * KO, M, D, KO}; pg8::StaticOrder S; S.init(M, D, F.G, F.bx);
            pg8::EpiX1 E{l == 0 ? A->in[0] : (const float*)F.out, F.out, modl + 2 * 2048};
            pg8::gemm_phase<pg8::EpiX1, pg8::StaticOrder, true, true>(F.lds + RING_OFF, g, S, E);
        }
        SEAM(pb + 4);
        if (EN(5) && IN(pb + 5)) { SITE_FRAME(); const float* modl = WSP(float, WS_MOD) + (size_t)l * 8 * 12288;
            norm_phase<false, true>(F, F.out, nullptr, A->in[3] + (size_t)l * D, modl + 3 * 2048, modl + 4 * 2048, nullptr); }
        SEAM(pb + 5);
        if (EN(6) && IN(pb + 6)) { SITE_FRAME(); router_phase(F, A, l); }
        SEAM(pb + 6);
        if (EN(7) && IN(pb + 7)) { SITE_FRAME(); scatter_phase(F, l); }
        SEAM(pb + 7);
        if (EN(8) && IN(pb + 8)) {
            SITE_FRAME();
            LAS int* st = (LAS int*)(F.lds + LDSCTL_OFF); expert_starts(F, l, st, 8);
            const int nrt = st[NE];
            pg8::Gemm g{WSP(bf16, WS_XS), WSP(bf16, WS_W13T) + (size_t)l * NE * 1024 * 2048, SLOTS, NE * 1024, D};
            pg8::GroupedOrder S{nrt * 4, 4, F.G, F.bx, (const LAS int*)st};
            pg8::EpiH E{WSP(bf16, WS_HBUF)};
            pg8::gemm_phase<pg8::EpiH, pg8::GroupedOrder, true, true>(F.lds + RING_OFF, g, S, E);
            __syncthreads();
        }
        SEAM(pb + 8);
        if (EN(9) && IN(pb + 9)) {
            SITE_FRAME();
            LAS int* st = (LAS int*)(F.lds + LDSCTL_OFF); expert_starts(F, l, st, 8);
            const int nrt = st[NE];
            pg8::Gemm g{WSP(bf16, WS_HBUF), WSP(bf16, WS_W2T) + (size_t)l * NE * 2048 * DE, SLOTS, NE * 2048, DE};
            pg8::GroupedOrder S{nrt * 8, 8, F.G, F.bx, (const LAS int*)st};
            pg8::EpiY E{WSP(bf16, WS_Y)};
            pg8::gemm_phase<pg8::EpiY, pg8::GroupedOrder, true, true>(F.lds + RING_OFF, g, S, E);
            __syncthreads();
        }
        SEAM(pb + 9);
    }
    if (EN(11) && IN(21)) { SITE_FRAME(); norm_phase<true, false>(F, F.out, F.out, nullptr, nullptr, nullptr, WSP(float, WS_MOD) + (size_t)1 * 8 * 12288 + 5 * 2048); }
#undef IN
#undef SEAM
}

#ifndef MK_PER_PHASE
#define MK_PER_PHASE 0
#endif
extern "C" void kernel_launch(void* const* d_in, const int* in_sizes, int n_in, void* d_out, int out_size, void* d_ws, size_t ws_size, hipStream_t stream) {
    static int grid = 0;
    if (grid == 0) {
        if (n_in != 25 || in_sizes[0] != M * D || out_size != M * D || ws_size < WS_END) { fprintf(stderr, "kernel_launch: shape/workspace mismatch (n_in %d, ws %zu, need %zu)\n", n_in, ws_size, (size_t)WS_END); grid = -1; return; }
        int dev = 0, cus = 0, per_cu = 0;
        if (hipGetDevice(&dev) != hipSuccess || hipDeviceGetAttribute(&cus, hipDeviceAttributeMultiprocessorCount, dev) != hipSuccess) { grid = -1; return; }
        if (hipFuncSetAttribute((const void*)fwd_kernel, hipFuncAttributeMaxDynamicSharedMemorySize, LDS_BYTES) != hipSuccess) { fprintf(stderr, "kernel_launch: hipFuncSetAttribute failed\n"); grid = -1; return; }
        if (hipOccupancyMaxActiveBlocksPerMultiprocessor(&per_cu, (const void*)fwd_kernel, NTHR, LDS_BYTES) != hipSuccess || per_cu < 1) { fprintf(stderr, "kernel_launch: occupancy query says %d\n", per_cu); }
        (void)hipGetLastError();
        grid = cus;
    }
    if (grid < 0) return;
    if (hipMemsetAsync((char*)d_ws + WS_CTL, 0, CTL_ZERO_BYTES, stream) != hipSuccess) { fprintf(stderr, "kernel_launch: memset failed\n"); return; }
    Args a{};
    for (int i = 0; i < 25; ++i) a.in[i] = (const float*)d_in[i];
    a.out = (float*)d_out; a.ws = (unsigned char*)d_ws;
#if MK_PER_PHASE
    for (int p = 0; p < NPHASE; ++p) { a.ph_lo = p; a.ph_hi = p + 1; hipLaunchKernelGGL(fwd_kernel, dim3(grid), dim3(NTHR), LDS_BYTES, stream, a); }
#else
    a.ph_lo = 0; a.ph_hi = NPHASE;
    hipLaunchKernelGGL(fwd_kernel, dim3(grid), dim3(NTHR), LDS_BYTES, stream, a);
#endif
    const hipError_t le = hipPeekAtLastError();
    if (le != hipSuccess) fprintf(stderr, "kernel_launch: launch failed: %s\n", hipGetErrorName(le));
}
```

```cpp
#include <hip/hip_runtime.h>
#include <cstdio>
#include <cstdint>
#define MK_PER_PHASE 0
namespace pg8 {
#define PG8_LAS __attribute__((address_space(3)))
typedef unsigned short bf16_t;
typedef short bf16x8 __attribute__((ext_vector_type(8)));
typedef float f32x4 __attribute__((ext_vector_type(4)));
typedef unsigned u32x4 __attribute__((ext_vector_type(4)));
constexpr int BM = 256, BK = 64, HALF = 128, HTB = HALF * BK * 2  , STAGE_BYTES = 8 * HTB, NXCD = 8, WGM = 8;

__host__ __device__ __forceinline__ int lds_byte(int r, int c) { const int st = (r >> 4) * 2 + (c >> 5), rr = r & 15, cc = c & 31, ob = rr * 64 + cc * 2; return st * 1024 + (ob ^ (((ob >> 9) & 1) << 5)); }
__host__ __device__ __forceinline__ void stage_rc(int b, int& R, int& C) { const int st = b / 1024, sb = b % 1024, swz = sb ^ (((sb >> 9) & 1) << 5); R = (st >> 1) * 16 + swz / 64; C = (st & 1) * 32 + (swz % 64) / 2; }
__host__ __device__ __forceinline__ int perm32(int rho) { const int n = rho >> 4, i = rho & 15; return 8 * (i >> 2) + 4 * n + (i & 3); }

struct Unit { int pm, pn; };
struct Gemm { const bf16_t* A; const bf16_t* Bt; int M, N, K; };

struct StaticOrder {
    int nM, nN, nwg, G, c;
    __host__ __device__ void init(int M, int N, int G_, int c_) { nM = M / BM; nN = N / BM; nwg = nM * nN; G = G_; c = c_; }
    __host__ __device__ bool next(int i, Unit& u) const {
        const long L = (long)i * G + c; if (L >= nwg) return false;
        int wgid = (int)L; { const int q = nwg / NXCD, r = nwg % NXCD, xcd = wgid % NXCD, off = wgid / NXCD; wgid = (xcd < r ? xcd * (q + 1) : r * (q + 1) + (xcd - r) * q) + off; }
        const int nig = WGM * nN, gid = wgid / nig, fm = gid * WGM, gsz = (nM - fm) < WGM ? (nM - fm) : WGM;
        u.pm = fm + ((wgid % nig) % gsz); u.pn = (wgid % nig) / gsz; return true;
    }
    __device__ __forceinline__ void a_ready(const Unit&) const {}
    __device__ __forceinline__ void done(const Unit&) const {}
};

__device__ __forceinline__ unsigned cvt_pk_bf16(float lo, float hi) { unsigned r; asm volatile("v_cvt_pk_bf16_f32 %0, %1, %2" : "=v"(r) : "v"(lo), "v"(hi)); return r; }
__device__ __forceinline__ float silu_f(float v) { return v * __builtin_amdgcn_rcpf(1.0f + __expf(-v)); }

struct EpiZ {
    static constexpr bool PERM = true, AFTER_DRAIN = false;
    bf16_t* Z; float* Gt;
    __device__ __forceinline__ void operator()(const f32x4 (&acc)[2][2][4][2], const Unit& u, int wr, int wc, int fr, int fq) const {
        const int row0 = u.pm * BM + wr * 64 + fr;
        if (u.pn < 36) {
            const int col0 = u.pn * BM + wc * 32 + 8 * fq;
#pragma unroll
            for (int ai = 0; ai < 2; ++ai)
#pragma unroll
                for (int m = 0; m < 4; ++m) { bf16_t* rowp = Z + (size_t)(row0 + ai * HALF + m * 16) * 9216 + col0;
#pragma unroll
                    for (int bj = 0; bj < 2; ++bj) { const f32x4 v0 = acc[ai][bj][m][0], v1 = acc[ai][bj][m][1];
                        u32x4 w; w.x = cvt_pk_bf16(v0[0], v0[1]); w.y = cvt_pk_bf16(v0[2], v0[3]); w.z = cvt_pk_bf16(v1[0], v1[1]); w.w = cvt_pk_bf16(v1[2], v1[3]);
                        *(u32x4*)(rowp + bj * HALF) = w; } }
        } else if (wc == 0) {
#pragma unroll
            for (int ai = 0; ai < 2; ++ai)
#pragma unroll
                for (int m = 0; m < 4; ++m) { float* rowp = Gt + (size_t)(row0 + ai * HALF + m * 16) * 32 + 8 * fq;
                    *(f32x4*)(rowp) = acc[ai][0][m][0]; *(f32x4*)(rowp + 4) = acc[ai][0][m][1]; }
        }
    }
};
struct EpiX1 {
    static constexpr bool PERM = false, AFTER_DRAIN = false;
    const float* xin; float* out; const float* g1;
    __device__ __forceinline__ void operator()(const f32x4 (&acc)[2][2][4][2], const Unit& u, int wr, int wc, int fr, int fq) const {
        const int row0 = u.pm * BM + wr * 64 + fr, col0 = u.pn * BM + wc * 32 + 4 * fq;
        const float* gb = g1 + (size_t)(u.pm >> 3) * 12288 + col0;
        f32x4 gv[2][2];
#pragma unroll
        for (int bj = 0; bj < 2; ++bj)
#pragma unroll
            for (int n = 0; n < 2; ++n) gv[bj][n] = *(const f32x4*)(gb + bj * HALF + n * 16);
#pragma unroll
        for (int ai = 0; ai < 2; ++ai)
#pragma unroll
            for (int m = 0; m < 4; ++m) { const size_t off = (size_t)(row0 + ai * HALF + m * 16) * 2048 + col0;
#pragma unroll
                for (int bj = 0; bj < 2; ++bj)
#pragma unroll
                    for (int n = 0; n < 2; ++n) { const f32x4 xv = *(const f32x4*)(xin + off + bj * HALF + n * 16);
                        *(f32x4*)(out + off + bj * HALF + n * 16) = xv + gv[bj][n] * acc[ai][bj][m][n]; } }
    }
};
struct EpiH {
    static constexpr bool PERM = true, AFTER_DRAIN = false;
    bf16_t* H;
    __device__ __forceinline__ void operator()(const f32x4 (&acc)[2][2][4][2], const Unit& u, int wr, int wc, int fr, int fq) const {
        const int row0 = u.pm * BM + wr * 64 + fr, col0 = (u.pn & 3) * 128 + wc * 32 + 8 * fq;
#pragma unroll
        for (int ai = 0; ai < 2; ++ai)
#pragma unroll
            for (int m = 0; m < 4; ++m) { const f32x4 a0 = acc[ai][0][m][0], a1 = acc[ai][0][m][1], b0 = acc[ai][1][m][0], b1 = acc[ai][1][m][1];
                u32x4 w; w.x = cvt_pk_bf16(silu_f(a0[0]) * b0[0], silu_f(a0[1]) * b0[1]); w.y = cvt_pk_bf16(silu_f(a0[2]) * b0[2], silu_f(a0[3]) * b0[3]);
                w.z = cvt_pk_bf16(silu_f(a1[0]) * b1[0], silu_f(a1[1]) * b1[1]); w.w = cvt_pk_bf16(silu_f(a1[2]) * b1[2], silu_f(a1[3]) * b1[3]);
                *(u32x4*)(H + (size_t)(row0 + ai * HALF + m * 16) * 512 + col0) = w; }
    }
};
struct EpiY {
    static constexpr bool PERM = true, AFTER_DRAIN = false;
    bf16_t* Y;
    __device__ __forceinline__ void operator()(const f32x4 (&acc)[2][2][4][2], const Unit& u, int wr, int wc, int fr, int fq) const {
        const int row0 = u.pm * BM + wr * 64 + fr, col0 = (u.pn & 7) * BM + wc * 32 + 8 * fq;
#pragma unroll
        for (int ai = 0; ai < 2; ++ai)
#pragma unroll
            for (int m = 0; m < 4; ++m) { bf16_t* rowp = Y + (size_t)(row0 + ai * HALF + m * 16) * 2048 + col0;
#pragma unroll
                for (int bj = 0; bj < 2; ++bj) { const f32x4 v0 = acc[ai][bj][m][0], v1 = acc[ai][bj][m][1];
                    u32x4 w; w.x = cvt_pk_bf16(v0[0], v0[1]); w.y = cvt_pk_bf16(v0[2], v0[3]); w.z = cvt_pk_bf16(v1[0], v1[1]); w.w = cvt_pk_bf16(v1[2], v1[3]);
                    *(u32x4*)(rowp + bj * HALF) = w; } }
    }
};
struct GroupedOrder {
    int nU, NCT, G, c; const PG8_LAS int* tstart;
    __device__ __forceinline__ bool next(int i, Unit& u) const {
        const long L = (long)i * G + c; if (L >= nU) return false;
        int wgid = (int)L; { const int q = nU / NXCD, r = nU % NXCD, xcd = wgid % NXCD, off = wgid / NXCD; wgid = (xcd < r ? xcd * (q + 1) : r * (q + 1) + (xcd - r) * q) + off; }
        const int rt = wgid / NCT, ct = wgid - rt * NCT;
        int e = 0;
#pragma unroll
        for (int k = 1; k < 32; ++k) e += (tstart[k] <= rt) ? 1 : 0;
        e = __builtin_amdgcn_readfirstlane(e);
        u.pm = rt; u.pn = e * NCT + ct; return true;
    }
    __device__ __forceinline__ void a_ready(const Unit&) const {}
    __device__ __forceinline__ void done(const Unit&) const {}
};
template <class Epi, class Sched, bool ALIGN_EPI = false, bool SP2 = false>
__device__ __forceinline__ void gemm_phase(PG8_LAS unsigned char* lds, const Gemm g, const Sched& S, const Epi& E) {
    int tid_ = threadIdx.x; asm volatile("" : "+v"(tid_));
    const int tid = tid_, wid = __builtin_amdgcn_readfirstlane(tid >> 6), lane = tid & 63, wr = wid >> 2, wc = wid & 3, fr = lane & 15, fq = lane >> 4;
    const int K = g.K, nt = K / BK;
    unsigned voffA[2], voffB[2];
#pragma unroll
    for (int i = 0; i < 2; ++i) { int R, C; stage_rc(tid * 16 + i * 8192, R, C); const int Rb = Epi::PERM ? ((R & ~31) + perm32(R & 31)) : R;
        voffA[i] = (unsigned)(R * K + C) * 2u; voffB[i] = (unsigned)(Rb * K + C) * 2u; }
    const size_t kstep = (size_t)(BK * 2);
    const size_t hstep = (size_t)HALF * K * 2;
    const size_t tstep = 2 * hstep;
    const unsigned ldsw = (unsigned)wid * 1024u;
    const int aoff = lds_byte(wr * 64 + fr, fq * 8), boff = lds_byte(wc * 32 + fr, fq * 8);
#define PG8_SA(b, h) (((b) * 2 + (h)) * HTB)
#define PG8_SB(b, h) ((4 + (b) * 2 + (h)) * HTB)
#define PG8_STAGE(bufoff, gbase, voff) do { _Pragma("unroll") for (int _i = 0; _i < 2; ++_i) \
        __builtin_amdgcn_global_load_lds((const unsigned*)((const char*)(gbase) + (voff)[_i]), (PG8_LAS unsigned*)(lds + (bufoff) + ldsw + _i * 8192), 16, 0, 0); } while (0)
#define PG8_LDA(dst, b, h) do { _Pragma("unroll") for (int m = 0; m < 4; ++m) _Pragma("unroll") for (int k = 0; k < 2; ++k) dst[m][k] = *(const PG8_LAS bf16x8*)(lds + PG8_SA(b, h) + aoff + m * 2048 + k * 1024); } while (0)
#define PG8_LDB(dst, b, h) do { _Pragma("unroll") for (int n = 0; n < 2; ++n) _Pragma("unroll") for (int k = 0; k < 2; ++k) dst[n][k] = *(const PG8_LAS bf16x8*)(lds + PG8_SB(b, h) + boff + n * 2048 + k * 1024); } while (0)
#define PG8_MMA(ai, bj, At, Bt) do { __builtin_amdgcn_s_setprio(1); _Pragma("unroll") for (int m = 0; m < 4; ++m) _Pragma("unroll") for (int n = 0; n < 2; ++n) _Pragma("unroll") for (int k = 0; k < 2; ++k) \
        acc[ai][bj][m][n] = __builtin_amdgcn_mfma_f32_16x16x32_bf16(Bt[n][k], At[m][k], acc[ai][bj][m][n], 0, 0, 0); __builtin_amdgcn_s_setprio(0); } while (0)
#define PG8_WAIT_V(n) asm volatile("s_waitcnt vmcnt(" #n ")" ::: "memory")
#define PG8_WAIT_L(n) asm volatile("s_waitcnt lgkmcnt(" #n ")" ::: "memory")
#define PG8_BAR __builtin_amdgcn_s_barrier()
#define PG8_SCHED __builtin_amdgcn_sched_barrier(0)
    Unit cur, nxt; int ui = 0;
    if (!S.next(0, cur)) return;
    f32x4 acc[2][2][4][2];
#pragma unroll
    for (int a = 0; a < 2; ++a)
#pragma unroll
        for (int b = 0; b < 2; ++b)
#pragma unroll
            for (int m = 0; m < 4; ++m)
#pragma unroll
                for (int n = 0; n < 2; ++n) acc[a][b][m][n] = (f32x4){0.f, 0.f, 0.f, 0.f};
    bf16x8 At[4][2], B0[2][2], B1[2][2];
    const char* cA = (const char*)g.A + (size_t)cur.pm * tstep; const char* cB = (const char*)g.Bt + (size_t)cur.pn * tstep;
    S.a_ready(cur);
    if constexpr (SP2) {
        PG8_STAGE(PG8_SB(0, 0), cB, voffB); PG8_STAGE(PG8_SB(0, 1), cB + hstep, voffB); PG8_STAGE(PG8_SA(0, 0), cA, voffA); PG8_STAGE(PG8_SA(0, 1), cA + hstep, voffA);
        if (wr == 1) PG8_BAR;
        PG8_WAIT_V(2); PG8_BAR;
        PG8_STAGE(PG8_SB(1, 0), cB + kstep, voffB); PG8_STAGE(PG8_SA(1, 0), cA + kstep, voffA); PG8_STAGE(PG8_SB(1, 1), cB + hstep + kstep, voffB);
        PG8_WAIT_V(6); PG8_BAR;
    } else {
        PG8_STAGE(PG8_SB(0, 0), cB, voffB); PG8_STAGE(PG8_SA(0, 0), cA, voffA); PG8_STAGE(PG8_SB(0, 1), cB + hstep, voffB); PG8_STAGE(PG8_SA(0, 1), cA + hstep, voffA);
        if (wr == 1) PG8_BAR;
        PG8_WAIT_V(4); PG8_BAR;
        PG8_STAGE(PG8_SB(1, 0), cB + kstep, voffB); PG8_STAGE(PG8_SA(1, 0), cA + kstep, voffA); PG8_STAGE(PG8_SB(1, 1), cB + hstep + kstep, voffB);
        PG8_WAIT_V(6); PG8_BAR;
    }
    for (;;) {
        const bool has_next = S.next(ui + 1, nxt);
        const char* nA = has_next ? (const char*)g.A + (size_t)nxt.pm * tstep : cA; const char* nB = has_next ? (const char*)g.Bt + (size_t)nxt.pn * tstep : cB;
        for (int t = 0; t < nt; t += 2) {
            const bool last = (t == nt - 2);
            const char* a1 = cA + (size_t)(t + 1) * kstep;
            const char* a2 = last ? nA : cA + (size_t)(t + 2) * kstep; const char* b2 = last ? nB : cB + (size_t)(t + 2) * kstep;
            const char* a3 = a2 + kstep; const char* b3 = b2 + kstep;
            if (last && has_next) S.a_ready(nxt);
            if constexpr (SP2) {
            PG8_LDB(B0, 0, 0); PG8_LDB(B1, 0, 1); PG8_SCHED; PG8_LDA(At, 0, 0); PG8_STAGE(PG8_SA(1, 1), a1 + hstep, voffA);
            PG8_WAIT_V(8); PG8_WAIT_L(0); PG8_BAR; PG8_MMA(0, 0, At, B0); PG8_MMA(0, 1, At, B1); PG8_BAR; PG8_SCHED;
            PG8_LDA(At, 0, 1); PG8_STAGE(PG8_SB(0, 0), b2, voffB); PG8_STAGE(PG8_SB(0, 1), b2 + hstep, voffB); PG8_STAGE(PG8_SA(0, 0), a2, voffA);
            PG8_WAIT_V(8); PG8_WAIT_L(0); PG8_BAR; PG8_MMA(1, 0, At, B0); PG8_MMA(1, 1, At, B1); PG8_BAR; PG8_SCHED;
            PG8_LDB(B0, 1, 0); PG8_LDB(B1, 1, 1); PG8_SCHED; PG8_LDA(At, 1, 0); PG8_STAGE(PG8_SA(0, 1), a2 + hstep, voffA);
            PG8_WAIT_V(8); PG8_WAIT_L(0); PG8_BAR; PG8_MMA(0, 0, At, B0); PG8_MMA(0, 1, At, B1); PG8_BAR; PG8_SCHED;
            PG8_LDA(At, 1, 1); PG8_STAGE(PG8_SB(1, 0), b3, voffB); PG8_STAGE(PG8_SB(1, 1), b3 + hstep, voffB); PG8_STAGE(PG8_SA(1, 0), a3, voffA);
            PG8_WAIT_V(8); PG8_WAIT_L(0); PG8_BAR; PG8_MMA(1, 0, At, B0); PG8_MMA(1, 1, At, B1); PG8_BAR; PG8_SCHED;
            } else {
            PG8_LDB(B0, 0, 0); PG8_SCHED; PG8_LDA(At, 0, 0); PG8_STAGE(PG8_SA(1, 1), a1 + hstep, voffA);
            PG8_WAIT_L(8); PG8_BAR; PG8_WAIT_L(0); PG8_MMA(0, 0, At, B0); PG8_BAR; PG8_SCHED;
            PG8_LDB(B1, 0, 1); PG8_STAGE(PG8_SB(0, 0), b2, voffB);
            PG8_BAR; PG8_WAIT_L(0); PG8_MMA(0, 1, At, B1); PG8_BAR;
            PG8_LDA(At, 0, 1); PG8_STAGE(PG8_SA(0, 0), a2, voffA);
            PG8_BAR; PG8_WAIT_L(0); PG8_MMA(1, 0, At, B0); PG8_BAR; PG8_SCHED;
            PG8_STAGE(PG8_SB(0, 1), b2 + hstep, voffB);
            PG8_WAIT_V(6); PG8_BAR; PG8_MMA(1, 1, At, B1); PG8_BAR;
            PG8_LDB(B0, 1, 0); PG8_SCHED; PG8_LDA(At, 1, 0); PG8_STAGE(PG8_SA(0, 1), a2 + hstep, voffA);
            PG8_WAIT_L(8); PG8_BAR; PG8_WAIT_L(0); PG8_MMA(0, 0, At, B0); PG8_BAR; PG8_SCHED;
            PG8_LDB(B1, 1, 1); PG8_STAGE(PG8_SB(1, 0), b3, voffB);
            PG8_BAR; PG8_WAIT_L(0); PG8_MMA(0, 1, At, B1); PG8_BAR;
            PG8_LDA(At, 1, 1); PG8_STAGE(PG8_SA(1, 0), a3, voffA);
            PG8_BAR; PG8_WAIT_L(0); PG8_MMA(1, 0, At, B0); PG8_BAR; PG8_SCHED;
            PG8_STAGE(PG8_SB(1, 1), b3 + hstep, voffB);
            PG8_WAIT_V(6); PG8_BAR; PG8_MMA(1, 1, At, B1); PG8_BAR;
            }
        }
        if constexpr (ALIGN_EPI) { if (wr == 0) PG8_BAR; }
        if constexpr (!Epi::AFTER_DRAIN) { E(acc, cur, wr, wc, fr, fq); S.done(cur); }
        if (!has_next) break;
#pragma unroll
        for (int a = 0; a < 2; ++a)
#pragma unroll
            for (int b = 0; b < 2; ++b)
#pragma unroll
                for (int m = 0; m < 4; ++m)
#pragma unroll
                    for (int n = 0; n < 2; ++n) acc[a][b][m][n] = (f32x4){0.f, 0.f, 0.f, 0.f};
        cur = nxt; cA = nA; cB = nB; ++ui;
        if constexpr (ALIGN_EPI) { if (wr == 1) PG8_BAR; }
    }
    PG8_WAIT_V(0);
    if constexpr (!ALIGN_EPI) { if (wr == 0) PG8_BAR; }
    PG8_BAR;
    if constexpr (Epi::AFTER_DRAIN) { E.fused(acc, cur, wr, wc, fr, fq, lds, wid, lane); S.done(cur); }
#undef PG8_SA
#undef PG8_SB
#undef PG8_STAGE
#undef PG8_LDA
#undef PG8_LDB
#undef PG8_MMA
#undef PG8_WAIT_V
#undef PG8_WAIT_L
#undef PG8_BAR
#undef PG8_SCHED
}
}

constexpr int NWAVES = 8, NTHR = 512;
constexpr int BATCH = 8, T = 2048, D = 2048, M = BATCH * T, NL = 2;
constexpr int DIN = 9236, ZW = 9216, NZP = 9472;
constexpr int HD = 128, NH = 4;
constexpr int KO = 2560;
constexpr int NE = 32, DE = 512;
constexpr int SLOTS = 2 * M + NE * 256;
constexpr float EPS = 1e-6f;
constexpr float LOG2E = 1.4426950408889634f;
constexpr float SCALE = 0.088388347648318440f;
constexpr int Z_MQ = 0, Z_MK = 512, Z_MV = 1024, Z_MO = 1536, Z_BQ = 2048, Z_BK = 2560, Z_BV = 3072, Z_RQ = 3584, Z_RK = 4096, Z_RV = 4608, Z_RG = 5120,
              Z_NQ = 5632, Z_NKC = 6144, Z_NVC = 6656, Z_NKS = 7168, Z_NVS = 7680, Z_NKW = 8192, Z_NVW = 8704;
constexpr size_t MiB = 1u << 20;
constexpr size_t WS_CTL = 0, CTL_ZERO_BYTES = 1 * MiB;
constexpr size_t WS_MOD = 1 * MiB;
constexpr size_t WS_GT = 2 * MiB;
constexpr size_t WS_FQ = 4 * MiB;
constexpr size_t WS_GK = 4 * MiB + 512 * 1024;
constexpr size_t WS_KPART = 5 * MiB;
constexpr size_t WS_KCMP = 6 * MiB;
constexpr size_t WS_VCMP = 7 * MiB;
constexpr size_t WS_CB1 = 8 * MiB;
constexpr size_t WS_TOKE = 8 * MiB + 64 * 1024;
constexpr size_t WS_TOKP = WS_TOKE + 128 * 1024;
constexpr size_t WS_TOKG = WS_TOKP + 128 * 1024;
constexpr size_t WS_TOKS = WS_TOKG + 128 * 1024;
constexpr size_t WS_RTT = 9 * MiB;
constexpr size_t WS_CW1T = 10 * MiB;
constexpr size_t WS_CW2T = 14 * MiB;
constexpr size_t WS_WINT = 16 * MiB;
constexpr size_t WS_WOUTT = 90 * MiB;
constexpr size_t WS_W13T = 110 * MiB;
constexpr size_t WS_W2T = 366 * MiB;
constexpr size_t WS_HB = 500 * MiB;
constexpr size_t WS_Z = 564 * MiB;
constexpr size_t WS_QKM = 852 * MiB;
constexpr size_t WS_YCAT = 884 * MiB;
constexpr size_t WS_XS = 564 * MiB;
constexpr size_t WS_HBUF = 724 * MiB;
constexpr size_t WS_Y = 764 * MiB;
constexpr size_t WS_END = 964 * MiB;
constexpr int CW_BAR = 4096;
constexpr int CW_QUEUE = 8192;
constexpr int CW_CNT = 8192 + 1024;
constexpr int RING_OFF = 0, RING_BYTES = 131072;
constexpr int LDSCTL_OFF = RING_BYTES, MISC_OFF = LDSCTL_OFF + 320;
constexpr int LDS_BYTES = 147456;

#define GAS __attribute__((address_space(1)))
#define LAS __attribute__((address_space(3)))
typedef unsigned short bf16;
typedef unsigned v4u __attribute__((ext_vector_type(4)));
typedef unsigned v2u __attribute__((ext_vector_type(2)));
typedef float f32x4 __attribute__((ext_vector_type(4)));
typedef float f32x16 __attribute__((ext_vector_type(16)));
typedef short bf16x8 __attribute__((ext_vector_type(8)));
typedef short s16x4 __attribute__((ext_vector_type(4)));
typedef GAS unsigned gu32;
#define RLX_AGENT __ATOMIC_RELAXED, __HIP_MEMORY_SCOPE_AGENT
#define LDS_WAIT() asm volatile("s_waitcnt lgkmcnt(0)" ::: "memory")
#define VM_WAIT() asm volatile("s_waitcnt vmcnt(0)" ::: "memory")
__device__ __forceinline__ unsigned f2bf(float f) { unsigned u = __builtin_bit_cast(unsigned, f); return (u + 0x7fffu + ((u >> 16) & 1u)) >> 16; }
__device__ __forceinline__ unsigned pk2(float lo, float hi) { return f2bf(lo) | (f2bf(hi) << 16); }
__device__ __forceinline__ float bflo(unsigned w) { return __uint_as_float(w << 16); }
__device__ __forceinline__ float bfhi(unsigned w) { return __uint_as_float(w & 0xffff0000u); }
__device__ __forceinline__ float bf2f(bf16 b) { return __uint_as_float(((unsigned)b) << 16); }
__device__ __forceinline__ float wave_sum(float v) {
#pragma unroll
    for (int o = 1; o < 64; o <<= 1) v += __shfl_xor(v, o);
    return v;
}
__device__ __forceinline__ float sigmoid_f(float v) { return __builtin_amdgcn_rcpf(1.0f + __expf(-v)); }
__device__ __forceinline__ float silu2_f(float v) { return v * sigmoid_f(v); }

#ifndef PH_MASK2
#define PH_MASK2 0xFFFFu
#endif
#define EN2(j) ((PH_MASK2 >> (j)) & 1u)
#define XB_TMO      128
#define XB_XCNT(j)  (256  + 64 * (j))
#define XB_XSUB(j)  (1280 + 64 * (j))
#define XB_XGEN(j)  (2304 + 64 * (j))
#define XB_TOP      3328
#define XB_TOPGEN   3392
#define XCD_BAR_WORDS 3456
#define XB_SPIN_CAP (1u << 18)

__device__ __forceinline__ unsigned xb_ld(unsigned* p)              { return __hip_atomic_load(p, __ATOMIC_RELAXED, __HIP_MEMORY_SCOPE_AGENT); }
__device__ __forceinline__ unsigned xb_add(unsigned* p, unsigned v) { return __hip_atomic_fetch_add(p, v, __ATOMIC_RELAXED, __HIP_MEMORY_SCOPE_AGENT); }
__device__ __forceinline__ unsigned xb_xcc_id() { return (unsigned)__builtin_amdgcn_s_getreg((3 << 11) | 20) & 0xFu; }
#define XB_SPIN(cond, bar) do { unsigned _sp = 0; while (cond) { __builtin_amdgcn_s_sleep(1); \
    if ((++_sp & 255u) == 0u) { if (xb_ld(&(bar)[XB_TMO])) break; if (_sp > XB_SPIN_CAP) { atomicAdd(&(bar)[XB_TMO], 1u); break; } } } } while (0)

struct XcdBarrier {
    unsigned* bar; unsigned x;
    volatile LAS unsigned* st;
};

__device__ __forceinline__ XcdBarrier xcd_barrier_post(unsigned* bar, volatile LAS unsigned* st) {
    XcdBarrier b; b.bar = bar; b.x = xb_xcc_id(); b.st = st;
    if (threadIdx.x == 0) (void)xb_add(&bar[XB_XCNT(b.x)], 1u);
    return b;
}
__device__ __forceinline__ void xcd_barrier_complete(unsigned* bar, unsigned x, unsigned& nloc, unsigned& nx) {
    const unsigned G = gridDim.x * gridDim.y * gridDim.z;
    unsigned sum, cnt, mine, sp = 0u;
    for (;;) {
        sum = 0u; cnt = 0u; mine = 0u;
#pragma unroll
        for (unsigned j = 0; j < 16; ++j) { const unsigned c = xb_ld(&bar[XB_XCNT(j)]); sum += c; cnt += (c > 0u) ? 1u : 0u; mine = (j == x) ? c : mine; }
        if (sum == G) break;
        __builtin_amdgcn_s_sleep(1);
        if ((++sp & 255u) == 0u) { if (xb_ld(&bar[XB_TMO])) break; if (sp > XB_SPIN_CAP) { atomicAdd(&bar[XB_TMO], 1u); break; } }
    }
    nloc = mine > 0u ? mine : 1u; nx = cnt > 0u ? cnt : 1u;
}

__device__ __forceinline__ void xcd_barrier(const XcdBarrier& b) {
    asm volatile("s_waitcnt vmcnt(0)" ::: "memory");
    __syncthreads();
    if (threadIdx.x == 0) {
        unsigned* bar = b.bar;
        __builtin_amdgcn_s_waitcnt(0);
        unsigned nloc = b.st[0], nx = b.st[1];
        if (nloc == 0u) { xcd_barrier_complete(bar, b.x, nloc, nx); b.st[0] = nloc; b.st[1] = nx; }
        const unsigned old = xb_add(&bar[XB_XSUB(b.x)], 1u);
        const unsigned gen = old / nloc;
        if (old + 1u == (gen + 1u) * nloc) {
            __builtin_amdgcn_fence(__ATOMIC_RELEASE, "agent");
            asm volatile("s_waitcnt vmcnt(0)" ::: "memory");
            const unsigned og = xb_add(&bar[XB_TOP], 1u);
            const unsigned tg = og / nx;
            if (og + 1u == (tg + 1u) * nx) xb_add(&bar[XB_TOPGEN], 1u);
            else XB_SPIN(xb_ld(&bar[XB_TOPGEN]) == tg, bar);
            __builtin_amdgcn_fence(__ATOMIC_ACQUIRE, "agent");
            xb_add(&bar[XB_XGEN(b.x)], 1u);
            asm volatile("s_waitcnt vmcnt(0)" ::: "memory");
        } else {
            XB_SPIN(xb_ld(&bar[XB_XGEN(b.x)]) == gen, bar);
            __builtin_amdgcn_fence(__ATOMIC_ACQUIRE, "agent");
            asm volatile("s_waitcnt vmcnt(0)" ::: "memory");
        }
    }
    __syncthreads();
}
namespace att {
constexpr int SHM_V = 64 * 128 * 2, SHM_K = 64 * 128 * 2;
constexpr int OFF_WS = 65536;
constexpr int OFF_GT = OFF_WS + 4096;
constexpr int OFF_KM = OFF_GT + 512;
constexpr int OFF_UN = OFF_KM + 4096;
constexpr int OFF_HID = OFF_UN + 256;
constexpr float THR2 = 11.5f;
#define KSWZ(row, colB) ((row) * 256 + ((colB) ^ (((row) & 7) << 4)))
#define SBAR() __builtin_amdgcn_sched_barrier(0)
__device__ __forceinline__ constexpr int crc(int r) { return (r & 3) + 8 * (r >> 2); }
__device__ __forceinline__ int crow(int r, int hi) { return (r & 3) + 8 * (r >> 2) + 4 * hi; }
__device__ __forceinline__ unsigned cvtpk(float lo, float hi) { unsigned r; asm volatile("v_cvt_pk_bf16_f32 %0, %1, %2" : "=v"(r) : "v"(lo), "v"(hi)); return r; }
__device__ __forceinline__ float swap_max(float v) { auto rr = __builtin_amdgcn_permlane32_swap(__float_as_uint(v), __float_as_uint(v), false, false); return fmaxf(__uint_as_float(rr[0]), __uint_as_float(rr[1])); }
__device__ __forceinline__ float swap_sum(float v) { auto rr = __builtin_amdgcn_permlane32_swap(__float_as_uint(v), __float_as_uint(v), false, false); return __uint_as_float(rr[0]) + __uint_as_float(rr[1]); }

__device__ __forceinline__ void qkt(f32x16& p0, f32x16& p1, const LAS char* Ks, const bf16x8 (&qr)[8], int r32, int hi) {
    p0 = f32x16{}; p1 = f32x16{};
#pragma unroll
    for (int d0 = 0; d0 < 8; ++d0) { const int cb = (d0 * 16 + hi * 8) * 2;
        const bf16x8 b0 = *(const LAS bf16x8*)(Ks + KSWZ(r32, cb));
        const bf16x8 b1 = *(const LAS bf16x8*)(Ks + KSWZ(32 + r32, cb));
        p0 = __builtin_amdgcn_mfma_f32_32x32x16_bf16(b0, qr[d0], p0, 0, 0, 0);
        p1 = __builtin_amdgcn_mfma_f32_32x32x16_bf16(b1, qr[d0], p1, 0, 0, 0); }
}
__device__ __forceinline__ int v_st(int k, int c) { const int kk = (k & ~0xC) | ((k & 4) << 1) | ((k & 8) >> 1); return ((kk >> 3) * 4 + (c >> 5)) * 512 + ((kk & 7) * 32 + (c & 31)) * 2; }
__device__ __forceinline__ int v_rd_base(int lane) { return ((lane & 3) << 3) | (((lane >> 2) & 3) << 6) | (((lane >> 4) & 1) << 5) | (((lane >> 5) & 1) << 8); }
constexpr int v_rd_off(int d0, int ks, int half) { return d0 * 512 + ks * 4096 + half * 2048; }
template <int OFF> __device__ __forceinline__ s16x4 tr_read(int vb) { s16x4 r; asm volatile("ds_read_b64_tr_b16 %0, %1 offset:%2" : "=&v"(r) : "v"(vb), "i"(OFF) : "memory"); return r; }
template <int D0> __device__ __forceinline__ void pv_one(f32x16& od, int vb, bf16x8 pa0, bf16x8 pa1, bf16x8 pa2, bf16x8 pa3) {
    const s16x4 l0 = tr_read<v_rd_off(D0, 0, 0)>(vb), h0 = tr_read<v_rd_off(D0, 0, 1)>(vb), l1 = tr_read<v_rd_off(D0, 1, 0)>(vb), h1 = tr_read<v_rd_off(D0, 1, 1)>(vb);
    const s16x4 l2 = tr_read<v_rd_off(D0, 2, 0)>(vb), h2 = tr_read<v_rd_off(D0, 2, 1)>(vb), l3 = tr_read<v_rd_off(D0, 3, 0)>(vb), h3 = tr_read<v_rd_off(D0, 3, 1)>(vb);
    asm volatile("s_waitcnt lgkmcnt(0)" ::: "memory"); SBAR();
#define PKV(L, H) (bf16x8){L[0], L[1], L[2], L[3], H[0], H[1], H[2], H[3]}
    od = __builtin_amdgcn_mfma_f32_32x32x16_bf16(pa0, PKV(l0, h0), od, 0, 0, 0);
    od = __builtin_amdgcn_mfma_f32_32x32x16_bf16(pa1, PKV(l1, h1), od, 0, 0, 0);
    od = __builtin_amdgcn_mfma_f32_32x32x16_bf16(pa2, PKV(l2, h2), od, 0, 0, 0);
    od = __builtin_amdgcn_mfma_f32_32x32x16_bf16(pa3, PKV(l3, h3), od, 0, 0, 0);
#undef PKV
}
__device__ __forceinline__ void pv_d0(f32x16 (&o)[4], int vb, bf16x8 pa0, bf16x8 pa1, bf16x8 pa2, bf16x8 pa3) {
    pv_one<0>(o[0], vb, pa0, pa1, pa2, pa3); pv_one<1>(o[1], vb, pa0, pa1, pa2, pa3); pv_one<2>(o[2], vb, pa0, pa1, pa2, pa3); pv_one<3>(o[3], vb, pa0, pa1, pa2, pa3);
}
__device__ __forceinline__ void pack_p(const f32x16& p0, const f32x16& p1, bf16x8& pa0, bf16x8& pa1, bf16x8& pa2, bf16x8& pa3) {
#define PK4(P, BASE, OUT) do { unsigned a0 = cvtpk(P[BASE + 0], P[BASE + 1]), a1 = cvtpk(P[BASE + 2], P[BASE + 3]);   \
    unsigned b0 = cvtpk(P[BASE + 4], P[BASE + 5]), b1 = cvtpk(P[BASE + 6], P[BASE + 7]);                              \
    auto r0 = __builtin_amdgcn_permlane32_swap(a0, b0, false, false); auto r1 = __builtin_amdgcn_permlane32_swap(a1, b1, false, false); \
    v4u w = {r0[0], r1[0], r0[1], r1[1]}; OUT = __builtin_bit_cast(bf16x8, w); } while (0)
    PK4(p0, 0, pa0); PK4(p0, 8, pa1); PK4(p1, 0, pa2); PK4(p1, 8, pa3);
#undef PK4
}
__device__ __forceinline__ void rescale_o(f32x16 (&o)[4], float a, LAS float* al_l, int r32, int hi) {
    if (hi == 0) al_l[r32] = a;
    asm volatile("s_waitcnt lgkmcnt(0)" ::: "memory");
#pragma unroll
    for (int r = 0; r < 16; ++r) { const float f = al_l[crow(r, hi)];
#pragma unroll
        for (int d = 0; d < 4; ++d) o[d][r] *= f; }
}
__device__ __forceinline__ void row_bcast(float v, float (&out)[16], LAS float* sl, int r32, int hi) {
    asm volatile("s_waitcnt lgkmcnt(0)" ::: "memory");
    if (hi == 0) sl[r32] = v;
    asm volatile("s_waitcnt lgkmcnt(0)" ::: "memory");
#pragma unroll
    for (int r = 0; r < 16; ++r) out[r] = sl[crow(r, hi)];
    asm volatile("s_waitcnt lgkmcnt(0)" ::: "memory");
}

enum { MD_MLSTM = 0, MD_MOBA = 1, MD_RET = 2, MD_SEL = 3, MD_WIN = 4 };
struct LaneCtx { int tq; float a; float slope2; unsigned qmask; };

template <int MODE>
__device__ __forceinline__ void attn_pass(LAS char* lds, const bf16* __restrict__ Kh, int ldk, const bf16* __restrict__ Vh, int ldv, const float* __restrict__ Gk,
                                          unsigned tmask, unsigned wmask, int qb, const bf16x8 (&qr)[8], f32x16 (&o)[4], float& m_reg, float& l_reg, const LaneCtx& lc) {
    int tid_ = threadIdx.x; asm volatile("" : "+v"(tid_));
    const int tid = tid_, wid = __builtin_amdgcn_readfirstlane(tid >> 6), lane = tid & 63, r32 = lane & 31, hi = lane >> 5;
    LAS char* V_lds = lds; LAS char* K_lds = lds + 2 * SHM_V;
    LAS float* al_l = (LAS float*)(lds + OFF_WS) + wid * 128;
    LAS float* gtab = (LAS float*)(lds + OFF_GT);
    const int sr = tid >> 4, sc = (tid & 15) * 8, vst0 = v_st(sr, sc), vst1 = v_st(32 + sr, sc), kc = sc * 2;
    const int vb0 = (int)(unsigned)(uintptr_t)V_lds + v_rd_base(lane);
    bf16x8 ks0, ks1, vs0, vs1; float gst = 0.f;
#define SLOAD(k0) do { ks0 = *(const bf16x8*)(Kh + (size_t)((k0) + sr) * ldk + sc); ks1 = *(const bf16x8*)(Kh + (size_t)((k0) + 32 + sr) * ldk + sc); \
        vs0 = *(const bf16x8*)(Vh + (size_t)((k0) + sr) * ldv + sc); vs1 = *(const bf16x8*)(Vh + (size_t)((k0) + 32 + sr) * ldv + sc); \
        if (MODE == MD_MLSTM) { if (tid < 64) gst = Gk[(k0) + tid]; } } while (0)
#define SWRITE(b) do { *(LAS bf16x8*)(V_lds + (b) * SHM_V + vst0) = vs0; *(LAS bf16x8*)(V_lds + (b) * SHM_V + vst1) = vs1; \
        *(LAS bf16x8*)(K_lds + (b) * SHM_K + KSWZ(sr, kc)) = ks0; *(LAS bf16x8*)(K_lds + (b) * SHM_K + KSWZ(32 + sr, kc)) = ks1; \
        if (MODE == MD_MLSTM) { if (tid < 64) gtab[(b) * 64 + tid] = gst; } } while (0)
    if (tmask == 0u) return;
    unsigned rem = tmask; int j = __builtin_ctz(rem); rem &= rem - 1u;
    SLOAD(j * 64);
    int buf = 0;
    const int q0w = qb * 256 + wid * 32;
    constexpr float C1 = SCALE * LOG2E;
    for (;;) {
        VM_WAIT(); SWRITE(buf); __syncthreads();
        int jn = -1;
        if (rem) { jn = __builtin_ctz(rem); rem &= rem - 1u; SLOAD(jn * 64); }
        if ((wmask >> j) & 1u) {
            f32x16 p0, p1;
            qkt(p0, p1, K_lds + buf * SHM_K, qr, r32, hi);
            const int k0 = j * 64;
            const int base = lc.tq - k0 - 4 * hi;
            const float bias0 = -lc.slope2 * (float)base;
            if (MODE == MD_MOBA || MODE == MD_SEL || MODE == MD_WIN) {
                bool lane_ok = true, chk_c = false, chk_w = false;
                if (MODE == MD_MOBA) { const int blk = j >> 2; if (blk == qb) chk_c = (k0 + 63 > q0w); else lane_ok = (lc.qmask >> blk) & 1u; }
                if (MODE == MD_SEL) { lane_ok = (lc.qmask >> j) & 1u; chk_c = (k0 + 63 > q0w); }
                if (MODE == MD_WIN) { chk_c = (k0 + 63 > q0w); chk_w = (q0w + 31 - k0 >= 512); }
#pragma unroll
                for (int r = 0; r < 16; ++r) {
                    const int c0 = crc(r), c1 = crc(r) + 32;
                    float s0 = fmaf(p0[r], C1, fmaf(lc.slope2, (float)c0, bias0));
                    float s1 = fmaf(p1[r], C1, fmaf(lc.slope2, (float)c1, bias0));
                    bool v0 = lane_ok, v1 = lane_ok;
                    if (chk_c) { v0 = v0 && (c0 <= base); v1 = v1 && (c1 <= base); }
                    if (chk_w) { v0 = v0 && (base - c0 < 512); v1 = v1 && (base - c1 < 512); }
                    p0[r] = v0 ? s0 : -1e30f; p1[r] = v1 ? s1 : -1e30f;
                }
                float pmax = p0[0];
#pragma unroll
                for (int r = 1; r < 16; ++r) pmax = fmaxf(pmax, p0[r]);
#pragma unroll
                for (int r = 0; r < 16; ++r) pmax = fmaxf(pmax, p1[r]);
                pmax = swap_max(pmax);
                float mn, alpha; bool resc;
                if (__all(pmax - m_reg <= THR2)) { mn = m_reg; alpha = 1.f; resc = false; }
                else { mn = fmaxf(m_reg, pmax); alpha = __builtin_amdgcn_exp2f(m_reg - mn); m_reg = mn; resc = true; }
                float ps = 0.f;
#pragma unroll
                for (int r = 0; r < 16; ++r) { p0[r] = __builtin_amdgcn_exp2f(p0[r] - mn); p1[r] = __builtin_amdgcn_exp2f(p1[r] - mn); ps += p0[r] + p1[r]; }
                l_reg = l_reg * alpha + ps;
                if (resc) rescale_o(o, alpha, al_l, r32, hi);
            } else {
                const bool chk_c = (k0 + 63 > q0w);
                float ps = 0.f;
                if (MODE == MD_MLSTM) {
                    const LAS float* gt = gtab + buf * 64 + 4 * hi;
#pragma unroll
                    for (int a = 0; a < 4; ++a) {
                        const f32x4 g0 = *(const LAS f32x4*)(gt + 8 * a), g1 = *(const LAS f32x4*)(gt + 32 + 8 * a);
#pragma unroll
                        for (int i = 0; i < 4; ++i) { const int r = 4 * a + i; const int c0 = crc(r), c1 = crc(r) + 32;
                            float w0 = __builtin_amdgcn_exp2f(lc.a + g0[i]) * SCALE, w1 = __builtin_amdgcn_exp2f(lc.a + g1[i]) * SCALE;
                            if (chk_c) { w0 = (c0 <= base) ? w0 : 0.f; w1 = (c1 <= base) ? w1 : 0.f; }
                            p0[r] *= w0; p1[r] *= w1; ps += p0[r] + p1[r]; }
                    }
                    l_reg += ps;
                } else {
#pragma unroll
                    for (int r = 0; r < 16; ++r) { const int c0 = crc(r), c1 = crc(r) + 32;
                        float w0 = __builtin_amdgcn_exp2f(fmaf(lc.slope2, (float)c0, bias0)) * SCALE, w1 = __builtin_amdgcn_exp2f(fmaf(lc.slope2, (float)c1, bias0)) * SCALE;
                        if (chk_c) { w0 = (c0 <= base) ? w0 : 0.f; w1 = (c1 <= base) ? w1 : 0.f; }
                        p0[r] *= w0; p1[r] *= w1; }
                }
            }
            bf16x8 pa0, pa1, pa2, pa3;
            pack_p(p0, p1, pa0, pa1, pa2, pa3);
            pv_d0(o, vb0 + buf * SHM_V, pa0, pa1, pa2, pa3);
        }
        if (jn < 0) break;
        j = jn; buf ^= 1;
    }
    __syncthreads();
#undef SLOAD
#undef SWRITE
}

template <bool ACCUM = false>
__device__ __forceinline__ void store_o(const f32x16 (&o)[4], const float (&fr)[16], bf16* Yp, int ldy, int r32, int hi) {
    bf16* Yl = Yp + (size_t)(4 * hi) * ldy + r32;
#pragma unroll
    for (int r = 0; r < 16; ++r) { bf16* rowp = Yl; asm volatile("" : "+v"(rowp)); rowp += (size_t)crc(r) * ldy;
        float pv[4] = {0.f, 0.f, 0.f, 0.f};
        if (ACCUM) {
#pragma unroll
            for (int d = 0; d < 4; ++d) pv[d] = bf2f(rowp[d * 32]); }
#pragma unroll
        for (int d = 0; d < 4; ++d) rowp[d * 32] = (bf16)f2bf(o[d][r] * fr[r] + pv[d]); }
}
template <int GACT>
__device__ __forceinline__ void store_rms_gate(f32x16 (&o)[4], const float (&fr)[16], const float* __restrict__ gain, const bf16* __restrict__ gate, int ldg, bf16* Yp, int ldy, int r32, int hi) {
    float gn[4];
#pragma unroll
    for (int d = 0; d < 4; ++d) gn[d] = gain[d * 32 + r32];
    const bf16* Gl = gate + (size_t)(4 * hi) * ldg + r32; bf16* Yl = Yp + (size_t)(4 * hi) * ldy + r32;
#pragma unroll
    for (int r = 0; r < 16; ++r) {
        const bf16* gp = Gl; bf16* yp = Yl; asm volatile("" : "+v"(gp), "+v"(yp)); gp += (size_t)crc(r) * ldg; yp += (size_t)crc(r) * ldy;
        float gv[4];
#pragma unroll
        for (int d = 0; d < 4; ++d) gv[d] = bf2f(gp[d * 32]);
        float ss = 0.f;
#pragma unroll
        for (int d = 0; d < 4; ++d) { o[d][r] *= fr[r]; ss += o[d][r] * o[d][r]; }
#pragma unroll
        for (int x = 1; x < 32; x <<= 1) ss += __shfl_xor(ss, x);
        const float rn = __builtin_amdgcn_rsqf(ss * (1.0f / 128.0f) + EPS);
#pragma unroll
        for (int d = 0; d < 4; ++d) { const float ga = GACT == 0 ? sigmoid_f(gv[d]) : silu2_f(gv[d]);
            yp[d * 32] = (bf16)f2bf(o[d][r] * rn * gn[d] * ga); }
    }
}
__device__ __forceinline__ void load_q(bf16x8 (&qr)[8], const bf16* Qw) {
#pragma unroll
    for (int d0 = 0; d0 < 8; ++d0) qr[d0] = *(const bf16x8*)(Qw + d0 * 16);
}
__device__ __forceinline__ unsigned wave_or(unsigned m) {
#pragma unroll
    for (int x = 1; x < 64; x <<= 1) m |= (unsigned)__shfl_xor((int)m, x);
    return m;
}
__device__ __forceinline__ unsigned causal_tiles(int qlast) { const int n = (qlast >> 6) + 1; return n >= 32 ? 0xffffffffu : ((1u << n) - 1u); }
}
struct Args { const float* in[25]; float* out; unsigned char* ws; int ph_lo, ph_hi; };
typedef const __attribute__((address_space(4))) Args* KArgs;
struct Frame {
    LAS unsigned char* lds; volatile LAS unsigned* MISC; gu32* ctl;
    int tid, lane, wave, G, bx;
    unsigned char* ws; float* out;
};
#define WSP(T, off) ((T*)(F.ws + (off)))

__device__ __forceinline__ int maprow(int mode, int n, int arg) {
    if (mode == 0) return n + arg;
    if (mode == 1) {
        if (n < 2048) return n;
        if (n < 2056) return ZW + (n - 2048);
        if (n < 9224) return n - 8;
        return ZW + 8 + (n - 9224);
    }
    return ((n >> 7) << 8) + (n & 127) + arg;
}
__device__ __forceinline__ void tr_item(const float* __restrict__ W, int N, bf16* __restrict__ WT, int ldd, int koff, int mode, int arg, LAS float* scr, int item, int lane) {
    const int nblk = (N + 31) >> 5, kb = item / nblk, nb = item - kb * nblk, k0 = 64 * kb, n0 = 32 * nb;
    const int nn = n0 + (lane & 31); const bool nok = nn < N;
#pragma unroll 8
    for (int i = 0; i < 32; ++i) { const int kk = 2 * i + (lane >> 5); scr[kk * 33 + (lane & 31)] = nok ? W[(size_t)(k0 + kk) * N + nn] : 0.f; }
    LDS_WAIT(); asm volatile("" ::: "memory");
    const int c = lane & 7;
#pragma unroll
    for (int j = 0; j < 4; ++j) { const int n = (lane >> 3) + 8 * j; const LAS float* s = scr + (8 * c) * 33 + n;
        v4u o; o.x = pk2(s[0 * 33], s[1 * 33]); o.y = pk2(s[2 * 33], s[3 * 33]); o.z = pk2(s[4 * 33], s[5 * 33]); o.w = pk2(s[6 * 33], s[7 * 33]);
        if (n0 + n < N) *(GAS v4u*)(WT + (size_t)maprow(mode, n0 + n, arg) * ldd + koff + k0 + 8 * c) = o; }
    LDS_WAIT(); asm volatile("" ::: "memory");
}
__device__ __forceinline__ void mod_item(const float* __restrict__ cin, const float* __restrict__ aw, const float* __restrict__ ab, float* __restrict__ mod, int item, int lane) {
    const int l = item / 384, ch = item - l * 384, n0 = ch * 32, cg = lane & 7, rs = lane >> 3;
    const float* W = aw + (size_t)l * 2048 * 12288 + n0 + 4 * cg;
    f32x4 acc[8];
#pragma unroll
    for (int b = 0; b < 8; ++b) acc[b] = (f32x4){0.f, 0.f, 0.f, 0.f};
#pragma unroll 4
    for (int i = 0; i < 256; ++i) { const int k = rs + 8 * i;
        const f32x4 w = *(const f32x4*)(W + (size_t)k * 12288);
#pragma unroll
        for (int b = 0; b < 8; ++b) { const float cv = cin[b * 2048 + k]; const float s = silu2_f(cv); acc[b] += w * s; } }
#pragma unroll
    for (int b = 0; b < 8; ++b)
#pragma unroll
        for (int x = 8; x < 64; x <<= 1) { acc[b].x += __shfl_xor(acc[b].x, x); acc[b].y += __shfl_xor(acc[b].y, x); acc[b].z += __shfl_xor(acc[b].z, x); acc[b].w += __shfl_xor(acc[b].w, x); }
    if (rs == 0) { const f32x4 bv = *(const f32x4*)(ab + (size_t)l * 12288 + n0 + 4 * cg);
#pragma unroll
        for (int b = 0; b < 8; ++b) *(f32x4*)(mod + ((size_t)l * 8 + b) * 12288 + n0 + 4 * cg) = acc[b] + bv; }
}
__device__ __forceinline__ void p0_prologue(Frame& F, KArgs A) {
    LAS float* scr = (LAS float*)(F.lds + RING_OFF + F.wave * 8448);
    const int gw = F.bx * NWAVES + F.wave, NGW = F.G * NWAVES;
    constexpr int J1 = 32 * 289, J2 = 32 * 64, J3 = 8 * 64, J4 = 32 * 512, J5 = J4, J6 = 32 * 512, J7 = 2 * 256, J8 = 2 * 8, J9 = 64;
    constexpr int JL = J1 + J2 + J3 + J4 + J5 + J6 + J7 + J8 + J9;
    constexpr int N_CB = 8, N_MOD = 768, NITEMS = N_CB + N_MOD + 2 * JL;
    for (int it = gw; it < NITEMS; it += NGW) {
        int r = it;
        if (r < N_CB) {
            const int lk = r >> 1, e = (r & 1) * 64 + F.lane;
            const float* pe = A->in[14] + (size_t)lk * 4096; const float* w1 = A->in[15] + (size_t)lk * 4096 * 128 + e;
            float s = 0.f;
#pragma unroll 8
            for (int f = 0; f < 4096; ++f) s = fmaf(pe[f], w1[(size_t)f * 128], s);
            WSP(float, WS_CB1)[lk * 128 + e] = s; continue; }
        r -= N_CB;
        if (r < N_MOD) { mod_item(A->in[1], A->in[4], A->in[5], WSP(float, WS_MOD), r, F.lane); continue; }
        r -= N_MOD;
        const int l = r / JL; r -= l * JL;
        if (r < J1) { tr_item(A->in[6] + (size_t)l * 2048 * DIN, DIN, WSP(bf16, WS_WINT) + (size_t)l * NZP * 2048, 2048, 0, 1, 0, scr, r, F.lane); continue; } r -= J1;
        if (r < J2) { tr_item(A->in[17] + (size_t)l * 2048 * 2048, 2048, WSP(bf16, WS_WOUTT) + (size_t)l * 2048 * KO, KO, 0, 0, 0, scr, r, F.lane); continue; } r -= J2;
        if (r < J3) { tr_item(A->in[17] + (size_t)l * 2048 * 2048 + (size_t)1536 * 2048, 2048, WSP(bf16, WS_WOUTT) + (size_t)l * 2048 * KO, KO, 2048, 0, 0, scr, r, F.lane); continue; } r -= J3;
        if (r < J4) { const int e = r >> 9; tr_item(A->in[22] + ((size_t)l * NE + e) * 2048 * DE, DE, WSP(bf16, WS_W13T) + ((size_t)l * NE + e) * 1024 * 2048, 2048, 0, 2, 0, scr, r & 511, F.lane); continue; } r -= J4;
        if (r < J5) { const int e = r >> 9; tr_item(A->in[23] + ((size_t)l * NE + e) * 2048 * DE, DE, WSP(bf16, WS_W13T) + ((size_t)l * NE + e) * 1024 * 2048, 2048, 0, 2, 128, scr, r & 511, F.lane); continue; } r -= J5;
        if (r < J6) { const int e = r >> 9; tr_item(A->in[24] + ((size_t)l * NE + e) * DE * 2048, 2048, WSP(bf16, WS_W2T) + ((size_t)l * NE + e) * 2048 * DE, DE, 0, 0, 0, scr, r & 511, F.lane); continue; } r -= J6;
        if (r < J7) { const int kv = r >> 8; tr_item(A->in[15] + ((size_t)l * 2 + kv) * 4096 * 128, 128, WSP(bf16, WS_CW1T) + ((size_t)l * 2 + kv) * 128 * 4096, 4096, 0, 0, 0, scr, r & 255, F.lane); continue; } r -= J7;
        if (r < J8) { const int kv = r >> 3; tr_item(A->in[16] + ((size_t)l * 2 + kv) * 128 * 128, 128, WSP(bf16, WS_CW2T) + ((size_t)l * 2 + kv) * 128 * 128, 128, 0, 0, 0, scr, r & 7, F.lane); continue; } r -= J8;
        if (r < 32) { tr_item(A->in[18] + (size_t)l * 2048 * 4, 4, WSP(bf16, WS_RTT) + (size_t)l * 48 * 2048, 2048, 0, 0, 0, scr, r, F.lane); continue; } r -= 32;
        tr_item(A->in[20] + (size_t)l * 2048 * 32, 32, WSP(bf16, WS_RTT) + (size_t)l * 48 * 2048, 2048, 0, 0, 4, scr, r, F.lane);
    }
}

template <bool COMBINE, bool NORM>
__device__ __forceinline__ void norm_phase(Frame& F, const float* xin, float* xout, const float* gain, const float* modsh, const float* modsc, const float* modg2) {
    const int gw = F.bx * NWAVES + F.wave, NGW = F.G * NWAVES, lane = F.lane;
    bf16* HB = WSP(bf16, WS_HB);
    for (int m = gw; m < M; m += NGW) {
        const int b = m >> 11;
        const f32x4* xr = (const f32x4*)(xin + (size_t)m * D) + lane;
        f32x4 v[8];
#pragma unroll
        for (int j = 0; j < 8; ++j) v[j] = xr[64 * j];
        if (COMBINE) {
            const int sa = WSP(int, WS_TOKS)[2 * m], sb = WSP(int, WS_TOKS)[2 * m + 1];
            const float ga = WSP(float, WS_TOKG)[2 * m], gb = WSP(float, WS_TOKG)[2 * m + 1];
            const v2u* ya = (const v2u*)(WSP(bf16, WS_Y) + (size_t)sa * D) + lane; const v2u* yb = (const v2u*)(WSP(bf16, WS_Y) + (size_t)sb * D) + lane;
            const f32x4* g2 = (const f32x4*)(modg2 + (size_t)b * 12288) + lane;
            f32x4* xo = (f32x4*)(xout + (size_t)m * D) + lane;
#pragma unroll
            for (int j = 0; j < 8; ++j) { const v2u a = ya[64 * j], bb = yb[64 * j]; const f32x4 g = g2[64 * j];
                f32x4 y; y.x = ga * bflo(a.x) + gb * bflo(bb.x); y.y = ga * bfhi(a.x) + gb * bfhi(bb.x); y.z = ga * bflo(a.y) + gb * bflo(bb.y); y.w = ga * bfhi(a.y) + gb * bfhi(bb.y);
                v[j] = v[j] + g * y; xo[64 * j] = v[j]; }
        }
        if (NORM) {
            float ss = 0.f;
#pragma unroll
            for (int j = 0; j < 8; ++j) ss += (v[j].x * v[j].x + v[j].y * v[j].y) + (v[j].z * v[j].z + v[j].w * v[j].w);
            const float rstd = __builtin_amdgcn_rsqf(wave_sum(ss) * (1.0f / D) + EPS);
            const f32x4* gn = (const f32x4*)gain + lane; const f32x4* sc = (const f32x4*)(modsc + (size_t)b * 12288) + lane; const f32x4* sh = (const f32x4*)(modsh + (size_t)b * 12288) + lane;
            v2u* o8 = (v2u*)(HB + (size_t)m * D) + lane;
#pragma unroll
            for (int j = 0; j < 8; ++j) { const f32x4 g = gn[64 * j], s = sc[64 * j], h = sh[64 * j];
                const f32x4 y = v[j] * rstd * g * (s + 1.0f) + h;
                v2u w; w.x = pk2(y.x, y.y); w.y = pk2(y.z, y.w); o8[64 * j] = w; }
        }
    }
}

__device__ __forceinline__ float gelu_tanh(float x) { const float u = 0.7978845608028654f * (x + 0.044715f * x * x * x); const float e = __expf(2.0f * u); const float t = 1.0f - 2.0f * __builtin_amdgcn_rcpf(e + 1.0f); return 0.5f * x * (1.0f + t); }
__device__ __forceinline__ void compress_item(Frame& F, KArgs A, int l, int item) {
    const int b = item >> 3, h = (item >> 1) & 3, kv = item & 1, lane = F.lane, w = F.wave;
    const bf16* Z = WSP(bf16, WS_Z) + (size_t)b * T * ZW + (kv ? Z_NVC : Z_NKC) + h * HD;
    const bf16* W1 = WSP(bf16, WS_CW1T) + ((size_t)l * 2 + kv) * 128 * 4096;
    const bf16* W2 = WSP(bf16, WS_CW2T) + ((size_t)l * 2 + kv) * 128 * 128;
    const float* cb1 = WSP(float, WS_CB1) + (l * 2 + kv) * 128;
    const int lr = lane & 15, lq = lane >> 4;
    const int n = 16 * w + lr;
    f32x4 acc[8];
#pragma unroll
    for (int i = 0; i < 8; ++i) acc[i] = (f32x4){0.f, 0.f, 0.f, 0.f};
    for (int ks = 0; ks < 128; ++ks) {
        const int p = ks >> 2, d = (ks & 3) * 32 + 8 * lq; int tok = 16 * n + p; tok = tok > T - 1 ? T - 1 : tok;
        const bf16x8 a = *(const bf16x8*)(Z + (size_t)tok * ZW + d);
#pragma unroll
        for (int nt = 0; nt < 8; ++nt) { const bf16x8 bw = *(const bf16x8*)(W1 + (size_t)(nt * 16 + lr) * 4096 + ks * 32 + 8 * lq);
            acc[nt] = __builtin_amdgcn_mfma_f32_16x16x32_bf16(a, bw, acc[nt], 0, 0, 0); }
    }
    LAS bf16* hid = (LAS bf16*)(F.lds + att::OFF_HID + w * 4352);
#pragma unroll
    for (int nt = 0; nt < 8; ++nt) { const float bb = cb1[nt * 16 + lr];
#pragma unroll
        for (int g = 0; g < 4; ++g) hid[(4 * lq + g) * 136 + nt * 16 + lr] = (bf16)f2bf(gelu_tanh(acc[nt][g] + bb)); }
    LDS_WAIT(); asm volatile("" ::: "memory");
    f32x4 ac2[8];
#pragma unroll
    for (int i = 0; i < 8; ++i) ac2[i] = (f32x4){0.f, 0.f, 0.f, 0.f};
#pragma unroll
    for (int ks = 0; ks < 4; ++ks) { const bf16x8 a = *(const LAS bf16x8*)(hid + lr * 136 + ks * 32 + 8 * lq);
#pragma unroll
        for (int nt = 0; nt < 8; ++nt) { const bf16x8 bw = *(const bf16x8*)(W2 + (size_t)(nt * 16 + lr) * 128 + ks * 32 + 8 * lq);
            ac2[nt] = __builtin_amdgcn_mfma_f32_16x16x32_bf16(a, bw, ac2[nt], 0, 0, 0); } }
    LDS_WAIT();
    bf16* O = WSP(bf16, kv ? WS_VCMP : WS_KCMP) + (size_t)(b * 4 + h) * 128 * 128;
    float rn[4] = {1.f, 1.f, 1.f, 1.f};
    if (kv == 0) {
#pragma unroll
        for (int g = 0; g < 4; ++g) { float ss = 0.f;
#pragma unroll
            for (int nt = 0; nt < 8; ++nt) ss += ac2[nt][g] * ac2[nt][g];
#pragma unroll
            for (int x = 1; x < 16; x <<= 1) ss += __shfl_xor(ss, x);
            rn[g] = __builtin_amdgcn_rsqf(ss * (1.0f / 128.0f) + EPS); }
    }
    const float* kg = A->in[13] + (size_t)l * 3 * 128;
#pragma unroll
    for (int nt = 0; nt < 8; ++nt) { const float g0 = kv == 0 ? kg[nt * 16 + lr] : 1.0f;
#pragma unroll
        for (int g = 0; g < 4; ++g) O[(size_t)(16 * w + 4 * lq + g) * 128 + nt * 16 + lr] = (bf16)f2bf(ac2[nt][g] * rn[g] * g0); }
}
__device__ __forceinline__ void cumsum_item(Frame& F, KArgs A, int l, int b) {
    if (F.wave >= 4) return;
    const int h = F.wave, lane = F.lane;
    const float* Gt = WSP(float, WS_GT) + (size_t)b * T * 32;
    const float bi = A->in[7][(l * 2 + 0) * 4 + h], bf_ = A->in[7][(l * 2 + 1) * 4 + h];
    float lf[32]; float run = 0.f;
#pragma unroll
    for (int i = 0; i < 32; ++i) { const float x = Gt[(size_t)(lane * 32 + i) * 32 + 4 + h] + bf_;
        const float ls = fminf(x, 0.f) - log1pf(__expf(-fabsf(x))); run += ls; lf[i] = run; }
    float tot = run, inc = run;
#pragma unroll
    for (int x = 1; x < 64; x <<= 1) { const float t = __shfl_up(inc, x); if (lane >= x) inc += t; }
    const float excl = inc - tot;
    float* Fq = WSP(float, WS_FQ) + (size_t)(b * 4 + h) * T; float* Gk = WSP(float, WS_GK) + (size_t)(b * 4 + h) * T;
#pragma unroll
    for (int i = 0; i < 32; ++i) { const int t = lane * 32 + i; const float f = excl + lf[i]; const float ig = Gt[(size_t)t * 32 + h] + bi;
        Fq[t] = f * LOG2E; Gk[t] = (ig - f) * LOG2E; }
}
__device__ __forceinline__ void rms_seg(bf16* p, const float* __restrict__ g, int lane, float (&y)[8]) {
    const v4u w = *(const v4u*)(p + 8 * lane);
    float x[8] = {bflo(w.x), bfhi(w.x), bflo(w.y), bfhi(w.y), bflo(w.z), bfhi(w.z), bflo(w.w), bfhi(w.w)};
    float ss = 0.f;
#pragma unroll
    for (int i = 0; i < 8; ++i) ss += x[i] * x[i];
#pragma unroll
    for (int s = 1; s < 16; s <<= 1) ss += __shfl_xor(ss, s);
    const float rn = __builtin_amdgcn_rsqf(ss * (1.0f / 128.0f) + EPS);
    const f32x4 g0 = *(const f32x4*)(g + 8 * (lane & 15)), g1 = *(const f32x4*)(g + 8 * (lane & 15) + 4);
    y[0] = x[0] * rn * g0.x; y[1] = x[1] * rn * g0.y; y[2] = x[2] * rn * g0.z; y[3] = x[3] * rn * g0.w;
    y[4] = x[4] * rn * g1.x; y[5] = x[5] * rn * g1.y; y[6] = x[6] * rn * g1.z; y[7] = x[7] * rn * g1.w;
    v4u o; o.x = pk2(y[0], y[1]); o.y = pk2(y[2], y[3]); o.z = pk2(y[4], y[5]); o.w = pk2(y[6], y[7]);
    *(v4u*)(p + 8 * lane) = o;
}
__device__ __forceinline__ void token_item(Frame& F, KArgs A, int l, int item) {
    const int lane = F.lane, w = F.wave;
    const int m0 = item * 64 + w * 8, b = m0 >> 11, t0 = m0 & (T - 1);
    bf16* Z = WSP(bf16, WS_Z); bf16* QKM = WSP(bf16, WS_QKM);
    const float* cw = A->in[8] + (size_t)l * 4 * 1024;
    float wq[4][8], wk[4][8];
#pragma unroll
    for (int j = 0; j < 4; ++j)
#pragma unroll
        for (int i = 0; i < 8; ++i) { wq[j][i] = cw[j * 1024 + 8 * lane + i]; wk[j][i] = cw[j * 1024 + 512 + 8 * lane + i]; }
    float hq[3][8], hk[3][8];
#pragma unroll
    for (int j = 0; j < 3; ++j) { const int tt = t0 - 3 + j;
        if (tt >= 0) { const v4u a = *(const v4u*)(Z + (size_t)(m0 - 3 + j) * ZW + Z_MQ + 8 * lane), c = *(const v4u*)(Z + (size_t)(m0 - 3 + j) * ZW + Z_MK + 8 * lane);
            hq[j][0] = bflo(a.x); hq[j][1] = bfhi(a.x); hq[j][2] = bflo(a.y); hq[j][3] = bfhi(a.y); hq[j][4] = bflo(a.z); hq[j][5] = bfhi(a.z); hq[j][6] = bflo(a.w); hq[j][7] = bfhi(a.w);
            hk[j][0] = bflo(c.x); hk[j][1] = bfhi(c.x); hk[j][2] = bflo(c.y); hk[j][3] = bfhi(c.y); hk[j][4] = bflo(c.z); hk[j][5] = bfhi(c.z); hk[j][6] = bflo(c.w); hk[j][7] = bfhi(c.w); }
        else {
#pragma unroll
            for (int i = 0; i < 8; ++i) { hq[j][i] = 0.f; hk[j][i] = 0.f; } } }
    const float* g_bq = A->in[10] + (size_t)l * 256; const float* g_bk = g_bq + 128;
    const float* g_nq = A->in[12] + (size_t)l * 128; const float* g_nks = A->in[13] + (size_t)l * 384 + 128; const float* g_nkw = A->in[13] + (size_t)l * 384 + 256;
    float ksum[8];
#pragma unroll
    for (int i = 0; i < 8; ++i) ksum[i] = 0.f;
#pragma unroll 1
    for (int tk = 0; tk < 8; ++tk) {
        const int m = m0 + tk; bf16* zr = Z + (size_t)m * ZW;
        const v4u a = *(const v4u*)(zr + Z_MQ + 8 * lane), c = *(const v4u*)(zr + Z_MK + 8 * lane);
        float cq[8] = {bflo(a.x), bfhi(a.x), bflo(a.y), bfhi(a.y), bflo(a.z), bfhi(a.z), bflo(a.w), bfhi(a.w)};
        float ck[8] = {bflo(c.x), bfhi(c.x), bflo(c.y), bfhi(c.y), bflo(c.z), bfhi(c.z), bflo(c.w), bfhi(c.w)};
        float oq[8], ok[8];
#pragma unroll
        for (int i = 0; i < 8; ++i) { oq[i] = silu2_f(wq[0][i] * hq[0][i] + wq[1][i] * hq[1][i] + wq[2][i] * hq[2][i] + wq[3][i] * cq[i]);
            ok[i] = silu2_f(wk[0][i] * hk[0][i] + wk[1][i] * hk[1][i] + wk[2][i] * hk[2][i] + wk[3][i] * ck[i]);
            hq[0][i] = hq[1][i]; hq[1][i] = hq[2][i]; hq[2][i] = cq[i]; hk[0][i] = hk[1][i]; hk[1][i] = hk[2][i]; hk[2][i] = ck[i]; }
        v4u o; o.x = pk2(oq[0], oq[1]); o.y = pk2(oq[2], oq[3]); o.z = pk2(oq[4], oq[5]); o.w = pk2(oq[6], oq[7]);
        *(v4u*)(QKM + (size_t)m * 1024 + 8 * lane) = o;
        o.x = pk2(ok[0], ok[1]); o.y = pk2(ok[2], ok[3]); o.z = pk2(ok[4], ok[5]); o.w = pk2(ok[6], ok[7]);
        *(v4u*)(QKM + (size_t)m * 1024 + 512 + 8 * lane) = o;
        float y[8];
        rms_seg(zr + Z_BQ, g_bq, lane, y);
        rms_seg(zr + Z_BK, g_bk, lane, y);
#pragma unroll
        for (int i = 0; i < 8; ++i) ksum[i] += y[i];
        rms_seg(zr + Z_NQ, g_nq, lane, y);
        rms_seg(zr + Z_NKS, g_nks, lane, y);
        rms_seg(zr + Z_NKW, g_nkw, lane, y);
    }
    LAS float* ka = (LAS float*)(F.lds + RING_OFF);
#pragma unroll
    for (int i = 0; i < 8; ++i) ka[w * 512 + 8 * lane + i] = ksum[i];
    __syncthreads();
    { const int col = F.tid; float s = 0.f;
#pragma unroll
      for (int ww = 0; ww < 8; ++ww) s += ka[ww * 512 + col];
      const int t64 = (item * 64) & (T - 1), blk = t64 >> 8, sub = (t64 >> 6) & 3, h = col >> 7, d = col & 127;
      WSP(float, WS_KPART)[((((size_t)(item >> 5) * 4 + h) * 8 + blk) * 4 + sub) * 128 + d] = s; }
    __syncthreads();
}
__device__ __forceinline__ void prep_phase(Frame& F, KArgs A, int l) {
    constexpr int N_CMP = 64, N_CUM = 8, N_TOK = M / 64;
    if (EN2(0)) for (int it = F.bx; it < N_CMP; it += F.G) { compress_item(F, A, l, it); __syncthreads(); }
    if (EN2(1)) for (int it = F.bx - N_CMP; it < N_CUM; it += F.G) { if (it >= 0) cumsum_item(F, A, l, it); }
    if (EN2(2)) for (int it = F.G - 1 - F.bx; it < N_TOK; it += F.G) token_item(F, A, l, it);
}
__device__ __forceinline__ unsigned range_mask(int lo, int hi) {
    const unsigned a = hi >= 31 ? 0xffffffffu : ((1u << (hi + 1)) - 1u); return a & ~((1u << lo) - 1u);
}
#define ATT_IDS() int tid_ = threadIdx.x; asm volatile("" : "+v"(tid_)); const int tid = tid_, wid = __builtin_amdgcn_readfirstlane(tid >> 6), lane = tid & 63, r32 = lane & 31, hi = lane >> 5; (void)tid; (void)lane
template <int TYPE>
__device__ __forceinline__ void unit_linear(Frame& F, KArgs A, int l, int b, int h, int qb) {
    using namespace att; ATT_IDS();
    LAS char* lds = (LAS char*)F.lds;
    const int q0 = qb * 256, q0w = q0 + wid * 32;
    bf16* Z = WSP(bf16, WS_Z) + (size_t)b * T * ZW;
    const bf16* QKM = WSP(bf16, WS_QKM) + (size_t)b * T * 1024;
    bf16x8 qr[8]; LaneCtx lc; lc.tq = q0w + r32; lc.qmask = 0u; lc.a = 0.f; lc.slope2 = 0.f;
    const bf16 *Kh, *Vh; int ldk; const float* Gk = nullptr;
    if (TYPE == 0) { load_q(qr, QKM + (size_t)lc.tq * 1024 + h * HD + hi * 8); Kh = QKM + 512 + h * HD; ldk = 1024; Vh = Z + Z_MV + h * HD;
        Gk = WSP(float, WS_GK) + (size_t)(b * 4 + h) * T; lc.a = WSP(float, WS_FQ)[(size_t)(b * 4 + h) * T + lc.tq]; }
    else { load_q(qr, Z + (size_t)lc.tq * ZW + Z_RQ + h * HD + hi * 8); Kh = Z + Z_RK + h * HD; ldk = ZW; Vh = Z + Z_RV + h * HD;
        lc.slope2 = -log2f(1.0f - exp2f(-5.0f - (float)h)); }
    f32x16 o[4] = {}; float m_reg = -1e29f, l_reg = 0.f;
    const unsigned tmask = causal_tiles(q0 + 255), wmask = causal_tiles(q0w + 31);
    attn_pass<TYPE == 0 ? MD_MLSTM : MD_RET>(lds, Kh, ldk, Vh, ZW, Gk, tmask, wmask, qb, qr, o, m_reg, l_reg, lc);
    LAS float* sl = (LAS float*)(lds + OFF_WS) + wid * 128 + 64;
    float fr[16];
    if (TYPE == 0) { const float den = l_reg + __shfl_xor(l_reg, 32); const float inv = __builtin_amdgcn_rcpf(fmaxf(fabsf(den), 1.0f)); row_bcast(inv, fr, sl, r32, hi); }
    else {
#pragma unroll
        for (int r = 0; r < 16; ++r) fr[r] = 1.0f; }
    bf16* Yp = WSP(bf16, WS_YCAT) + ((size_t)b * T + q0w) * KO + (TYPE == 0 ? 0 : 1024) + h * HD;
    const bf16* gate = Z + (size_t)q0w * ZW + (TYPE == 0 ? Z_MO : Z_RG) + h * HD;
    const float* gain = (TYPE == 0 ? A->in[9] : A->in[11]) + (size_t)l * HD;
    store_rms_gate<TYPE == 0 ? 0 : 1>(o, fr, gain, gate, ZW, Yp, KO, r32, hi);
}
__device__ __forceinline__ void unit_moba(Frame& F, KArgs A, int l, int b, int h, int qb) {
    using namespace att; ATT_IDS();
    LAS char* lds = (LAS char*)F.lds;
    const int q0 = qb * 256, q0w = q0 + wid * 32;
    const bf16* Z = WSP(bf16, WS_Z) + (size_t)b * T * ZW;
    bf16x8 qr[8]; LaneCtx lc; lc.tq = q0w + r32; lc.a = 0.f; lc.slope2 = exp2f(-(float)(2 * h + 1)) * LOG2E; lc.qmask = 0u;
    load_q(qr, Z + (size_t)lc.tq * ZW + Z_BQ + h * HD + hi * 8);
    LAS float* km = (LAS float*)(lds + OFF_KM); LAS unsigned* un = (LAS unsigned*)(lds + OFF_UN);
    const float* kp = WSP(float, WS_KPART) + (size_t)(b * 4 + h) * 8 * 4 * 128;
    for (int idx = tid; idx < qb * 128; idx += NTHR) { const int blk = idx >> 7, d = idx & 127; const float* p = kp + (size_t)blk * 512 + d;
        km[idx] = ((p[0] + p[128]) + (p[256] + p[384])) * (1.0f / 256.0f); }
    if (tid == 0) un[0] = 0u;
    __syncthreads();
    float gv[7];
#pragma unroll
    for (int blk = 0; blk < 7; ++blk) { float g = 0.f;
        if (blk < qb) {
#pragma unroll
            for (int d0 = 0; d0 < 8; ++d0) { const f32x4 k0 = *(const LAS f32x4*)(km + blk * 128 + d0 * 16 + hi * 8), k1 = *(const LAS f32x4*)(km + blk * 128 + d0 * 16 + hi * 8 + 4);
                g += bf2f((bf16)qr[d0][0]) * k0.x + bf2f((bf16)qr[d0][1]) * k0.y + bf2f((bf16)qr[d0][2]) * k0.z + bf2f((bf16)qr[d0][3]) * k0.w
                   + bf2f((bf16)qr[d0][4]) * k1.x + bf2f((bf16)qr[d0][5]) * k1.y + bf2f((bf16)qr[d0][6]) * k1.z + bf2f((bf16)qr[d0][7]) * k1.w; }
            g += __shfl_xor(g, 32); }
        gv[blk] = g; }
    unsigned sel = 0u;
#pragma unroll
    for (int pass = 0; pass < 3; ++pass) { float best = -3.0e38f; int bi = -1;
#pragma unroll
        for (int blk = 0; blk < 7; ++blk) if (blk < qb && !((sel >> blk) & 1u) && gv[blk] > best) { best = gv[blk]; bi = blk; }
        if (bi >= 0) sel |= 1u << bi; }
    lc.qmask = sel;
    const unsigned wsel = wave_or(sel);
    if (lane == 0 && wsel) __hip_atomic_fetch_or(un, wsel, __ATOMIC_RELAXED, __HIP_MEMORY_SCOPE_WORKGROUP);
    __syncthreads();
    const unsigned usel = un[0];
    unsigned tmask = 0xFu << (4 * qb), wmask = causal_tiles(q0w + 31) & (0xFu << (4 * qb));
#pragma unroll
    for (int blk = 0; blk < 7; ++blk) { if ((usel >> blk) & 1u) tmask |= 0xFu << (4 * blk); if ((wsel >> blk) & 1u) wmask |= 0xFu << (4 * blk); }
    f32x16 o[4] = {}; float m_reg = -1e29f, l_reg = 0.f;
    attn_pass<MD_MOBA>(lds, Z + Z_BK + h * HD, ZW, Z + Z_BV + h * HD, ZW, nullptr, tmask, wmask, qb, qr, o, m_reg, l_reg, lc);
    LAS float* sl = (LAS float*)(lds + OFF_WS) + wid * 128 + 64;
    const float lsum = l_reg + __shfl_xor(l_reg, 32);
    float fr[16]; row_bcast(__builtin_amdgcn_rcpf(lsum), fr, sl, r32, hi);
    store_o(o, fr, WSP(bf16, WS_YCAT) + ((size_t)b * T + q0w) * KO + 512 + h * HD, KO, r32, hi);
}
__device__ __forceinline__ void unit_nsa_win(Frame& F, KArgs A, int l, int b, int h, int qb) {
    using namespace att; ATT_IDS();
    LAS char* lds = (LAS char*)F.lds;
    const int q0 = qb * 256, q0w = q0 + wid * 32;
    const bf16* Z = WSP(bf16, WS_Z) + (size_t)b * T * ZW;
    bf16x8 qr[8]; LaneCtx lc; lc.tq = q0w + r32; lc.a = 0.f; lc.slope2 = exp2f(-(float)(2 * h + 2)) * LOG2E; lc.qmask = 0u;
    load_q(qr, Z + (size_t)lc.tq * ZW + Z_NQ + h * HD + hi * 8);
    const int tlo = q0 >= 511 ? (q0 - 511) >> 6 : 0, wlo = q0w >= 511 ? (q0w - 511) >> 6 : 0;
    const unsigned tmask = range_mask(tlo, (q0 + 255) >> 6), wmask = range_mask(wlo, (q0w + 31) >> 6);
    f32x16 o[4] = {}; float m_reg = -1e29f, l_reg = 0.f;
    attn_pass<MD_WIN>(lds, Z + Z_NKW + h * HD, ZW, Z + Z_NVW + h * HD, ZW, nullptr, tmask, wmask, qb, qr, o, m_reg, l_reg, lc);
    LAS float* sl = (LAS float*)(lds + OFF_WS) + wid * 128 + 64;
    const float lsum = l_reg + __shfl_xor(l_reg, 32);
    const float g2 = sigmoid_f(WSP(float, WS_GT)[((size_t)b * T + lc.tq) * 32 + 8 + 2 * 4 + h]);
    float fr[16]; row_bcast(g2 * __builtin_amdgcn_rcpf(lsum), fr, sl, r32, hi);
    store_o(o, fr, WSP(bf16, WS_YCAT) + ((size_t)b * T + q0w) * KO + 2048 + h * HD, KO, r32, hi);
}
__device__ __forceinline__ void unit_nsa_cs(Frame& F, KArgs A, int l, int b, int h, int qb) {
    using namespace att; ATT_IDS();
    LAS char* lds = (LAS char*)F.lds;
    const int q0 = qb * 256, q0w = q0 + wid * 32;
    const bf16* Z = WSP(bf16, WS_Z) + (size_t)b * T * ZW;
    bf16x8 qr[8]; LaneCtx lc; lc.tq = q0w + r32; lc.a = 0.f; lc.slope2 = exp2f(-(float)(2 * h + 2)) * LOG2E; lc.qmask = 0u;
    load_q(qr, Z + (size_t)lc.tq * ZW + Z_NQ + h * HD + hi * 8);
    LAS char* V_lds = lds; LAS char* K_lds = lds + 2 * SHM_V; LAS unsigned* un = (LAS unsigned*)(lds + OFF_UN);
    LAS float* sl = (LAS float*)(lds + OFF_WS) + wid * 128 + 64;
    const float* gt = WSP(float, WS_GT) + ((size_t)b * T + lc.tq) * 32 + 8 + h;
    const float g0 = sigmoid_f(gt[0]), g1 = sigmoid_f(gt[4]);
    f32x16 o[4] = {};
    bf16* Yn = WSP(bf16, WS_YCAT) + ((size_t)b * T + q0w) * KO + 1536 + h * HD;
    {
        const bf16* Kc = WSP(bf16, WS_KCMP) + (size_t)(b * 4 + h) * 128 * 128; const bf16* Vc = WSP(bf16, WS_VCMP) + (size_t)(b * 4 + h) * 128 * 128;
        const int sr = tid >> 4, sc = (tid & 15) * 8, vst0 = v_st(sr, sc), vst1 = v_st(32 + sr, sc), kc = sc * 2;
        if (tid == 0) un[0] = 0u;
#pragma unroll
        for (int t2 = 0; t2 < 2; ++t2) {
            const bf16x8 ks0 = *(const bf16x8*)(Kc + (size_t)(t2 * 64 + sr) * 128 + sc), ks1 = *(const bf16x8*)(Kc + (size_t)(t2 * 64 + 32 + sr) * 128 + sc);
            const bf16x8 vs0 = *(const bf16x8*)(Vc + (size_t)(t2 * 64 + sr) * 128 + sc), vs1 = *(const bf16x8*)(Vc + (size_t)(t2 * 64 + 32 + sr) * 128 + sc);
            *(LAS bf16x8*)(V_lds + t2 * SHM_V + vst0) = vs0; *(LAS bf16x8*)(V_lds + t2 * SHM_V + vst1) = vs1;
            *(LAS bf16x8*)(K_lds + t2 * SHM_K + KSWZ(sr, kc)) = ks0; *(LAS bf16x8*)(K_lds + t2 * SHM_K + KSWZ(32 + sr, kc)) = ks1; }
        __syncthreads();
        f32x16 sA0, sA1, sB0, sB1;
        qkt(sA0, sA1, K_lds, qr, r32, hi); qkt(sB0, sB1, K_lds + SHM_K, qr, r32, hi);
        constexpr float C1 = SCALE * LOG2E;
        const int basec = lc.tq - 31 - 64 * hi;
        const float biasc = -lc.slope2 * (float)basec;
        float mx = -1e30f;
#pragma unroll
        for (int r = 0; r < 16; ++r) { const int c = crc(r);
            const float s0 = fmaf(sA0[r], C1, fmaf(lc.slope2, 16.0f * (float)c, biasc)), s1 = fmaf(sA1[r], C1, fmaf(lc.slope2, 16.0f * (float)(c + 32), biasc));
            const float s2 = fmaf(sB0[r], C1, fmaf(lc.slope2, 16.0f * (float)(c + 64), biasc)), s3 = fmaf(sB1[r], C1, fmaf(lc.slope2, 16.0f * (float)(c + 96), biasc));
            sA0[r] = (16 * c <= basec) ? s0 : -1e30f; sA1[r] = (16 * (c + 32) <= basec) ? s1 : -1e30f;
            sB0[r] = (16 * (c + 64) <= basec) ? s2 : -1e30f; sB1[r] = (16 * (c + 96) <= basec && (c + 96 + 4 * hi) < 127) ? s3 : -1e30f;
            mx = fmaxf(fmaxf(mx, fmaxf(sA0[r], sA1[r])), fmaxf(sB0[r], sB1[r])); }
        mx = fmaxf(swap_max(mx), -1e29f);
        float ps = 0.f;
#pragma unroll
        for (int r = 0; r < 16; ++r) { sA0[r] = __builtin_amdgcn_exp2f(sA0[r] - mx); sA1[r] = __builtin_amdgcn_exp2f(sA1[r] - mx); sB0[r] = __builtin_amdgcn_exp2f(sB0[r] - mx); sB1[r] = __builtin_amdgcn_exp2f(sB1[r] - mx);
            ps += (sA0[r] + sA1[r]) + (sB0[r] + sB1[r]); }
        const float lc_sum = swap_sum(ps);
        const int vb0 = (int)(unsigned)(uintptr_t)V_lds + v_rd_base(lane);
        float Gs[16], last[16];
#pragma unroll
        for (int a = 0; a < 4; ++a) {
            Gs[a] = (sA0[4 * a] + sA0[4 * a + 1]) + (sA0[4 * a + 2] + sA0[4 * a + 3]); last[a] = sA0[4 * a + 3];
            Gs[4 + a] = (sA1[4 * a] + sA1[4 * a + 1]) + (sA1[4 * a + 2] + sA1[4 * a + 3]); last[4 + a] = sA1[4 * a + 3];
            Gs[8 + a] = (sB0[4 * a] + sB0[4 * a + 1]) + (sB0[4 * a + 2] + sB0[4 * a + 3]); last[8 + a] = sB0[4 * a + 3];
            Gs[12 + a] = (sB1[4 * a] + sB1[4 * a + 1]) + (sB1[4 * a + 2] + sB1[4 * a + 3]); last[12 + a] = sB1[4 * a + 3]; }
        bf16x8 pA0, pA1, pA2, pA3, pB0, pB1, pB2, pB3;
        pack_p(sA0, sA1, pA0, pA1, pA2, pA3); pack_p(sB0, sB1, pB0, pB1, pB2, pB3);
        asm volatile("" : "+v"(pA0), "+v"(pA1), "+v"(pA2), "+v"(pA3), "+v"(pB0), "+v"(pB1), "+v"(pB2), "+v"(pB3));
        const int cur = lc.tq >> 6;
        float val[16]; float prevo = 0.f;
#pragma unroll
        for (int i = 0; i < 16; ++i) { const float ol = __shfl_xor(last[i], 32); const float add = hi ? ol : prevo; prevo = ol;
            val[i] = (2 * i + hi < cur) ? (Gs[i] + add) : -1.0f; }
        float cv[6]; int cj[6];
#pragma unroll
        for (int pass = 0; pass < 3; ++pass) { float best = -0.5f; int bi = 64;
#pragma unroll
            for (int i = 0; i < 16; ++i) if (val[i] > best) { best = val[i]; bi = 2 * i + hi; }
            cv[pass] = bi < 64 ? best : -1.0f; cj[pass] = bi;
#pragma unroll
            for (int i = 0; i < 16; ++i) if (2 * i + hi == bi) val[i] = -2.0f; }
#pragma unroll
        for (int k = 0; k < 3; ++k) { cv[3 + k] = __shfl_xor(cv[k], 32); cj[3 + k] = __shfl_xor(cj[k], 32); }
        unsigned sel = 0u;
#pragma unroll
        for (int pass = 0; pass < 3; ++pass) { float best = -0.5f; int bj = 64;
#pragma unroll
            for (int k = 0; k < 6; ++k) if (cv[k] > best || (cv[k] == best && cv[k] >= 0.f && cj[k] < bj)) { best = cv[k]; bj = cj[k]; }
            if (bj < 64) { sel |= 1u << bj;
#pragma unroll
                for (int k = 0; k < 6; ++k) if (cj[k] == bj) cv[k] = -2.0f; } }
        lc.qmask = sel | (1u << cur);
        pv_d0(o, vb0, pA0, pA1, pA2, pA3); pv_d0(o, vb0 + SHM_V, pB0, pB1, pB2, pB3);
        float fr[16]; row_bcast(lc_sum > 0.f ? g0 * __builtin_amdgcn_rcpf(lc_sum) : 0.f, fr, sl, r32, hi);
        store_o(o, fr, Yn, KO, r32, hi);
    }
    const unsigned wsel = wave_or(lc.qmask);
    if (lane == 0) __hip_atomic_fetch_or(un, wsel, __ATOMIC_RELAXED, __HIP_MEMORY_SCOPE_WORKGROUP);
    __syncthreads();
    const unsigned usel = un[0];
#pragma unroll
    for (int d = 0; d < 4; ++d) o[d] = f32x16{};
    float m_reg = -1e29f, l_reg = 0.f;
    attn_pass<MD_SEL>(lds, Z + Z_NKS + h * HD, ZW, Z + Z_NVS + h * HD, ZW, nullptr, usel, wsel, qb, qr, o, m_reg, l_reg, lc);
    const float lsum = l_reg + __shfl_xor(l_reg, 32);
    float fr[16]; row_bcast(g1 * __builtin_amdgcn_rcpf(lsum), fr, sl, r32, hi);
    store_o<true>(o, fr, Yn, KO, r32, hi);
}
#define MIXER_QUEUE(kind, CALL) do { for (;;) { __syncthreads(); \
        if (F.tid == 0) uq[0] = (int)__hip_atomic_fetch_add((unsigned*)(F.ctl + CW_QUEUE + 64 * (l * 8 + (kind))), 1u, RLX_AGENT); \
        __syncthreads(); const int u = __builtin_amdgcn_readfirstlane(uq[0]); if (u >= 256) break; \
        const int qb = 7 - (u >> 5), bh = u & 31, b = bh >> 2, h = bh & 3; CALL; } } while (0)
__device__ __forceinline__ void mixer_phase(Frame& F, KArgs A, int l) {
    LAS int* uq = (LAS int*)(F.lds + att::OFF_UN + 64);
    if (EN2(3)) MIXER_QUEUE(0, unit_linear<0>(F, A, l, b, h, qb));
    if (EN2(4)) MIXER_QUEUE(1, unit_moba(F, A, l, b, h, qb));
    if (EN2(5)) MIXER_QUEUE(2, unit_linear<2>(F, A, l, b, h, qb));
    if (EN2(6)) MIXER_QUEUE(3, unit_nsa_cs(F, A, l, b, h, qb));
    if (EN2(7)) MIXER_QUEUE(4, unit_nsa_win(F, A, l, b, h, qb));
}
__device__ __forceinline__ void router_phase(Frame& F, KArgs A, int l) {
    const int lane = F.lane, w = F.wave, lr = lane & 15, lq = lane >> 4;
    LAS float* lg = (LAS float*)(F.lds) + w * 16 * 52;
    LAS int* hist = (LAS int*)(F.lds + 32768);
    const bf16* HB = WSP(bf16, WS_HB); const bf16* RT = WSP(bf16, WS_RTT) + (size_t)l * 48 * 2048;
    const float* bg = A->in[19] + l * 4; const float* be = A->in[21] + l * 32;
    for (int grp = F.bx; grp < M / 64; grp += F.G) {
        if (F.tid < 64) hist[F.tid] = 0;
        __syncthreads();
        int e0 = 0, e1 = 0, p0 = 0, p1 = 0; float ga = 0.f, gb = 0.f;
        const int t0 = grp * 64 + w * 16;
        if (w < 4) {
            f32x4 acc[3];
#pragma unroll
            for (int i = 0; i < 3; ++i) acc[i] = (f32x4){0.f, 0.f, 0.f, 0.f};
#pragma unroll 4
            for (int ks = 0; ks < 64; ++ks) { const bf16x8 a = *(const bf16x8*)(HB + (size_t)(t0 + lr) * D + ks * 32 + 8 * lq);
#pragma unroll
                for (int nt = 0; nt < 3; ++nt) { const bf16x8 bw = *(const bf16x8*)(RT + (size_t)(nt * 16 + lr) * D + ks * 32 + 8 * lq);
                    acc[nt] = __builtin_amdgcn_mfma_f32_16x16x32_bf16(a, bw, acc[nt], 0, 0, 0); } }
#pragma unroll
            for (int nt = 0; nt < 3; ++nt)
#pragma unroll
                for (int g = 0; g < 4; ++g) lg[(4 * lq + g) * 52 + nt * 16 + lr] = acc[nt][g];
            LDS_WAIT(); asm volatile("" ::: "memory");
            if (lane < 16) {
                const LAS float* row = lg + lane * 52;
                float g4[4]; int gi = 0; float gm = -3.0e38f;
#pragma unroll
                for (int i = 0; i < 4; ++i) { g4[i] = row[i] + bg[i]; if (g4[i] > gm) { gm = g4[i]; gi = i; } }
                float gs = 0.f;
#pragma unroll
                for (int i = 0; i < 4; ++i) gs += __expf(g4[i] - gm);
                const float pgrp = 1.0f / gs;
                float la = -3.0e38f, lb = -3.0e38f; int ia = 0, ib = 0;
#pragma unroll
                for (int i = 0; i < 8; ++i) { const float v = row[4 + gi * 8 + i] + be[gi * 8 + i];
                    if (v > la) { lb = la; ib = ia; la = v; ia = i; } else if (v > lb) { lb = v; ib = i; } }
                const float eb = __expf(lb - la), inv = 1.0f / (1.0f + eb);
                ga = pgrp * inv; gb = pgrp * eb * inv; e0 = gi * 8 + ia; e1 = gi * 8 + ib;
                p0 = __hip_atomic_fetch_add(hist + e0, 1, __ATOMIC_RELAXED, __HIP_MEMORY_SCOPE_WORKGROUP);
                p1 = __hip_atomic_fetch_add(hist + e1, 1, __ATOMIC_RELAXED, __HIP_MEMORY_SCOPE_WORKGROUP);
            }
        }
        __syncthreads();
        if (F.tid < 32) { const int c = hist[F.tid]; int base = 0; if (c) base = (int)__hip_atomic_fetch_add((unsigned*)(F.ctl + CW_CNT + l * 32 + F.tid), (unsigned)c, RLX_AGENT); hist[32 + F.tid] = base; }
        __syncthreads();
        if (w < 4 && lane < 16) { const int m = t0 + lane;
            WSP(int, WS_TOKE)[2 * m] = e0; WSP(int, WS_TOKE)[2 * m + 1] = e1;
            WSP(int, WS_TOKP)[2 * m] = hist[32 + e0] + p0; WSP(int, WS_TOKP)[2 * m + 1] = hist[32 + e1] + p1;
            WSP(float, WS_TOKG)[2 * m] = ga; WSP(float, WS_TOKG)[2 * m + 1] = gb; }
        __syncthreads();
    }
}
__device__ __forceinline__ void expert_starts(Frame& F, int l, LAS int* st, int shift) {
    if (F.tid == 0) { int run = 0;
        for (int e = 0; e < NE; ++e) { st[e] = run; const int c = (int)__hip_atomic_load(F.ctl + CW_CNT + l * 32 + e, RLX_AGENT); run += ((c + 255) >> 8) << (8 - shift); }
        st[NE] = run; }
    __syncthreads();
}
__device__ __forceinline__ void scatter_phase(Frame& F, int l) {
    LAS int* st = (LAS int*)(F.lds + LDSCTL_OFF);
    expert_starts(F, l, st, 0);
    const int gw = F.bx * NWAVES + F.wave, NGW = F.G * NWAVES, lane = F.lane;
    const bf16* HB = WSP(bf16, WS_HB); bf16* XS = WSP(bf16, WS_XS);
    for (int m = gw; m < M; m += NGW) {
        const int e0 = WSP(int, WS_TOKE)[2 * m], e1 = WSP(int, WS_TOKE)[2 * m + 1];
        const int s0 = st[e0] + WSP(int, WS_TOKP)[2 * m], s1 = st[e1] + WSP(int, WS_TOKP)[2 * m + 1];
        const v4u* src = (const v4u*)(HB + (size_t)m * D) + lane; v4u* d0 = (v4u*)(XS + (size_t)s0 * D) + lane; v4u* d1 = (v4u*)(XS + (size_t)s1 * D) + lane;
#pragma unroll
        for (int j = 0; j < 4; ++j) { const v4u v = src[64 * j]; d0[64 * j] = v; d1[64 * j] = v; }
        if (lane == 0) { WSP(int, WS_TOKS)[2 * m] = s0; WSP(int, WS_TOKS)[2 * m + 1] = s1; }
    }
    __syncthreads();
}

constexpr int NPHASE = 22;
#ifndef PH_MASK
#define PH_MASK 0xFFFFu
#endif
#define EN(j) ((PH_MASK >> (j)) & 1u)
#define SITE_FRAME() KArgs A = (KArgs)__builtin_amdgcn_kernarg_segment_ptr(); asm volatile("" : "+s"(A)); Frame F; \
    F.lds = (LAS unsigned char*)lds; F.MISC = (volatile LAS unsigned*)(F.lds + MISC_OFF); F.tid = threadIdx.x; asm volatile("" : "+v"(F.tid)); F.lane = F.tid & 63; F.wave = __builtin_amdgcn_readfirstlane(F.tid >> 6); \
    F.G = gridDim.x; F.bx = blockIdx.x; F.ws = A->ws; F.out = A->out; F.ctl = (gu32*)(F.ws + WS_CTL)
__global__ void __launch_bounds__(NTHR, 2) fwd_kernel(Args args) {
    extern __shared__ __attribute__((aligned(16))) unsigned char lds[];
    int lo, hi;
    {
        SITE_FRAME();
        for (int u = F.tid; u < (LDS_BYTES - LDSCTL_OFF) / 4; u += NTHR) ((LAS unsigned*)(F.lds + LDSCTL_OFF))[u] = 0u;
        __syncthreads();
        lo = A->ph_lo; hi = A->ph_hi;
        if (hi - lo > 1) (void)xcd_barrier_post((unsigned*)(F.ctl + CW_BAR), F.MISC + 8);
    }
#define IN(k) (lo <= (k) && (k) < hi)
#define SEAM(k) do { if (IN(k) && IN((k) + 1)) { SITE_FRAME(); XcdBarrier bar; bar.bar = (unsigned*)(F.ctl + CW_BAR); bar.x = xb_xcc_id(); bar.st = F.MISC + 8; xcd_barrier(bar); } } while (0)
    if (EN(10) && IN(0)) { SITE_FRAME(); p0_prologue(F, A); __syncthreads(); }
    SEAM(0);
    for (int l = 0; l < NL; ++l) {
        const int pb = 1 + 10 * l;
        if (EN(0) && IN(pb + 0)) {
            SITE_FRAME(); const float* modl = WSP(float, WS_MOD) + (size_t)l * 8 * 12288;
            if (l == 0) norm_phase<false, true>(F, A->in[0], nullptr, A->in[2], modl, modl + 2048, nullptr);
            else norm_phase<true, true>(F, F.out, F.out, A->in[2] + (size_t)l * D, modl, modl + 2048, modl - 8 * 12288 + 5 * 2048);
        }
        SEAM(pb + 0);
        if (EN(1) && IN(pb + 1)) {
            SITE_FRAME();
            pg8::Gemm g{WSP(bf16, WS_HB), WSP(bf16, WS_WINT) + (size_t)l * NZP * 2048, M, NZP, D}; pg8::StaticOrder S; S.init(M, NZP, F.G, F.bx);
            pg8::EpiZ E{WSP(bf16, WS_Z), WSP(float, WS_GT)};
            pg8::gemm_phase<pg8::EpiZ, pg8::StaticOrder, true, true>(F.lds + RING_OFF, g, S, E);
        }
        SEAM(pb + 1);
        if (EN(2) && IN(pb + 2)) { SITE_FRAME(); prep_phase(F, A, l); }
        SEAM(pb + 2);
        if (EN(3) && IN(pb + 3)) { SITE_FRAME(); mixer_phase(F, A, l); }
        SEAM(pb + 3);
        if (EN(4) && IN(pb + 4)) {
            SITE_FRAME(); const float* modl = WSP(float, WS_MOD) + (size_t)l * 8 * 12288;
            pg8::Gemm g{WSP(bf16, WS_YCAT), WSP(bf16, WS_WOUTT) + (size_t)l * 2048 * KO, M, D, KO}; pg8::StaticOrder S; S.init(M, D, F.G, F.bx);
            pg8::EpiX1 E{l == 0 ? A->in[0] : (const float*)F.out, F.out, modl + 2 * 2048};
            pg8::gemm_phase<pg8::EpiX1, pg8::StaticOrder, true, true>(F.lds + RING_OFF, g, S, E);
        }
        SEAM(pb + 4);
        if (EN(5) && IN(pb + 5)) { SITE_FRAME(); const float* modl = WSP(float, WS_MOD) + (size_t)l * 8 * 12288;
            norm_phase<false, true>(F, F.out, nullptr, A->in[3] + (size_t)l * D, modl + 3 * 2048, modl + 4 * 2048, nullptr); }
        SEAM(pb + 5);
        if (EN(6) && IN(pb + 6)) { SITE_FRAME(); router_phase(F, A, l); }
        SEAM(pb + 6);
        if (EN(7) && IN(pb + 7)) { SITE_FRAME(); scatter_phase(F, l); }
        SEAM(pb + 7);
        if (EN(8) && IN(pb + 8)) {
            SITE_FRAME();
            LAS int* st = (LAS int*)(F.lds + LDSCTL_OFF); expert_starts(F, l, st, 8);
            const int nrt = st[NE];
            pg8::Gemm g{WSP(bf16, WS_XS), WSP(bf16, WS_W13T) + (size_t)l * NE * 1024 * 2048, SLOTS, NE * 1024, D};
            pg8::GroupedOrder S{nrt * 4, 4, F.G, F.bx, (const LAS int*)st};
            pg8::EpiH E{WSP(bf16, WS_HBUF)};
            pg8::gemm_phase<pg8::EpiH, pg8::GroupedOrder, true, true>(F.lds + RING_OFF, g, S, E);
            __syncthreads();
        }
        SEAM(pb + 8);
        if (EN(9) && IN(pb + 9)) {
            SITE_FRAME();
            LAS int* st = (LAS int*)(F.lds + LDSCTL_OFF); expert_starts(F, l, st, 8);
            const int nrt = st[NE];
            pg8::Gemm g{WSP(bf16, WS_HBUF), WSP(bf16, WS_W2T) + (size_t)l * NE * 2048 * DE, SLOTS, NE * 2048, DE};
            pg8::GroupedOrder S{nrt * 8, 8, F.G, F.bx, (const LAS int*)st};
            pg8::EpiY E{WSP(bf16, WS_Y)};
            pg8::gemm_phase<pg8::EpiY, pg8::GroupedOrder, true, true>(F.lds + RING_OFF, g, S, E);
            __syncthreads();
        }
        SEAM(pb + 9);
    }
    if (EN(11) && IN(21)) { SITE_FRAME(); norm_phase<true, false>(F, F.out, F.out, nullptr, nullptr, nullptr, WSP(float, WS_MOD) + (size_t)1 * 8 * 12288 + 5 * 2048); }
#undef IN
#undef SEAM
}

#ifndef MK_PER_PHASE
#define MK_PER_PHASE 0
#endif
extern "C" void kernel_launch(void* const* d_in, const int* in_sizes, int n_in, void* d_out, int out_size, void* d_ws, size_t ws_size, hipStream_t stream) {
    static int grid = 0;
    if (grid == 0) {
        if (n_in != 25 || in_sizes[0] != M * D || out_size != M * D || ws_size < WS_END) { fprintf(stderr, "kernel_launch: shape/workspace mismatch (n_in %d, ws %zu, need %zu)\n", n_in, ws_size, (size_t)WS_END); grid = -1; return; }
        int dev = 0, cus = 0, per_cu = 0;
        if (hipGetDevice(&dev) != hipSuccess || hipDeviceGetAttribute(&cus, hipDeviceAttributeMultiprocessorCount, dev) != hipSuccess) { grid = -1; return; }
        if (hipFuncSetAttribute((const void*)fwd_kernel, hipFuncAttributeMaxDynamicSharedMemorySize, LDS_BYTES) != hipSuccess) { fprintf(stderr, "kernel_launch: hipFuncSetAttribute failed\n"); grid = -1; return; }
        if (hipOccupancyMaxActiveBlocksPerMultiprocessor(&per_cu, (const void*)fwd_kernel, NTHR, LDS_BYTES) != hipSuccess || per_cu < 1) { fprintf(stderr, "kernel_launch: occupancy query says %d\n", per_cu); }
        (void)hipGetLastError();
        grid = cus;
    }
    if (grid < 0) return;
    if (hipMemsetAsync((char*)d_ws + WS_CTL, 0, CTL_ZERO_BYTES, stream) != hipSuccess) { fprintf(stderr, "kernel_launch: memset failed\n"); return; }
    Args a{};
    for (int i = 0; i < 25; ++i) a.in[i] = (const float*)d_in[i];
    a.out = (float*)d_out; a.ws = (unsigned char*)d_ws;
#if MK_PER_PHASE
    for (int p = 0; p < NPHASE; ++p) { a.ph_lo = p; a.ph_hi = p + 1; hipLaunchKernelGGL(fwd_kernel, dim3(grid), dim3(NTHR), LDS_BYTES, stream, a); }
#else
    a.ph_lo = 0; a.ph_hi = NPHASE;
    hipLaunchKernelGGL(fwd_kernel, dim3(grid), dim3(NTHR), LDS_BYTES, stream, a);
#endif
    const hipError_t le = hipPeekAtLastError();
    if (le != hipSuccess) fprintf(stderr, "kernel_launch: launch failed: %s\n", hipGetErrorName(le));
}
```

```cpp
#include <hip/hip_runtime.h>
#include <cstdio>
#include <cstdint>
__device__ __forceinline__ int mk_lane_fresh() { int l = __builtin_amdgcn_mbcnt_hi(-1, __builtin_amdgcn_mbcnt_lo(-1, 0)); asm volatile("" : "+v"(l)); return l; }
__device__ __forceinline__ float mk_shx(float v, int mask) { return __builtin_bit_cast(float, __builtin_amdgcn_ds_bpermute((mk_lane_fresh() ^ mask) << 2, __builtin_bit_cast(int, v))); }
__device__ __forceinline__ int mk_shx(int v, int mask) { return __builtin_amdgcn_ds_bpermute((mk_lane_fresh() ^ mask) << 2, v); }
__device__ __forceinline__ unsigned mk_shx(unsigned v, int mask) { return (unsigned)__builtin_amdgcn_ds_bpermute((mk_lane_fresh() ^ mask) << 2, (int)v); }
#define __shfl_xor(v, m) mk_shx((v), (m))
#define MK_PER_PHASE 0
namespace pg8 {
#define PG8_LAS __attribute__((address_space(3)))
typedef unsigned short bf16_t;
typedef short bf16x8 __attribute__((ext_vector_type(8)));
typedef float f32x4 __attribute__((ext_vector_type(4)));
typedef unsigned u32x4 __attribute__((ext_vector_type(4)));
constexpr int BM = 256, BK = 64, HALF = 128, HTB = HALF * BK * 2  , STAGE_BYTES = 8 * HTB, NXCD = 8, WGM = 8;

__host__ __device__ __forceinline__ int lds_byte(int r, int c) { const int st = (r >> 4) * 2 + (c >> 5), rr = r & 15, cc = c & 31, ob = rr * 64 + cc * 2; return st * 1024 + (ob ^ (((ob >> 9) & 1) << 5)); }
__host__ __device__ __forceinline__ void stage_rc(int b, int& R, int& C) { const int st = b / 1024, sb = b % 1024, swz = sb ^ (((sb >> 9) & 1) << 5); R = (st >> 1) * 16 + swz / 64; C = (st & 1) * 32 + (swz % 64) / 2; }
__host__ __device__ __forceinline__ int perm32(int rho) { const int n = rho >> 4, i = rho & 15; return 8 * (i >> 2) + 4 * n + (i & 3); }

struct Unit { int pm, pn; };
struct Gemm { const bf16_t* A; const bf16_t* Bt; int M, N, K; };

struct StaticOrder {
    int nM, nN, nwg, G, c;
    __host__ __device__ void init(int M, int N, int G_, int c_) { nM = M / BM; nN = N / BM; nwg = nM * nN; G = G_; c = c_; }
    __host__ __device__ bool next(int i, Unit& u) const {
        const long L = (long)i * G + c; if (L >= nwg) return false;
        int wgid = (int)L; { const int q = nwg / NXCD, r = nwg % NXCD, xcd = wgid % NXCD, off = wgid / NXCD; wgid = (xcd < r ? xcd * (q + 1) : r * (q + 1) + (xcd - r) * q) + off; }
        const int nig = WGM * nN, gid = wgid / nig, fm = gid * WGM, gsz = (nM - fm) < WGM ? (nM - fm) : WGM;
        u.pm = fm + ((wgid % nig) % gsz); u.pn = (wgid % nig) / gsz; return true;
    }
    __device__ __forceinline__ void a_ready(const Unit&) const {}
    __device__ __forceinline__ void done(const Unit&) const {}
};

__device__ __forceinline__ unsigned cvt_pk_bf16(float lo, float hi) { unsigned r; asm volatile("v_cvt_pk_bf16_f32 %0, %1, %2" : "=v"(r) : "v"(lo), "v"(hi)); return r; }
__device__ __forceinline__ float silu_f(float v) { return v * __builtin_amdgcn_rcpf(1.0f + __expf(-v)); }

struct EpiZ {
    static constexpr bool PERM = true, AFTER_DRAIN = false;
    bf16_t* Z; float* Gt; const float* gbq; const float* gnq; const float* gnk; PG8_LAS float* red;
    __device__ __forceinline__ void operator()(const f32x4 (&acc)[2][2][4][2], const Unit& u, int wr, int wc, int fr, int fq) const {
        const int row0 = u.pm * BM + wr * 64 + fr;
        const int col0 = u.pn * BM + wc * 32 + 8 * fq;
        const int pn = u.pn;
        const float* gp = nullptr;
        if (pn == 8 || pn == 9) gp = gbq; else if (pn == 10 || pn == 11) gp = gbq + 128; else if (pn == 22 || pn == 23) gp = gnq; else if (pn == 28 || pn == 29) gp = gnk + 128; else if (pn == 32 || pn == 33) gp = gnk + 256;
        if (gp == nullptr) {
#pragma unroll
            for (int ai = 0; ai < 2; ++ai)
#pragma unroll
                for (int m = 0; m < 4; ++m) { bf16_t* rowp = Z + (size_t)(row0 + ai * HALF + m * 16) * 9216 + col0;
#pragma unroll
                    for (int bj = 0; bj < 2; ++bj) { const f32x4 v0 = acc[ai][bj][m][0], v1 = acc[ai][bj][m][1];
                        u32x4 w; w.x = cvt_pk_bf16(v0[0], v0[1]); w.y = cvt_pk_bf16(v0[2], v0[3]); w.z = cvt_pk_bf16(v1[0], v1[1]); w.w = cvt_pk_bf16(v1[2], v1[3]);
                        *(u32x4*)(rowp + bj * HALF) = w; } }
        } else {
            const f32x4 g0 = *(const f32x4*)(gp + wc * 32 + 8 * fq), g1 = *(const f32x4*)(gp + wc * 32 + 8 * fq + 4);
#pragma unroll
            for (int ai = 0; ai < 2; ++ai)
#pragma unroll
                for (int m = 0; m < 4; ++m)
#pragma unroll
                    for (int bj = 0; bj < 2; ++bj) { const f32x4 v0 = acc[ai][bj][m][0], v1 = acc[ai][bj][m][1];
                        float ss = (v0[0] * v0[0] + v0[1] * v0[1]) + (v0[2] * v0[2] + v0[3] * v0[3]) + (v1[0] * v1[0] + v1[1] * v1[1]) + (v1[2] * v1[2] + v1[3] * v1[3]);
                        ss += __shfl_xor(ss, 16); ss += __shfl_xor(ss, 32);
                        if (fq == 0) red[((wr * 64 + fr + ai * HALF + m * 16) * 2 + bj) * 4 + wc] = ss; }
            asm volatile("s_waitcnt lgkmcnt(0)" ::: "memory"); __builtin_amdgcn_s_barrier(); asm volatile("" ::: "memory");
#pragma unroll
            for (int ai = 0; ai < 2; ++ai)
#pragma unroll
                for (int m = 0; m < 4; ++m) { bf16_t* rowp = Z + (size_t)(row0 + ai * HALF + m * 16) * 9216 + col0;
#pragma unroll
                    for (int bj = 0; bj < 2; ++bj) { const f32x4 t = *(const PG8_LAS f32x4*)(red + ((wr * 64 + fr + ai * HALF + m * 16) * 2 + bj) * 4);
                        const float rn = __builtin_amdgcn_rsqf(((t[0] + t[1]) + (t[2] + t[3])) * (1.0f / 128.0f) + 1e-6f);
                        const f32x4 v0 = acc[ai][bj][m][0] * rn * g0, v1 = acc[ai][bj][m][1] * rn * g1;
                        u32x4 w; w.x = cvt_pk_bf16(v0[0], v0[1]); w.y = cvt_pk_bf16(v0[2], v0[3]); w.z = cvt_pk_bf16(v1[0], v1[1]); w.w = cvt_pk_bf16(v1[2], v1[3]);
                        *(u32x4*)(rowp + bj * HALF) = w; } }
        }
    }
};
struct EpiX1 {
    static constexpr bool PERM = true, AFTER_DRAIN = false;
    const float* xin; bf16_t* out; const float* g1;
    __device__ __forceinline__ void operator()(const f32x4 (&acc)[2][2][4][2], const Unit& u, int wr, int wc, int fr, int fq) const {
        const int row0 = u.pm * BM + wr * 64 + fr, col0 = u.pn * BM + wc * 32 + 8 * fq;
        const float* gb = g1 + (size_t)(u.pm >> 3) * 12288 + col0;
        f32x4 gv[2][2];
#pragma unroll
        for (int bj = 0; bj < 2; ++bj)
#pragma unroll
            for (int n = 0; n < 2; ++n) gv[bj][n] = *(const f32x4*)(gb + bj * HALF + 4 * n);
#pragma unroll
        for (int ai = 0; ai < 2; ++ai)
#pragma unroll
            for (int m = 0; m < 4; ++m) { const size_t off = (size_t)(row0 + ai * HALF + m * 16) * 2048 + col0;
#pragma unroll
                for (int bj = 0; bj < 2; ++bj) { const f32x4 x0 = *(const f32x4*)(xin + off + bj * HALF), x1 = *(const f32x4*)(xin + off + bj * HALF + 4);
                    const f32x4 v0 = x0 + gv[bj][0] * acc[ai][bj][m][0], v1 = x1 + gv[bj][1] * acc[ai][bj][m][1];
                    u32x4 w; w.x = cvt_pk_bf16(v0[0], v0[1]); w.y = cvt_pk_bf16(v0[2], v0[3]); w.z = cvt_pk_bf16(v1[0], v1[1]); w.w = cvt_pk_bf16(v1[2], v1[3]);
                    *(u32x4*)(out + off + bj * HALF) = w; } }
    }
};
struct EpiH {
    static constexpr bool PERM = true, AFTER_DRAIN = false;
    bf16_t* H;
    __device__ __forceinline__ void operator()(const f32x4 (&acc)[2][2][4][2], const Unit& u, int wr, int wc, int fr, int fq) const {
        const int row0 = u.pm * BM + wr * 64 + fr, col0 = (u.pn & 3) * 128 + wc * 32 + 8 * fq;
#pragma unroll
        for (int ai = 0; ai < 2; ++ai)
#pragma unroll
            for (int m = 0; m < 4; ++m) { const f32x4 a0 = acc[ai][0][m][0], a1 = acc[ai][0][m][1], b0 = acc[ai][1][m][0], b1 = acc[ai][1][m][1];
                u32x4 w; w.x = cvt_pk_bf16(silu_f(a0[0]) * b0[0], silu_f(a0[1]) * b0[1]); w.y = cvt_pk_bf16(silu_f(a0[2]) * b0[2], silu_f(a0[3]) * b0[3]);
                w.z = cvt_pk_bf16(silu_f(a1[0]) * b1[0], silu_f(a1[1]) * b1[1]); w.w = cvt_pk_bf16(silu_f(a1[2]) * b1[2], silu_f(a1[3]) * b1[3]);
                *(u32x4*)(H + (size_t)(row0 + ai * HALF + m * 16) * 512 + col0) = w; }
    }
};
struct EpiY {
    static constexpr bool PERM = true, AFTER_DRAIN = false;
    bf16_t* Y;
    __device__ __forceinline__ void operator()(const f32x4 (&acc)[2][2][4][2], const Unit& u, int wr, int wc, int fr, int fq) const {
        const int row0 = u.pm * BM + wr * 64 + fr, col0 = (u.pn & 7) * BM + wc * 32 + 8 * fq;
#pragma unroll
        for (int ai = 0; ai < 2; ++ai)
#pragma unroll
            for (int m = 0; m < 4; ++m) { bf16_t* rowp = Y + (size_t)(row0 + ai * HALF + m * 16) * 2048 + col0;
#pragma unroll
                for (int bj = 0; bj < 2; ++bj) { const f32x4 v0 = acc[ai][bj][m][0], v1 = acc[ai][bj][m][1];
                    u32x4 w; w.x = cvt_pk_bf16(v0[0], v0[1]); w.y = cvt_pk_bf16(v0[2], v0[3]); w.z = cvt_pk_bf16(v1[0], v1[1]); w.w = cvt_pk_bf16(v1[2], v1[3]);
                    *(u32x4*)(rowp + bj * HALF) = w; } }
    }
};
struct GroupedOrder {
    int nU, NCT, G, c; const PG8_LAS int* tstart; const int* tokl;
    __device__ __forceinline__ bool next(int i, Unit& u) const {
        const long L = (long)i * G + c; if (L >= nU) return false;
        int wgid = (int)L; { const int q = nU / NXCD, r = nU % NXCD, xcd = wgid % NXCD, off = wgid / NXCD; wgid = (xcd < r ? xcd * (q + 1) : r * (q + 1) + (xcd - r) * q) + off; }
        const int rt = wgid / NCT, ct = wgid - rt * NCT;
        int e = 0;
#pragma unroll
        for (int k = 1; k < 32; ++k) e += (tstart[k] <= rt) ? 1 : 0;
        e = __builtin_amdgcn_readfirstlane(e);
        u.pm = rt; u.pn = e * NCT + ct; return true;
    }
    __device__ __forceinline__ int row_token(const Unit& u, int r) const { const int e = u.pn / NCT; const int pos = (u.pm - tstart[e]) * 256 + r, last = tstart[33 + e] - 1; return tokl[e * 16384 + (pos < last ? pos : last)]; }
    __device__ __forceinline__ void a_ready(const Unit&) const {}
    __device__ __forceinline__ void done(const Unit&) const {}
};
template <class Epi, class Sched, bool ALIGN_EPI = false, bool SP2 = false, bool GATHER = false>
__device__ __forceinline__ void gemm_phase(PG8_LAS unsigned char* lds, const Gemm g, const Sched& S, const Epi& E) {
    int tid_ = threadIdx.x; asm volatile("" : "+v"(tid_));
    const int tid = tid_, wid = __builtin_amdgcn_readfirstlane(tid >> 6), lane = tid & 63, wr = wid >> 2, wc = wid & 3, fr = lane & 15, fq = lane >> 4;
    const int K = g.K, nt = K / BK;
    unsigned voffA[2], voffB[2]; int Rrow[2]; unsigned Ccol2[2];
#pragma unroll
    for (int i = 0; i < 2; ++i) { int R, C; stage_rc(tid * 16 + i * 8192, R, C); const int Rb = Epi::PERM ? ((R & ~31) + perm32(R & 31)) : R;
        voffA[i] = (unsigned)(R * K + C) * 2u; voffB[i] = (unsigned)(Rb * K + C) * 2u; Rrow[i] = R; Ccol2[i] = (unsigned)C * 2u; }
    unsigned gC0[2] = {0u, 0u}, gC1[2] = {0u, 0u}, gN0[2] = {0u, 0u}, gN1[2] = {0u, 0u}, sx0[2] = {0u, 0u}, sx1[2] = {0u, 0u};
#define PG8_GROWS(D0, D1, U) do { _Pragma("unroll") for (int _i = 0; _i < 2; ++_i) { D0[_i] = (unsigned)S.row_token(U, Rrow[_i]) * (unsigned)(K * 2) + Ccol2[_i]; D1[_i] = (unsigned)S.row_token(U, HALF + Rrow[_i]) * (unsigned)(K * 2) + Ccol2[_i]; } } while (0)
#define VA0C (GATHER ? gC0 : voffA)
#define VA1C (GATHER ? gC1 : voffA)
#define VA0X (GATHER ? sx0 : voffA)
#define VA1X (GATHER ? sx1 : voffA)
#define AH(p) (GATHER ? (p) : (p) + hstep)
    const size_t kstep = (size_t)(BK * 2);
    const size_t hstep = (size_t)HALF * K * 2;
    const size_t tstep = 2 * hstep;
    const unsigned ldsw = (unsigned)wid * 1024u;
    const int aoff = lds_byte(wr * 64 + fr, fq * 8), boff = lds_byte(wc * 32 + fr, fq * 8);
#define PG8_SA(b, h) (((b) * 2 + (h)) * HTB)
#define PG8_SB(b, h) ((4 + (b) * 2 + (h)) * HTB)
#define PG8_STAGE(bufoff, gbase, voff) do { _Pragma("unroll") for (int _i = 0; _i < 2; ++_i) \
        __builtin_amdgcn_global_load_lds((const unsigned*)((const char*)(gbase) + (voff)[_i]), (PG8_LAS unsigned*)(lds + (bufoff) + ldsw + _i * 8192), 16, 0, 0); } while (0)
#define PG8_LDA(dst, b, h) do { _Pragma("unroll") for (int m = 0; m < 4; ++m) _Pragma("unroll") for (int k = 0; k < 2; ++k) dst[m][k] = *(const PG8_LAS bf16x8*)(lds + PG8_SA(b, h) + aoff + m * 2048 + k * 1024); } while (0)
#define PG8_LDB(dst, b, h) do { _Pragma("unroll") for (int n = 0; n < 2; ++n) _Pragma("unroll") for (int k = 0; k < 2; ++k) dst[n][k] = *(const PG8_LAS bf16x8*)(lds + PG8_SB(b, h) + boff + n * 2048 + k * 1024); } while (0)
#define PG8_MMA(ai, bj, At, Bt) do { __builtin_amdgcn_s_setprio(1); _Pragma("unroll") for (int m = 0; m < 4; ++m) _Pragma("unroll") for (int n = 0; n < 2; ++n) _Pragma("unroll") for (int k = 0; k < 2; ++k) \
        acc[ai][bj][m][n] = __builtin_amdgcn_mfma_f32_16x16x32_bf16(Bt[n][k], At[m][k], acc[ai][bj][m][n], 0, 0, 0); __builtin_amdgcn_s_setprio(0); } while (0)
#define PG8_WAIT_V(n) asm volatile("s_waitcnt vmcnt(" #n ")" ::: "memory")
#define PG8_WAIT_L(n) asm volatile("s_waitcnt lgkmcnt(" #n ")" ::: "memory")
#define PG8_BAR __builtin_amdgcn_s_barrier()
#define PG8_SCHED __builtin_amdgcn_sched_barrier(0)
    Unit cur, nxt; int ui = 0;
    if (!S.next(0, cur)) return;
    f32x4 acc[2][2][4][2];
#pragma unroll
    for (int a = 0; a < 2; ++a)
#pragma unroll
        for (int b = 0; b < 2; ++b)
#pragma unroll
            for (int m = 0; m < 4; ++m)
#pragma unroll
                for (int n = 0; n < 2; ++n) acc[a][b][m][n] = (f32x4){0.f, 0.f, 0.f, 0.f};
    bf16x8 At[4][2], B0[2][2], B1[2][2];
    const char* cA = (const char*)g.A + (GATHER ? (size_t)0 : (size_t)cur.pm * tstep); const char* cB = (const char*)g.Bt + (size_t)cur.pn * tstep;
    S.a_ready(cur);
    if constexpr (GATHER) { PG8_GROWS(gC0, gC1, cur); }
    if constexpr (SP2) {
        PG8_STAGE(PG8_SB(0, 0), cB, voffB); PG8_STAGE(PG8_SB(0, 1), cB + hstep, voffB); PG8_STAGE(PG8_SA(0, 0), cA, VA0C); PG8_STAGE(PG8_SA(0, 1), AH(cA), VA1C);
        if (wr == 1) PG8_BAR;
        PG8_WAIT_V(2); PG8_BAR;
        PG8_STAGE(PG8_SB(1, 0), cB + kstep, voffB); PG8_STAGE(PG8_SA(1, 0), cA + kstep, VA0C); PG8_STAGE(PG8_SB(1, 1), cB + hstep + kstep, voffB);
        PG8_WAIT_V(6); PG8_BAR;
    } else {
        PG8_STAGE(PG8_SB(0, 0), cB, voffB); PG8_STAGE(PG8_SA(0, 0), cA, voffA); PG8_STAGE(PG8_SB(0, 1), cB + hstep, voffB); PG8_STAGE(PG8_SA(0, 1), cA + hstep, voffA);
        if (wr == 1) PG8_BAR;
        PG8_WAIT_V(4); PG8_BAR;
        PG8_STAGE(PG8_SB(1, 0), cB + kstep, voffB); PG8_STAGE(PG8_SA(1, 0), cA + kstep, voffA); PG8_STAGE(PG8_SB(1, 1), cB + hstep + kstep, voffB);
        PG8_WAIT_V(6); PG8_BAR;
    }
    for (;;) {
        const bool has_next = S.next(ui + 1, nxt);
        const char* nA = (has_next && !GATHER) ? (const char*)g.A + (size_t)nxt.pm * tstep : cA; const char* nB = has_next ? (const char*)g.Bt + (size_t)nxt.pn * tstep : cB;
        if constexpr (GATHER) { if (has_next) { PG8_GROWS(gN0, gN1, nxt); } else { _Pragma("unroll") for (int _i = 0; _i < 2; ++_i) { gN0[_i] = gC0[_i]; gN1[_i] = gC1[_i]; } } }
        for (int t = 0; t < nt; t += 2) {
            const bool last = (t == nt - 2);
            const char* a1 = cA + (size_t)(t + 1) * kstep;
            const char* a2 = last ? nA : cA + (size_t)(t + 2) * kstep; const char* b2 = last ? nB : cB + (size_t)(t + 2) * kstep;
            const char* a3 = a2 + kstep; const char* b3 = b2 + kstep;
            if (last && has_next) S.a_ready(nxt);
            if constexpr (GATHER) { _Pragma("unroll") for (int _i = 0; _i < 2; ++_i) { sx0[_i] = last ? gN0[_i] : gC0[_i]; sx1[_i] = last ? gN1[_i] : gC1[_i]; } }
            if constexpr (SP2) {
            PG8_LDB(B0, 0, 0); PG8_LDB(B1, 0, 1); PG8_SCHED; PG8_LDA(At, 0, 0); PG8_STAGE(PG8_SA(1, 1), AH(a1), VA1C);
            PG8_WAIT_V(8); PG8_WAIT_L(0); PG8_BAR; PG8_MMA(0, 0, At, B0); PG8_MMA(0, 1, At, B1); PG8_BAR; PG8_SCHED;
            PG8_LDA(At, 0, 1); PG8_STAGE(PG8_SB(0, 0), b2, voffB); PG8_STAGE(PG8_SB(0, 1), b2 + hstep, voffB); PG8_STAGE(PG8_SA(0, 0), a2, VA0X);
            PG8_WAIT_V(8); PG8_WAIT_L(0); PG8_BAR; PG8_MMA(1, 0, At, B0); PG8_MMA(1, 1, At, B1); PG8_BAR; PG8_SCHED;
            PG8_LDB(B0, 1, 0); PG8_LDB(B1, 1, 1); PG8_SCHED; PG8_LDA(At, 1, 0); PG8_STAGE(PG8_SA(0, 1), AH(a2), VA1X);
            PG8_WAIT_V(8); PG8_WAIT_L(0); PG8_BAR; PG8_MMA(0, 0, At, B0); PG8_MMA(0, 1, At, B1); PG8_BAR; PG8_SCHED;
            PG8_LDA(At, 1, 1); PG8_STAGE(PG8_SB(1, 0), b3, voffB); PG8_STAGE(PG8_SB(1, 1), b3 + hstep, voffB); PG8_STAGE(PG8_SA(1, 0), a3, VA0X);
            PG8_WAIT_V(8); PG8_WAIT_L(0); PG8_BAR; PG8_MMA(1, 0, At, B0); PG8_MMA(1, 1, At, B1); PG8_BAR; PG8_SCHED;
            } else {
            PG8_LDB(B0, 0, 0); PG8_SCHED; PG8_LDA(At, 0, 0); PG8_STAGE(PG8_SA(1, 1), a1 + hstep, voffA);
            PG8_WAIT_L(8); PG8_BAR; PG8_WAIT_L(0); PG8_MMA(0, 0, At, B0); PG8_BAR; PG8_SCHED;
            PG8_LDB(B1, 0, 1); PG8_STAGE(PG8_SB(0, 0), b2, voffB);
            PG8_BAR; PG8_WAIT_L(0); PG8_MMA(0, 1, At, B1); PG8_BAR;
            PG8_LDA(At, 0, 1); PG8_STAGE(PG8_SA(0, 0), a2, voffA);
            PG8_BAR; PG8_WAIT_L(0); PG8_MMA(1, 0, At, B0); PG8_BAR; PG8_SCHED;
            PG8_STAGE(PG8_SB(0, 1), b2 + hstep, voffB);
            PG8_WAIT_V(6); PG8_BAR; PG8_MMA(1, 1, At, B1); PG8_BAR;
            PG8_LDB(B0, 1, 0); PG8_SCHED; PG8_LDA(At, 1, 0); PG8_STAGE(PG8_SA(0, 1), a2 + hstep, voffA);
            PG8_WAIT_L(8); PG8_BAR; PG8_WAIT_L(0); PG8_MMA(0, 0, At, B0); PG8_BAR; PG8_SCHED;
            PG8_LDB(B1, 1, 1); PG8_STAGE(PG8_SB(1, 0), b3, voffB);
            PG8_BAR; PG8_WAIT_L(0); PG8_MMA(0, 1, At, B1); PG8_BAR;
            PG8_LDA(At, 1, 1); PG8_STAGE(PG8_SA(1, 0), a3, voffA);
            PG8_BAR; PG8_WAIT_L(0); PG8_MMA(1, 0, At, B0); PG8_BAR; PG8_SCHED;
            PG8_STAGE(PG8_SB(1, 1), b3 + hstep, voffB);
            PG8_WAIT_V(6); PG8_BAR; PG8_MMA(1, 1, At, B1); PG8_BAR;
            }
        }
        if constexpr (ALIGN_EPI) { if (wr == 0) PG8_BAR; }
        if constexpr (!Epi::AFTER_DRAIN) { E(acc, cur, wr, wc, fr, fq); S.done(cur); }
        if (!has_next) break;
#pragma unroll
        for (int a = 0; a < 2; ++a)
#pragma unroll
            for (int b = 0; b < 2; ++b)
#pragma unroll
                for (int m = 0; m < 4; ++m)
#pragma unroll
                    for (int n = 0; n < 2; ++n) acc[a][b][m][n] = (f32x4){0.f, 0.f, 0.f, 0.f};
        cur = nxt; cA = nA; cB = nB; ++ui;
        if constexpr (GATHER) { _Pragma("unroll") for (int _i = 0; _i < 2; ++_i) { gC0[_i] = gN0[_i]; gC1[_i] = gN1[_i]; } }
        if constexpr (ALIGN_EPI) { if (wr == 1) PG8_BAR; }
    }
    PG8_WAIT_V(0);
    if constexpr (!ALIGN_EPI) { if (wr == 0) PG8_BAR; }
    PG8_BAR;
    if constexpr (Epi::AFTER_DRAIN) { E.fused(acc, cur, wr, wc, fr, fq, lds, wid, lane); S.done(cur); }
#undef PG8_GROWS
#undef VA0C
#undef VA1C
#undef VA0X
#undef VA1X
#undef AH
#undef PG8_SA
#undef PG8_SB
#undef PG8_STAGE
#undef PG8_LDA
#undef PG8_LDB
#undef PG8_MMA
#undef PG8_WAIT_V
#undef PG8_WAIT_L
#undef PG8_BAR
#undef PG8_SCHED
}
}

constexpr int NWAVES = 8, NTHR = 512;
constexpr int BATCH = 8, T = 2048, D = 2048, M = BATCH * T, NL = 2;
constexpr int DIN = 9236, ZW = 9216, NZP = 9216;
constexpr int HD = 128, NH = 4;
constexpr int KO = 2048;
constexpr int NE = 32, DE = 512;
constexpr int SLOTS = 2 * M + NE * 256;
constexpr float EPS = 1e-6f;
constexpr float LOG2E = 1.4426950408889634f;
constexpr float SCALE = 0.088388347648318440f;
constexpr int Z_MQ = 0, Z_MK = 512, Z_MV = 1024, Z_MO = 1536, Z_BQ = 2048, Z_BK = 2560, Z_BV = 3072, Z_RQ = 3584, Z_RK = 4096, Z_RV = 4608, Z_RG = 5120,
              Z_NQ = 5632, Z_NKC = 6144, Z_NVC = 6656, Z_NKS = 7168, Z_NVS = 7680, Z_NKW = 8192, Z_NVW = 8704;
constexpr size_t MiB = 1u << 20;
constexpr size_t WS_CTL = 0, CTL_ZERO_BYTES = 1 * MiB;
constexpr size_t WS_MOD = 1 * MiB;
constexpr size_t WS_GT = 2 * MiB;
constexpr size_t WS_FQ = 4 * MiB;
constexpr size_t WS_GK = 4 * MiB + 512 * 1024;
constexpr size_t WS_EK = 4 * MiB + 768 * 1024;
constexpr size_t WS_KPART = 5 * MiB;
constexpr size_t WS_KCMP = 6 * MiB;
constexpr size_t WS_VCMP = 7 * MiB;
constexpr size_t WS_CB1 = 8 * MiB;
constexpr size_t WS_TOKE = 8 * MiB + 64 * 1024;
constexpr size_t WS_TOKP = WS_TOKE + 128 * 1024;
constexpr size_t WS_TOKG = WS_TOKP + 128 * 1024;
constexpr size_t WS_TOKS = WS_TOKG + 128 * 1024;
constexpr size_t WS_RTT = 9 * MiB;
constexpr size_t WS_GWF = 9 * MiB + 512 * 1024;
constexpr size_t WS_CW1T = 10 * MiB;
constexpr size_t WS_CW2T = 14 * MiB;
constexpr size_t WS_WINT = 16 * MiB;
constexpr size_t WS_WOUTT = 90 * MiB;
constexpr size_t WS_W13T = 110 * MiB;
constexpr size_t WS_W2T = 366 * MiB;
constexpr size_t WS_HB = 500 * MiB;
constexpr size_t WS_Z = 564 * MiB;
constexpr size_t WS_QKM = 852 * MiB;
constexpr size_t WS_YCAT = 884 * MiB;
constexpr size_t WS_XS = 564 * MiB;
constexpr size_t WS_HBUF = 724 * MiB;
constexpr size_t WS_Y = 764 * MiB;
constexpr size_t WS_TOKL = 964 * MiB;
constexpr size_t WS_X1 = 966 * MiB;
constexpr size_t WS_US = 1030 * MiB;
constexpr size_t WS_NS = 1058 * MiB;
constexpr size_t WS_END = 1060 * MiB;
constexpr int CW_BAR = 4096;
constexpr int CW_QUEUE = 8192;
constexpr int CW_CNT = 8192 + 4096;
constexpr int CW_RDY = 32768;
constexpr int RING_OFF = 0, RING_BYTES = 131072;
constexpr int LDSCTL_OFF = RING_BYTES, MISC_OFF = LDSCTL_OFF + 320;
constexpr int LDS_BYTES = 147456;

#define GAS __attribute__((address_space(1)))
#define LAS __attribute__((address_space(3)))
typedef unsigned short bf16;
typedef unsigned v4u __attribute__((ext_vector_type(4)));
typedef unsigned v2u __attribute__((ext_vector_type(2)));
typedef float f32x4 __attribute__((ext_vector_type(4)));
typedef float f32x16 __attribute__((ext_vector_type(16)));
typedef short bf16x8 __attribute__((ext_vector_type(8)));
typedef short s16x4 __attribute__((ext_vector_type(4)));
typedef GAS unsigned gu32;
#define RLX_AGENT __ATOMIC_RELAXED, __HIP_MEMORY_SCOPE_AGENT
#define LDS_WAIT() asm volatile("s_waitcnt lgkmcnt(0)" ::: "memory")
#define VM_WAIT() asm volatile("s_waitcnt vmcnt(0)" ::: "memory")
__device__ __forceinline__ unsigned f2bf(float f) { unsigned u = __builtin_bit_cast(unsigned, f); return (u + 0x7fffu + ((u >> 16) & 1u)) >> 16; }
__device__ __forceinline__ unsigned pk2(float lo, float hi) { return f2bf(lo) | (f2bf(hi) << 16); }
__device__ __forceinline__ float bflo(unsigned w) { return __uint_as_float(w << 16); }
__device__ __forceinline__ float bfhi(unsigned w) { return __uint_as_float(w & 0xffff0000u); }
__device__ __forceinline__ float bf2f(bf16 b) { return __uint_as_float(((unsigned)b) << 16); }
__device__ __forceinline__ float wave_sum(float v) {
#pragma unroll
    for (int o = 1; o < 64; o <<= 1) v += __shfl_xor(v, o);
    return v;
}
__device__ __forceinline__ float sigmoid_f(float v) { return __builtin_amdgcn_rcpf(1.0f + __expf(-v)); }
__device__ __forceinline__ float silu2_f(float v) { return v * sigmoid_f(v); }

#ifndef PH_MASK2
#define PH_MASK2 0xFFFFu
#endif
#define EN2(j) ((PH_MASK2 >> (j)) & 1u)
#ifndef DUP_MASK
#define DUP_MASK 0u
#endif
#define XB_TMO      128
#define XB_XCNT(j)  (256  + 64 * (j))
#define XB_XSUB(j)  (1280 + 64 * (j))
#define XB_XGEN(j)  (2304 + 64 * (j))
#define XB_TOP      3328
#define XB_TOPGEN   3392
#define XCD_BAR_WORDS 3456
#define XB_SPIN_CAP (1u << 18)

__device__ __forceinline__ unsigned xb_ld(unsigned* p)              { return __hip_atomic_load(p, __ATOMIC_RELAXED, __HIP_MEMORY_SCOPE_AGENT); }
__device__ __forceinline__ unsigned xb_add(unsigned* p, unsigned v) { return __hip_atomic_fetch_add(p, v, __ATOMIC_RELAXED, __HIP_MEMORY_SCOPE_AGENT); }
__device__ __forceinline__ unsigned xb_xcc_id() { return (unsigned)__builtin_amdgcn_s_getreg((3 << 11) | 20) & 0xFu; }
#define XB_SPIN(cond, bar) do { unsigned _sp = 0; while (cond) { __builtin_amdgcn_s_sleep(1); \
    if ((++_sp & 255u) == 0u) { if (xb_ld(&(bar)[XB_TMO])) break; if (_sp > XB_SPIN_CAP) { atomicAdd(&(bar)[XB_TMO], 1u); break; } } } } while (0)

struct XcdBarrier {
    unsigned* bar; unsigned x;
    volatile LAS unsigned* st;
};

__device__ __forceinline__ XcdBarrier xcd_barrier_post(unsigned* bar, volatile LAS unsigned* st) {
    XcdBarrier b; b.bar = bar; b.x = xb_xcc_id(); b.st = st;
    if (threadIdx.x == 0) (void)xb_add(&bar[XB_XCNT(b.x)], 1u);
    return b;
}
__device__ __forceinline__ void xcd_barrier_complete(unsigned* bar, unsigned x, unsigned& nloc, unsigned& nx) {
    const unsigned G = gridDim.x * gridDim.y * gridDim.z;
    unsigned sum, cnt, mine, sp = 0u;
    for (;;) {
        sum = 0u; cnt = 0u; mine = 0u;
#pragma unroll
        for (unsigned j = 0; j < 16; ++j) { const unsigned c = xb_ld(&bar[XB_XCNT(j)]); sum += c; cnt += (c > 0u) ? 1u : 0u; mine = (j == x) ? c : mine; }
        if (sum == G) break;
        __builtin_amdgcn_s_sleep(1);
        if ((++sp & 255u) == 0u) { if (xb_ld(&bar[XB_TMO])) break; if (sp > XB_SPIN_CAP) { atomicAdd(&bar[XB_TMO], 1u); break; } }
    }
    nloc = mine > 0u ? mine : 1u; nx = cnt > 0u ? cnt : 1u;
}

__device__ __forceinline__ void xcd_barrier(const XcdBarrier& b) {
    asm volatile("s_waitcnt vmcnt(0)" ::: "memory");
    __syncthreads();
    if (threadIdx.x == 0) {
        unsigned* bar = b.bar;
        __builtin_amdgcn_s_waitcnt(0);
        unsigned nloc = b.st[0], nx = b.st[1];
        if (nloc == 0u) { xcd_barrier_complete(bar, b.x, nloc, nx); b.st[0] = nloc; b.st[1] = nx; }
        const unsigned old = xb_add(&bar[XB_XSUB(b.x)], 1u);
        const unsigned gen = old / nloc;
        if (old + 1u == (gen + 1u) * nloc) {
            __builtin_amdgcn_fence(__ATOMIC_RELEASE, "agent");
            asm volatile("s_waitcnt vmcnt(0)" ::: "memory");
            const unsigned og = xb_add(&bar[XB_TOP], 1u);
            const unsigned tg = og / nx;
            if (og + 1u == (tg + 1u) * nx) xb_add(&bar[XB_TOPGEN], 1u);
            else XB_SPIN(xb_ld(&bar[XB_TOPGEN]) == tg, bar);
            __builtin_amdgcn_fence(__ATOMIC_ACQUIRE, "agent");
            xb_add(&bar[XB_XGEN(b.x)], 1u);
            asm volatile("s_waitcnt vmcnt(0)" ::: "memory");
        } else {
            XB_SPIN(xb_ld(&bar[XB_XGEN(b.x)]) == gen, bar);
            __builtin_amdgcn_fence(__ATOMIC_ACQUIRE, "agent");
            asm volatile("s_waitcnt vmcnt(0)" ::: "memory");
        }
    }
    __syncthreads();
}
namespace att {
constexpr int SHM_V = 64 * 128 * 2, SHM_K = 64 * 128 * 2;
constexpr int OFF_K = 3 * 16384;
constexpr int OFF_WS = 81920;
constexpr int OFF_GT = OFF_WS + 4096;
constexpr int OFF_KM = OFF_GT + 1024;
constexpr int OFF_UN = OFF_KM + 4096;
constexpr int OFF_HID = OFF_UN + 256;
constexpr float THR2 = 11.5f;
#define KSWZ(row, colB) ((row) * 256 + ((colB) ^ (((row) & 7) << 4)))
#define SBAR() __builtin_amdgcn_sched_barrier(0)
__device__ __forceinline__ constexpr int crc(int r) { return (r & 3) + 8 * (r >> 2); }
__device__ __forceinline__ int crow(int r, int hi) { return (r & 3) + 8 * (r >> 2) + 4 * hi; }
__device__ __forceinline__ unsigned cvtpk(float lo, float hi) { unsigned r; asm volatile("v_cvt_pk_bf16_f32 %0, %1, %2" : "=v"(r) : "v"(lo), "v"(hi)); return r; }
__device__ __forceinline__ float swap_max(float v) { auto rr = __builtin_amdgcn_permlane32_swap(__float_as_uint(v), __float_as_uint(v), false, false); return fmaxf(__uint_as_float(rr[0]), __uint_as_float(rr[1])); }
__device__ __forceinline__ float swap_sum(float v) { auto rr = __builtin_amdgcn_permlane32_swap(__float_as_uint(v), __float_as_uint(v), false, false); return __uint_as_float(rr[0]) + __uint_as_float(rr[1]); }

struct KAddr { int a[4]; };
__device__ __forceinline__ KAddr k_addr(int r32, int hi) { KAddr k; const int sw = (r32 & 7) << 4;
#pragma unroll
    for (int q = 0; q < 4; ++q) k.a[q] = r32 * 256 + ((q * 32 + hi * 16) ^ sw);
    return k; }
__device__ __forceinline__ void qkt(f32x16& p0, f32x16& p1, const LAS char* Ks, const bf16x8 (&qr)[8], const KAddr& ka) {
    p0 = f32x16{}; p1 = f32x16{};
#pragma unroll
    for (int d0 = 0; d0 < 8; ++d0) {
        const bf16x8 b0 = *(const LAS bf16x8*)(Ks + ka.a[d0 & 3] + (d0 >> 2) * 128);
        const bf16x8 b1 = *(const LAS bf16x8*)(Ks + ka.a[d0 & 3] + (d0 >> 2) * 128 + 8192);
        p0 = __builtin_amdgcn_mfma_f32_32x32x16_bf16(b0, qr[d0], p0, 0, 0, 0);
        p1 = __builtin_amdgcn_mfma_f32_32x32x16_bf16(b1, qr[d0], p1, 0, 0, 0); }
}
__device__ __forceinline__ int v_st(int k, int c) { const int kk = (k & ~0xC) | ((k & 4) << 1) | ((k & 8) >> 1); return ((kk >> 3) * 4 + (c >> 5)) * 512 + ((kk & 7) * 32 + (c & 31)) * 2; }
__device__ __forceinline__ int v_rd_base(int lane) { return ((lane & 3) << 3) | (((lane >> 2) & 3) << 6) | (((lane >> 4) & 1) << 5) | (((lane >> 5) & 1) << 8); }
constexpr int v_rd_off(int d0, int ks, int half) { return d0 * 512 + ks * 4096 + half * 2048; }
template <int OFF> __device__ __forceinline__ s16x4 tr_read(int vb) { s16x4 r; asm volatile("ds_read_b64_tr_b16 %0, %1 offset:%2" : "=&v"(r) : "v"(vb), "i"(OFF) : "memory"); return r; }
template <int D0> __device__ __forceinline__ void pv_one(f32x16& od, int vb, bf16x8 pa0, bf16x8 pa1, bf16x8 pa2, bf16x8 pa3) {
    const s16x4 l0 = tr_read<v_rd_off(D0, 0, 0)>(vb), h0 = tr_read<v_rd_off(D0, 0, 1)>(vb), l1 = tr_read<v_rd_off(D0, 1, 0)>(vb), h1 = tr_read<v_rd_off(D0, 1, 1)>(vb);
    const s16x4 l2 = tr_read<v_rd_off(D0, 2, 0)>(vb), h2 = tr_read<v_rd_off(D0, 2, 1)>(vb), l3 = tr_read<v_rd_off(D0, 3, 0)>(vb), h3 = tr_read<v_rd_off(D0, 3, 1)>(vb);
    asm volatile("s_waitcnt lgkmcnt(0)" ::: "memory"); SBAR();
#define PKV(L, H) (bf16x8){L[0], L[1], L[2], L[3], H[0], H[1], H[2], H[3]}
    od = __builtin_amdgcn_mfma_f32_32x32x16_bf16(pa0, PKV(l0, h0), od, 0, 0, 0);
    od = __builtin_amdgcn_mfma_f32_32x32x16_bf16(pa1, PKV(l1, h1), od, 0, 0, 0);
    od = __builtin_amdgcn_mfma_f32_32x32x16_bf16(pa2, PKV(l2, h2), od, 0, 0, 0);
    od = __builtin_amdgcn_mfma_f32_32x32x16_bf16(pa3, PKV(l3, h3), od, 0, 0, 0);
#undef PKV
}
#define PV_RD(D0, L0, H0, L1, H1, L2, H2, L3, H3) do { L0 = tr_read<v_rd_off(D0, 0, 0)>(vb); H0 = tr_read<v_rd_off(D0, 0, 1)>(vb); L1 = tr_read<v_rd_off(D0, 1, 0)>(vb); H1 = tr_read<v_rd_off(D0, 1, 1)>(vb); \
        L2 = tr_read<v_rd_off(D0, 2, 0)>(vb); H2 = tr_read<v_rd_off(D0, 2, 1)>(vb); L3 = tr_read<v_rd_off(D0, 3, 0)>(vb); H3 = tr_read<v_rd_off(D0, 3, 1)>(vb); } while (0)
#define PV_MM(OD, L0, H0, L1, H1, L2, H2, L3, H3) do { \
        OD = __builtin_amdgcn_mfma_f32_32x32x16_bf16(pa0, ((bf16x8){L0[0], L0[1], L0[2], L0[3], H0[0], H0[1], H0[2], H0[3]}), OD, 0, 0, 0); \
        OD = __builtin_amdgcn_mfma_f32_32x32x16_bf16(pa1, ((bf16x8){L1[0], L1[1], L1[2], L1[3], H1[0], H1[1], H1[2], H1[3]}), OD, 0, 0, 0); \
        OD = __builtin_amdgcn_mfma_f32_32x32x16_bf16(pa2, ((bf16x8){L2[0], L2[1], L2[2], L2[3], H2[0], H2[1], H2[2], H2[3]}), OD, 0, 0, 0); \
        OD = __builtin_amdgcn_mfma_f32_32x32x16_bf16(pa3, ((bf16x8){L3[0], L3[1], L3[2], L3[3], H3[0], H3[1], H3[2], H3[3]}), OD, 0, 0, 0); } while (0)
__device__ __forceinline__ void pv_d0(f32x16 (&o)[4], int vb, bf16x8 pa0, bf16x8 pa1, bf16x8 pa2, bf16x8 pa3) {
    s16x4 a0, a1, a2, a3, a4, a5, a6, a7, b0, b1, b2, b3, b4, b5, b6, b7;
    PV_RD(0, a0, a1, a2, a3, a4, a5, a6, a7);
    PV_RD(1, b0, b1, b2, b3, b4, b5, b6, b7);
    asm volatile("s_waitcnt lgkmcnt(8)" ::: "memory"); SBAR();
    PV_MM(o[0], a0, a1, a2, a3, a4, a5, a6, a7);
    SBAR(); PV_RD(2, a0, a1, a2, a3, a4, a5, a6, a7);
    asm volatile("s_waitcnt lgkmcnt(8)" ::: "memory"); SBAR();
    PV_MM(o[1], b0, b1, b2, b3, b4, b5, b6, b7);
    SBAR(); PV_RD(3, b0, b1, b2, b3, b4, b5, b6, b7);
    asm volatile("s_waitcnt lgkmcnt(8)" ::: "memory"); SBAR();
    PV_MM(o[2], a0, a1, a2, a3, a4, a5, a6, a7);
    asm volatile("s_waitcnt lgkmcnt(0)" ::: "memory"); SBAR();
    PV_MM(o[3], b0, b1, b2, b3, b4, b5, b6, b7);
}
#undef PV_RD
#undef PV_MM
__device__ __forceinline__ void pack_p(const f32x16& p0, const f32x16& p1, bf16x8& pa0, bf16x8& pa1, bf16x8& pa2, bf16x8& pa3) {
#define PK4(P, BASE, OUT) do { unsigned a0 = cvtpk(P[BASE + 0], P[BASE + 1]), a1 = cvtpk(P[BASE + 2], P[BASE + 3]);   \
    unsigned b0 = cvtpk(P[BASE + 4], P[BASE + 5]), b1 = cvtpk(P[BASE + 6], P[BASE + 7]);                              \
    auto r0 = __builtin_amdgcn_permlane32_swap(a0, b0, false, false); auto r1 = __builtin_amdgcn_permlane32_swap(a1, b1, false, false); \
    v4u w = {r0[0], r1[0], r0[1], r1[1]}; OUT = __builtin_bit_cast(bf16x8, w); } while (0)
    PK4(p0, 0, pa0); PK4(p0, 8, pa1); PK4(p1, 0, pa2); PK4(p1, 8, pa3);
#undef PK4
}
__device__ __forceinline__ void rescale_o(f32x16 (&o)[4], float a, LAS float* al_l, int r32, int hi) {
    if (hi == 0) al_l[r32] = a;
    asm volatile("s_waitcnt lgkmcnt(0)" ::: "memory");
#pragma unroll
    for (int r = 0; r < 16; ++r) { const float f = al_l[crow(r, hi)];
#pragma unroll
        for (int d = 0; d < 4; ++d) o[d][r] *= f; }
}
__device__ __forceinline__ void row_bcast(float v, float (&out)[16], LAS float* sl, int r32, int hi) {
    asm volatile("s_waitcnt lgkmcnt(0)" ::: "memory");
    if (hi == 0) sl[r32] = v;
    asm volatile("s_waitcnt lgkmcnt(0)" ::: "memory");
#pragma unroll
    for (int r = 0; r < 16; ++r) out[r] = sl[crow(r, hi)];
    asm volatile("s_waitcnt lgkmcnt(0)" ::: "memory");
}

enum { MD_MLSTM = 0, MD_MOBA = 1, MD_RET = 2, MD_SEL = 3, MD_WIN = 4 };
struct LaneCtx { int tq; float a; float slope2; unsigned qmask; };

__device__ __forceinline__ unsigned cvtpk_s(float lo, float hi) { typedef float f32x2_t __attribute__((ext_vector_type(2))); typedef __bf16 bf16x2_t __attribute__((ext_vector_type(2)));
    f32x2_t v = {lo, hi}; bf16x2_t b = __builtin_convertvector(v, bf16x2_t); return __builtin_bit_cast(unsigned, b); }
__device__ __forceinline__ void pack_p_s(const f32x16& p0, const f32x16& p1, bf16x8& pa0, bf16x8& pa1, bf16x8& pa2, bf16x8& pa3) {
#define PK4(P, BASE, OUT) do { unsigned a0 = cvtpk_s(P[BASE + 0], P[BASE + 1]), a1 = cvtpk_s(P[BASE + 2], P[BASE + 3]);   \
    unsigned b0 = cvtpk_s(P[BASE + 4], P[BASE + 5]), b1 = cvtpk_s(P[BASE + 6], P[BASE + 7]);                              \
    auto r0 = __builtin_amdgcn_permlane32_swap(a0, b0, false, false); auto r1 = __builtin_amdgcn_permlane32_swap(a1, b1, false, false); \
    v4u w = {r0[0], r1[0], r0[1], r1[1]}; OUT = __builtin_bit_cast(bf16x8, w); } while (0)
    PK4(p0, 0, pa0); PK4(p0, 8, pa1); PK4(p1, 0, pa2); PK4(p1, 8, pa3);
#undef PK4
}
#define QK_ISSUE(C0, C1) do { C0 = f32x16{}; C1 = f32x16{}; _Pragma("unroll") for (int d0 = 0; d0 < 8; ++d0) { \
        const bf16x8 b0_ = *(const LAS bf16x8*)(Kbuf + ka.a[d0 & 3] + (d0 >> 2) * 128); const bf16x8 b1_ = *(const LAS bf16x8*)(Kbuf + ka.a[d0 & 3] + (d0 >> 2) * 128 + 8192); \
        C0 = __builtin_amdgcn_mfma_f32_32x32x16_bf16(b0_, qr[d0], C0, 0, 0, 0); C1 = __builtin_amdgcn_mfma_f32_32x32x16_bf16(b1_, qr[d0], C1, 0, 0, 0); } } while (0)
#define MIX_SCHED(NV) do { _Pragma("unroll") for (int g_ = 0; g_ < 16; ++g_) { __builtin_amdgcn_sched_group_barrier(0x100, 1, 0); __builtin_amdgcn_sched_group_barrier(0x002, NV, 0); __builtin_amdgcn_sched_group_barrier(0x008, 1, 0); } } while (0)
template <int MODE>
__device__ __forceinline__ void tile_step(f32x16& c0, f32x16& c1, const LAS char* Kbuf, const bf16x8 (&qr)[8], const KAddr& ka,
                                          f32x16& p0, f32x16& p1, int vb0, LAS float* al_l, const LAS float* gtab, int j, int vbuf, int qb, int q0w, int r32, int hi,
                                          f32x16 (&o)[4], float& m_reg, float& l_reg, const LaneCtx& lc) {
    constexpr float C1 = SCALE * LOG2E;
    float sl2 = lc.slope2; asm volatile("" : "+v"(sl2));
    const int k0 = j * 64;
    const int base = lc.tq - k0 - 4 * hi;
    const float bias0 = -sl2 * (float)base;
    bf16x8 pa0, pa1, pa2, pa3;
    if (MODE == MD_MOBA || MODE == MD_SEL || MODE == MD_WIN) {
        bool lane_ok = true, chk_c = false, chk_w = false;
        if (MODE == MD_MOBA) { const int blk = j >> 2; if (blk == qb) chk_c = (k0 + 63 > q0w); else lane_ok = (lc.qmask >> blk) & 1u; }
        if (MODE == MD_SEL) { lane_ok = (lc.qmask >> j) & 1u; chk_c = (k0 + 63 > q0w); }
        if (MODE == MD_WIN) { chk_c = (k0 + 63 > q0w); chk_w = (q0w + 31 - k0 >= 512); }
        const float biasl = lane_ok ? bias0 : -1e30f;
        if (!(chk_c || chk_w)) {
#pragma unroll
            for (int r = 0; r < 16; ++r) { p0[r] = fmaf(p0[r], C1, fmaf(sl2, (float)crc(r), biasl)); p1[r] = fmaf(p1[r], C1, fmaf(sl2, (float)(crc(r) + 32), biasl)); }
        } else {
#pragma unroll
            for (int r = 0; r < 16; ++r) {
                const int cc0 = crc(r), cc1 = crc(r) + 32;
                const float s0 = fmaf(p0[r], C1, fmaf(sl2, (float)cc0, biasl)), s1 = fmaf(p1[r], C1, fmaf(sl2, (float)cc1, biasl));
                bool v0 = true, v1 = true;
                if (chk_c) { v0 = (cc0 <= base); v1 = (cc1 <= base); }
                if (chk_w) { v0 = v0 && (base - cc0 < 512); v1 = v1 && (base - cc1 < 512); }
                p0[r] = v0 ? s0 : -1e30f; p1[r] = v1 ? s1 : -1e30f;
            }
        }
        float pmax = p0[0];
#pragma unroll
        for (int r = 1; r < 16; ++r) pmax = fmaxf(pmax, p0[r]);
#pragma unroll
        for (int r = 0; r < 16; ++r) pmax = fmaxf(pmax, p1[r]);
        pmax = swap_max(pmax);
        float mn, alpha;
        if (__all(pmax - m_reg <= THR2)) { mn = m_reg; alpha = 1.f; }
        else { mn = fmaxf(m_reg, pmax); alpha = __builtin_amdgcn_exp2f(m_reg - mn); m_reg = mn; rescale_o(o, alpha, al_l, r32, hi); }
        __builtin_amdgcn_sched_barrier(0);
        QK_ISSUE(c0, c1);
        float ps = 0.f;
#pragma unroll
        for (int r = 0; r < 16; ++r) { p0[r] = __builtin_amdgcn_exp2f(p0[r] - mn); p1[r] = __builtin_amdgcn_exp2f(p1[r] - mn); ps += p0[r] + p1[r]; }
        l_reg = l_reg * alpha + ps;
        pack_p_s(p0, p1, pa0, pa1, pa2, pa3);
        MIX_SCHED(8);
        __builtin_amdgcn_sched_barrier(0);
    } else {
        const bool chk_c = (k0 + 63 > q0w);
        if (MODE == MD_MLSTM) {
            const LAS float* gt = gtab + vbuf * 80 + 4 * hi;
            const float B = __builtin_amdgcn_exp2f(lc.a + (-3.5f) + gtab[vbuf * 80 + 64]);
            f32x4 g0[4], g1[4];
#pragma unroll
            for (int a = 0; a < 4; ++a) { g0[a] = *(const LAS f32x4*)(gt + 8 * a); g1[a] = *(const LAS f32x4*)(gt + 32 + 8 * a); }
            asm volatile("s_waitcnt lgkmcnt(0)" ::: "memory");
            __builtin_amdgcn_sched_barrier(0);
            QK_ISSUE(c0, c1);
            float ps = 0.f;
#pragma unroll
            for (int a = 0; a < 4; ++a)
#pragma unroll
                for (int i = 0; i < 4; ++i) { const int r = 4 * a + i; const int cc0 = crc(r), cc1 = crc(r) + 32;
                    float w0 = B * g0[a][i], w1 = B * g1[a][i];
                    if (chk_c) { w0 = (cc0 <= base) ? w0 : 0.f; w1 = (cc1 <= base) ? w1 : 0.f; }
                    p0[r] *= w0; p1[r] *= w1; ps += p0[r] + p1[r]; }
            l_reg += ps;
            pack_p_s(p0, p1, pa0, pa1, pa2, pa3);
            MIX_SCHED(8);
            __builtin_amdgcn_sched_barrier(0);
        } else {
            __builtin_amdgcn_sched_barrier(0);
            QK_ISSUE(c0, c1);
            const float B = __builtin_amdgcn_exp2f(bias0 + (-3.5f)), e32 = __builtin_amdgcn_exp2f(sl2 * 32.0f);
            float e1[4], b8[4];
#pragma unroll
            for (int q = 0; q < 4; ++q) { e1[q] = __builtin_amdgcn_exp2f(sl2 * (float)q); b8[q] = B * __builtin_amdgcn_exp2f(sl2 * (float)(8 * q)); }
#pragma unroll
            for (int r = 0; r < 16; ++r) { const int cc0 = crc(r), cc1 = crc(r) + 32;
                float w0 = b8[r >> 2] * e1[r & 3], w1 = w0 * e32;
                if (chk_c) { w0 = (cc0 <= base) ? w0 : 0.f; w1 = (cc1 <= base) ? w1 : 0.f; }
                p0[r] *= w0; p1[r] *= w1; }
            pack_p_s(p0, p1, pa0, pa1, pa2, pa3);
            MIX_SCHED(6);
            __builtin_amdgcn_sched_barrier(0);
        }
    }
    pv_d0(o, vb0 + vbuf * SHM_V, pa0, pa1, pa2, pa3);
}
template <int MODE>
__device__ __forceinline__ void attn_pass(LAS char* lds, const bf16* __restrict__ Kh, int ldk, const bf16* __restrict__ Vh, int ldv, const float* __restrict__ Gk, const float* __restrict__ Ek,
                                          unsigned tmask, unsigned wmask, int qb, const bf16x8 (&qr)[8], f32x16 (&o)[4], float& m_reg, float& l_reg, const LaneCtx& lc) {
    int tid_ = threadIdx.x; asm volatile("" : "+v"(tid_));
    const int tid = tid_, wid = __builtin_amdgcn_readfirstlane(tid >> 6), lane = tid & 63, r32 = lane & 31, hi = lane >> 5;
    LAS char* V_lds = lds; LAS char* K_lds = lds + OFF_K;
    LAS float* al_l = (LAS float*)(lds + OFF_WS) + wid * 128;
    LAS float* gtab = (LAS float*)(lds + OFF_GT);
    const int vb0 = (int)(unsigned)(uintptr_t)V_lds + v_rd_base(lane);
    bf16x8 ks0, ks1, vs0, vs1; float gst = 0.f;
#define STG_IDS() int t2_ = tid; asm volatile("" : "+v"(t2_)); const int sr = t2_ >> 4, sc = (t2_ & 15) * 8
#define SLOAD(k0) do { STG_IDS(); ks0 = *(const bf16x8*)(Kh + (size_t)((k0) + sr) * ldk + sc); ks1 = *(const bf16x8*)(Kh + (size_t)((k0) + 32 + sr) * ldk + sc); \
        vs0 = *(const bf16x8*)(Vh + (size_t)((k0) + sr) * ldv + sc); vs1 = *(const bf16x8*)(Vh + (size_t)((k0) + 32 + sr) * ldv + sc); \
        if (MODE == MD_MLSTM) { if (t2_ < 65) gst = (t2_ < 64) ? Ek[(k0) + t2_] : Gk[(k0)]; } } while (0)
#define SWRITE(kb, vb) do { STG_IDS(); const int vst0 = v_st(sr, sc), vst1 = v_st(32 + sr, sc), kc = sc * 2; \
        *(LAS bf16x8*)(V_lds + (vb) * SHM_V + vst0) = vs0; *(LAS bf16x8*)(V_lds + (vb) * SHM_V + vst1) = vs1; \
        *(LAS bf16x8*)(K_lds + (kb) * SHM_K + KSWZ(sr, kc)) = ks0; *(LAS bf16x8*)(K_lds + (kb) * SHM_K + KSWZ(32 + sr, kc)) = ks1; \
        if (MODE == MD_MLSTM) { if (t2_ < 65) gtab[(vb) * 80 + t2_] = gst; } } while (0)
#define WG_BAR() do { asm volatile("s_waitcnt lgkmcnt(0)" ::: "memory"); __builtin_amdgcn_s_barrier(); asm volatile("" ::: "memory"); } while (0)
    if (tmask == 0u) return;
    (void)wmask;
    const int q0w = qb * 256 + wid * 32;
    unsigned rem = tmask; int jc = __builtin_ctz(rem); rem &= rem - 1u;
    const int jsafe = jc;
    SLOAD(jc * 64);
    int kb = 0, vb = 0, jp = 0, vp = 0;
    f32x16 pA0, pA1, pB0, pB1; const KAddr ka = k_addr(r32, hi);
    { SWRITE(kb, vb); WG_BAR();
      int jn = -1; if (rem) { jn = __builtin_ctz(rem); rem &= rem - 1u; }
      SLOAD((jn < 0 ? jsafe : jn) * 64);
      qkt(pA0, pA1, K_lds + kb * SHM_K, qr, ka);
      jp = jc; vp = vb; jc = jn; kb ^= 1; vb = 1; }
#define STEP(PC0, PC1, PP0, PP1) do { \
        SWRITE(kb, vb); WG_BAR(); \
        int jn = -1; if (rem) { jn = __builtin_ctz(rem); rem &= rem - 1u; } \
        SLOAD((jn < 0 ? jsafe : jn) * 64); \
        tile_step<MODE>(PC0, PC1, K_lds + kb * SHM_K, qr, ka, PP0, PP1, vb0, al_l, gtab, jp, vp, qb, q0w, r32, hi, o, m_reg, l_reg, lc); \
        last = (jc < 0); jp = jc; vp = vb; jc = jn; kb ^= 1; vb = (vb == 2) ? 0 : vb + 1; } while (0)
    for (;;) { bool last;
        STEP(pB0, pB1, pA0, pA1); if (last) break;
        STEP(pA0, pA1, pB0, pB1); if (last) break;
    }
    __syncthreads();
#undef STEP
#undef STG_IDS
#undef SLOAD
#undef SWRITE
#undef WG_BAR
}
template <bool ACCUM = false>
__device__ __forceinline__ void store_o(const f32x16 (&o)[4], const float (&fr)[16], bf16* Yp, int ldy, int r32, int hi) {
    bf16* Yl = Yp + (size_t)(4 * hi) * ldy + r32;
    float pv[16][4];
#pragma unroll
    for (int rg = 0; rg < 4; ++rg) { bf16* base = Yl; asm volatile("" : "+v"(base));
#pragma unroll
        for (int i = 0; i < 4; ++i)
#pragma unroll
            for (int d = 0; d < 4; ++d) pv[4 * rg + i][d] = ACCUM ? bf2f(base[(size_t)crc(4 * rg + i) * ldy + d * 32]) : 0.f; }
    if (ACCUM) __builtin_amdgcn_sched_barrier(0);
#pragma unroll
    for (int rg = 0; rg < 4; ++rg) { bf16* base = Yl; asm volatile("" : "+v"(base));
#pragma unroll
        for (int i = 0; i < 4; ++i) { const int r = 4 * rg + i;
#pragma unroll
            for (int d = 0; d < 4; ++d) base[(size_t)crc(r) * ldy + d * 32] = (bf16)f2bf(o[d][r] * fr[r] + pv[r][d]); } }
}
template <int GACT>
__device__ __forceinline__ void store_rms_gate(f32x16 (&o)[4], const float (&fr)[16], const float* __restrict__ gain, const bf16* __restrict__ gate, int ldg, bf16* Yp, int ldy, int r32, int hi) {
    float gn[4];
#pragma unroll
    for (int d = 0; d < 4; ++d) gn[d] = gain[d * 32 + r32];
    const bf16* Gl = gate + (size_t)(4 * hi) * ldg + r32; bf16* Yl = Yp + (size_t)(4 * hi) * ldy + r32;
    float gv[16][4];
#pragma unroll
    for (int rg = 0; rg < 4; ++rg) { const bf16* gp = Gl; asm volatile("" : "+v"(gp));
#pragma unroll
        for (int i = 0; i < 4; ++i)
#pragma unroll
            for (int d = 0; d < 4; ++d) gv[4 * rg + i][d] = bf2f(gp[(size_t)crc(4 * rg + i) * ldg + d * 32]); }
    __builtin_amdgcn_sched_barrier(0);
#pragma unroll
    for (int rg = 0; rg < 4; ++rg) { bf16* yp = Yl; asm volatile("" : "+v"(yp));
#pragma unroll
        for (int i = 0; i < 4; ++i) { const int r = 4 * rg + i;
            float ss = 0.f;
#pragma unroll
            for (int d = 0; d < 4; ++d) { o[d][r] *= fr[r]; ss += o[d][r] * o[d][r]; }
#pragma unroll
            for (int x = 1; x < 32; x <<= 1) ss += __shfl_xor(ss, x);
            const float rn = __builtin_amdgcn_rsqf(ss * (1.0f / 128.0f) + EPS);
#pragma unroll
            for (int d = 0; d < 4; ++d) { const float ga = GACT == 0 ? sigmoid_f(gv[r][d]) : silu2_f(gv[r][d]);
                yp[(size_t)crc(r) * ldy + d * 32] = (bf16)f2bf(o[d][r] * rn * gn[d] * ga); } } }
}
template <int KIND>
__device__ __forceinline__ void epi_store(const f32x16 (&o)[4], float srow, const float* gain, const bf16* gate, int ldg, bf16* Yp, int ldy, LAS float* stg, int lane_) {
    int lane = lane_; asm volatile("" : "+v"(lane));
    const int r32 = lane & 31, hi = lane >> 5, rowT = lane >> 3, ch = lane & 7;
    float one = 1.0f; asm volatile("" : "+v"(one));
    asm volatile("s_waitcnt lgkmcnt(0)" ::: "memory"); __builtin_amdgcn_sched_barrier(0);
#pragma unroll
    for (int rnd = 0; rnd < 4; ++rnd) {
#pragma unroll
        for (int rr = 0; rr < 4; ++rr) { const int r = 4 * rnd + rr; const int rl = rr + 4 * hi;
#pragma unroll
            for (int dd = 0; dd < 4; ++dd) stg[rl * 132 + dd * 32 + r32] = o[dd][r] * one; }
        asm volatile("s_waitcnt lgkmcnt(0)" ::: "memory");
        const int row = 8 * rnd + rowT;
        const float s = __builtin_bit_cast(float, __builtin_amdgcn_ds_bpermute(row << 2, __builtin_bit_cast(int, srow)));
        v4u gq[2];
        if (KIND >= 2) { gq[0] = *(const v4u*)(gate + (size_t)row * ldg + ch * 16); gq[1] = *(const v4u*)(gate + (size_t)row * ldg + ch * 16 + 8); }
        if (KIND == 1) { gq[0] = *(const v4u*)(Yp + (size_t)row * ldy + ch * 16); gq[1] = *(const v4u*)(Yp + (size_t)row * ldy + ch * 16 + 8); }
        f32x4 v[4];
#pragma unroll
        for (int k = 0; k < 4; ++k) v[k] = *(const LAS f32x4*)(stg + rowT * 132 + ch * 16 + 4 * k) * s;
        asm volatile("s_waitcnt lgkmcnt(0)" ::: "memory");
        if (KIND >= 2) {
            float ss = 0.f;
#pragma unroll
            for (int k = 0; k < 4; ++k) ss += (v[k].x * v[k].x + v[k].y * v[k].y) + (v[k].z * v[k].z + v[k].w * v[k].w);
            ss += __shfl_xor(ss, 1); ss += __shfl_xor(ss, 2); ss += __shfl_xor(ss, 4);
            const float rn = __builtin_amdgcn_rsqf(ss * (1.0f / 128.0f) + EPS);
#pragma unroll
            for (int k = 0; k < 4; ++k) { const f32x4 g = *(const f32x4*)(gain + ch * 16 + 4 * k); const unsigned w0 = (k & 1) ? gq[k >> 1].z : gq[k >> 1].x, w1 = (k & 1) ? gq[k >> 1].w : gq[k >> 1].y;
                const float a0 = bflo(w0), a1 = bfhi(w0), a2 = bflo(w1), a3 = bfhi(w1);
                f32x4 ga; ga.x = KIND == 2 ? sigmoid_f(a0) : silu2_f(a0); ga.y = KIND == 2 ? sigmoid_f(a1) : silu2_f(a1); ga.z = KIND == 2 ? sigmoid_f(a2) : silu2_f(a2); ga.w = KIND == 2 ? sigmoid_f(a3) : silu2_f(a3);
                v[k] = v[k] * rn * g * ga; }
        }
        if (KIND == 1) {
#pragma unroll
            for (int k = 0; k < 4; ++k) { const unsigned w0 = (k & 1) ? gq[k >> 1].z : gq[k >> 1].x, w1 = (k & 1) ? gq[k >> 1].w : gq[k >> 1].y;
                v[k] = v[k] + (f32x4){bflo(w0), bfhi(w0), bflo(w1), bfhi(w1)}; }
        }
#pragma unroll
        for (int k = 0; k < 2; ++k) { v4u w; w.x = pk2(v[2 * k].x, v[2 * k].y); w.y = pk2(v[2 * k].z, v[2 * k].w); w.z = pk2(v[2 * k + 1].x, v[2 * k + 1].y); w.w = pk2(v[2 * k + 1].z, v[2 * k + 1].w);
            *(v4u*)(Yp + (size_t)row * ldy + ch * 16 + 8 * k) = w; }
        __builtin_amdgcn_sched_barrier(0);
    }
    __syncthreads();
}
__device__ __forceinline__ void load_q(bf16x8 (&qr)[8], const bf16* Qw) {
#pragma unroll
    for (int d0 = 0; d0 < 8; ++d0) qr[d0] = *(const bf16x8*)(Qw + d0 * 16);
}
__device__ __forceinline__ unsigned wave_or(unsigned m) {
#pragma unroll
    for (int x = 1; x < 64; x <<= 1) m |= (unsigned)__shfl_xor((int)m, x);
    return m;
}
__device__ __forceinline__ unsigned causal_tiles(int qlast) { const int n = (qlast >> 6) + 1; return n >= 32 ? 0xffffffffu : ((1u << n) - 1u); }
}
struct Args { const float* in[25]; float* out; unsigned char* ws; int ph_lo, ph_hi; };
typedef const __attribute__((address_space(4))) Args* KArgs;
struct Frame {
    LAS unsigned char* lds; volatile LAS unsigned* MISC; gu32* ctl;
    int tid, lane, wave, G, bx;
    unsigned char* ws; float* out;
};
#define WSP(T, off) ((T*)(F.ws + (off)))

__device__ __forceinline__ int maprow(int mode, int n, int arg) {
    if (mode == 0) return n + arg;
    if (mode == 1) {
        if (n < 2048) return n;
        if (n < 2056) return -1;
        if (n < 9224) return n - 8;
        return -1;
    }
    return ((n >> 7) << 8) + (n & 127) + arg;
}
__device__ __forceinline__ void tr_item(const float* __restrict__ W, int N, int ldw, bf16* __restrict__ WT, int ldd, int koff, int mode, int arg, int noff, int smap, LAS float* scr, int item, int lane) {
    const int nblk = (N + 31) >> 5, kb = item / nblk, nb = item - kb * nblk, k0 = 64 * kb, n0 = 32 * nb;
    const int nn = n0 + (lane & 31); const bool nok = nn < N;
    const int ns = smap ? (nn < 8 ? 2048 + nn : 9224 + (nn - 8)) : nn;
#pragma unroll
    for (int i = 0; i < 32; ++i) { const int kk = 2 * i + (lane >> 5); scr[kk * 33 + (lane & 31)] = nok ? W[(size_t)(k0 + kk) * ldw + ns] : 0.f; }
    LDS_WAIT(); asm volatile("" ::: "memory");
    const int c = lane & 7;
#pragma unroll
    for (int j = 0; j < 4; ++j) { const int n = (lane >> 3) + 8 * j; const LAS float* s = scr + (8 * c) * 33 + n;
        v4u o; o.x = pk2(s[0 * 33], s[1 * 33]); o.y = pk2(s[2 * 33], s[3 * 33]); o.z = pk2(s[4 * 33], s[5 * 33]); o.w = pk2(s[6 * 33], s[7 * 33]);
        if (n0 + n < N) { const int nn2 = n0 + n + (mode == 3 ? noff : 0), kk2 = k0 + 8 * c;
            const int mr = mode == 3 ? 0 : maprow(mode, n0 + n, arg);
            const size_t off = mode == 3 ? ((size_t)(((kk2 >> 5) * arg + (nn2 >> 4)) * 64 + ((kk2 >> 3) & 3) * 16 + (nn2 & 15)) * 8) : ((size_t)mr * ldd + koff + kk2);
            if (mr >= 0) *(GAS v4u*)(WT + off) = o; } }
    LDS_WAIT(); asm volatile("" ::: "memory");
}
__device__ __forceinline__ void mod_item(const LAS float* sc, const float* __restrict__ aw, const float* __restrict__ ab, const float* __restrict__ gn1, const float* __restrict__ gn2, float* __restrict__ mod, int item, int lane) {
    const int l = item / 384, ch = item - l * 384, n0 = ch * 32, cg = lane & 7, rs = lane >> 3;
    const float* W = aw + (size_t)l * 2048 * 12288 + n0 + 4 * cg;
    f32x4 acc[8];
#pragma unroll
    for (int b = 0; b < 8; ++b) acc[b] = (f32x4){0.f, 0.f, 0.f, 0.f};
#pragma unroll 8
    for (int i = 0; i < 256; ++i) { const int k = rs + 8 * i;
        const f32x4 w = *(const f32x4*)(W + (size_t)k * 12288);
        const f32x4 s0 = *(const LAS f32x4*)(sc + k * 8), s1 = *(const LAS f32x4*)(sc + k * 8 + 4);
        acc[0] += w * s0.x; acc[1] += w * s0.y; acc[2] += w * s0.z; acc[3] += w * s0.w; acc[4] += w * s1.x; acc[5] += w * s1.y; acc[6] += w * s1.z; acc[7] += w * s1.w; }
#pragma unroll
    for (int b = 0; b < 8; ++b)
#pragma unroll
        for (int x = 8; x < 64; x <<= 1) { acc[b].x += __shfl_xor(acc[b].x, x); acc[b].y += __shfl_xor(acc[b].y, x); acc[b].z += __shfl_xor(acc[b].z, x); acc[b].w += __shfl_xor(acc[b].w, x); }
    if (rs == 0) { const f32x4 bv = *(const f32x4*)(ab + (size_t)l * 12288 + n0 + 4 * cg);
        const int slot = n0 >> 11; const bool isg = (slot == 1 || slot == 4);
        f32x4 gm = (f32x4){1.f, 1.f, 1.f, 1.f}; if (isg) gm = *(const f32x4*)((slot == 1 ? gn1 : gn2) + (size_t)l * 2048 + (n0 & 2047) + 4 * cg);
#pragma unroll
        for (int b = 0; b < 8; ++b) { const f32x4 t = acc[b] + bv; *(f32x4*)(mod + ((size_t)l * 8 + b) * 12288 + n0 + 4 * cg) = isg ? gm * (t + 1.0f) : t; } }
}
__device__ __forceinline__ void p0_prologue(Frame& F, KArgs A) {
    LAS float* scr = (LAS float*)(F.lds + RING_OFF + F.wave * 8448);
    const int gw = F.bx * NWAVES + F.wave, NGW = F.G * NWAVES;
    constexpr int J1 = 32 * 289, J2 = 32 * 64, J3 = 0, J4 = 32 * 512, J5 = J4, J6 = 32 * 512, J7 = 2 * 256, J8 = 2 * 8, J9 = 96;
    constexpr int JL = J1 + J2 + J3 + J4 + J5 + J6 + J7 + J8 + J9;
    constexpr int N_MOD = 768, NT = 2 * JL, PRE = 8;
    const int nmodw = (N_MOD < NGW) ? N_MOD : NGW;
    if (F.bx * NWAVES < N_MOD) {
        LAS float* sct = (LAS float*)(F.lds + RING_OFF);
        for (int i = F.tid; i < 2048 * 8; i += NTHR) { const int k = i >> 3, b = i & 7; sct[i] = silu2_f(A->in[1][b * 2048 + k]); }
        __syncthreads();
        if (gw < N_MOD) mod_item(sct, A->in[4], A->in[5], A->in[2], A->in[3], WSP(float, WS_MOD), gw, F.lane);
        __syncthreads();
    }
    const int npre = (NGW - nmodw) * PRE < NT ? (NGW - nmodw) * PRE : NT;
    for (int pass = 0; pass < 2; ++pass) {
      int it0, it1, step;
      if (pass == 0) { if (gw < nmodw) continue; it0 = gw - nmodw; it1 = npre; step = NGW - nmodw; }
      else { it0 = npre + gw; it1 = NT; step = NGW; }
      for (int it = it0; it < it1; it += step) {
        int r = it;
        const int l = r / JL; r -= l * JL;
        if (r < J1) { tr_item(A->in[6] + (size_t)l * 2048 * DIN, DIN, DIN, WSP(bf16, WS_WINT) + (size_t)l * NZP * 2048, 2048, 0, 1, 0, 0, 0, scr, r, F.lane); continue; } r -= J1;
        if (r < J2) { tr_item(A->in[17] + (size_t)l * 2048 * 2048, 2048, 2048, WSP(bf16, WS_WOUTT) + (size_t)l * 2048 * KO, KO, 0, 0, 0, 0, 0, scr, r, F.lane); continue; } r -= J2;
        if (r < J3) { tr_item(A->in[17] + (size_t)l * 2048 * 2048 + (size_t)1536 * 2048, 2048, 2048, WSP(bf16, WS_WOUTT) + (size_t)l * 2048 * KO, KO, 2048, 0, 0, 0, 0, scr, r, F.lane); continue; } r -= J3;
        if (r < J4) { const int e = r >> 9; tr_item(A->in[22] + ((size_t)l * NE + e) * 2048 * DE, DE, DE, WSP(bf16, WS_W13T) + ((size_t)l * NE + e) * 1024 * 2048, 2048, 0, 2, 0, 0, 0, scr, r & 511, F.lane); continue; } r -= J4;
        if (r < J5) { const int e = r >> 9; tr_item(A->in[23] + ((size_t)l * NE + e) * 2048 * DE, DE, DE, WSP(bf16, WS_W13T) + ((size_t)l * NE + e) * 1024 * 2048, 2048, 0, 2, 128, 0, 0, scr, r & 511, F.lane); continue; } r -= J5;
        if (r < J6) { const int e = r >> 9; tr_item(A->in[24] + ((size_t)l * NE + e) * DE * 2048, 2048, 2048, WSP(bf16, WS_W2T) + ((size_t)l * NE + e) * 2048 * DE, DE, 0, 0, 0, 0, 0, scr, r & 511, F.lane); continue; } r -= J6;
        if (r < J7) { const int kv = r >> 8; tr_item(A->in[15] + ((size_t)l * 2 + kv) * 4096 * 128, 128, 128, WSP(bf16, WS_CW1T) + ((size_t)l * 2 + kv) * 128 * 4096, 4096, 0, 3, 8, 0, 0, scr, r & 255, F.lane); continue; } r -= J7;
        if (r < J8) { const int kv = r >> 3; tr_item(A->in[16] + ((size_t)l * 2 + kv) * 128 * 128, 128, 128, WSP(bf16, WS_CW2T) + ((size_t)l * 2 + kv) * 128 * 128, 128, 0, 0, 0, 0, 0, scr, r & 7, F.lane); continue; } r -= J8;
        if (r < 32) { tr_item(A->in[18] + (size_t)l * 2048 * 4, 4, 4, WSP(bf16, WS_RTT) + (size_t)l * 48 * 2048, 2048, 0, 3, 3, 0, 0, scr, r, F.lane); continue; } r -= 32;
        if (r < 32) { tr_item(A->in[20] + (size_t)l * 2048 * 32, 32, 32, WSP(bf16, WS_RTT) + (size_t)l * 48 * 2048, 2048, 0, 3, 3, 4, 0, scr, r, F.lane); continue; } r -= 32;
        tr_item(A->in[6] + (size_t)l * 2048 * DIN, 20, DIN, WSP(bf16, WS_GWF) + (size_t)l * 32 * 2048, 2048, 0, 3, 2, 0, 1, scr, r, F.lane);
      }
    }
}

template <typename XT> struct XRow;
template <> struct XRow<float> { typedef f32x4 raw_t; static __device__ __forceinline__ raw_t ld(const float* row, int lane, int j) { return ((const f32x4*)row)[lane + 64 * j]; }
    static __device__ __forceinline__ f32x4 cv(raw_t r) { return r; } };
template <> struct XRow<bf16> { typedef v2u raw_t; static __device__ __forceinline__ raw_t ld(const bf16* row, int lane, int j) { return ((const v2u*)row)[lane + 64 * j]; }
    static __device__ __forceinline__ f32x4 cv(raw_t r) { return (f32x4){bflo(r.x), bfhi(r.x), bflo(r.y), bfhi(r.y)}; } };
template <bool COMBINE, bool NORM, typename XT>
__device__ __forceinline__ void norm_phase(Frame& F, const XT* xin, float* xout, const float* gain, const float* modsh, const float* modsc, const float* modg2) {
    const int gw = F.bx * NWAVES + F.wave, NGW = F.G * NWAVES, lane = F.lane;
    static_assert(COMBINE && !NORM, "only the final MoE combine uses this phase");
    (void)gain; (void)modsh; (void)modsc;
    for (int m = gw; m < M; m += 2 * NGW) {
        const int m1 = (m + NGW < M) ? m + NGW : m;
        const LAS int* est = (const LAS int*)(F.lds + LDSCTL_OFF);
        const int* te = WSP(int, WS_TOKE); const int* tp = WSP(int, WS_TOKP); const float* tg = WSP(float, WS_TOKG);
        const int ea0 = te[2 * m], eb0 = te[2 * m + 1], pa0 = tp[2 * m], pb0 = tp[2 * m + 1], ea1 = te[2 * m1], eb1 = te[2 * m1 + 1], pa1 = tp[2 * m1], pb1 = tp[2 * m1 + 1];
        const float ga0 = tg[2 * m], gb0 = tg[2 * m + 1], ga1 = tg[2 * m1], gb1 = tg[2 * m1 + 1];
        typename XRow<XT>::raw_t x0[8], x1[8];
#pragma unroll
        for (int j = 0; j < 8; ++j) { x0[j] = XRow<XT>::ld(xin + (size_t)m * D, lane, j); x1[j] = XRow<XT>::ld(xin + (size_t)m1 * D, lane, j); }
        const int sa0 = est[ea0] + pa0, sb0 = est[eb0] + pb0, sa1 = est[ea1] + pa1, sb1 = est[eb1] + pb1;
        const v2u* ya0 = (const v2u*)(WSP(bf16, WS_Y) + (size_t)sa0 * D) + lane; const v2u* yb0 = (const v2u*)(WSP(bf16, WS_Y) + (size_t)sb0 * D) + lane;
        const v2u* ya1 = (const v2u*)(WSP(bf16, WS_Y) + (size_t)sa1 * D) + lane; const v2u* yb1 = (const v2u*)(WSP(bf16, WS_Y) + (size_t)sb1 * D) + lane;
        v2u a0[8], b0[8], a1[8], b1[8];
#pragma unroll
        for (int j = 0; j < 8; ++j) { a0[j] = ya0[64 * j]; b0[j] = yb0[64 * j]; a1[j] = ya1[64 * j]; b1[j] = yb1[64 * j]; }
        const f32x4* g20 = (const f32x4*)(modg2 + (size_t)(m >> 11) * 12288) + lane; const f32x4* g21 = (const f32x4*)(modg2 + (size_t)(m1 >> 11) * 12288) + lane;
        f32x4* xo0 = (f32x4*)(xout + (size_t)m * D) + lane; f32x4* xo1 = (f32x4*)(xout + (size_t)m1 * D) + lane;
        __builtin_amdgcn_sched_barrier(0);
#pragma unroll
        for (int j = 0; j < 8; ++j) { const f32x4 g0 = g20[64 * j], g1 = g21[64 * j];
            f32x4 y; y.x = ga0 * bflo(a0[j].x) + gb0 * bflo(b0[j].x); y.y = ga0 * bfhi(a0[j].x) + gb0 * bfhi(b0[j].x); y.z = ga0 * bflo(a0[j].y) + gb0 * bflo(b0[j].y); y.w = ga0 * bfhi(a0[j].y) + gb0 * bfhi(b0[j].y);
            xo0[64 * j] = XRow<XT>::cv(x0[j]) + g0 * y;
            f32x4 z; z.x = ga1 * bflo(a1[j].x) + gb1 * bflo(b1[j].x); z.y = ga1 * bfhi(a1[j].x) + gb1 * bfhi(b1[j].x); z.z = ga1 * bflo(a1[j].y) + gb1 * bflo(b1[j].y); z.w = ga1 * bfhi(a1[j].y) + gb1 * bfhi(b1[j].y);
            xo1[64 * j] = XRow<XT>::cv(x1[j]) + g1 * z; }
    }
}

#ifdef TPROBE
#define SUBSTAMP(id, var) do { if (TPROBE == (id) && l == 0) var = __builtin_amdgcn_s_memrealtime(); } while (0)
#else
#define SUBSTAMP(id, var) do {} while (0)
#endif
template <bool COMBINE, int MODE, typename XT>
__device__ __forceinline__ void normgemm_phase(Frame& F, KArgs A, int l, const XT* xin, float* xout, const float* gain, const float* modsh, const float* modsc, const float* modg2, unsigned long long& tpa, unsigned long long& tpb) {
#define LBAR() do { asm volatile("s_waitcnt lgkmcnt(0)" ::: "memory"); __builtin_amdgcn_s_barrier(); asm volatile("" ::: "memory"); } while (0)
    constexpr int NT = MODE == 0 ? 2 : 3, TP = 4112;
    const int lane = F.lane, w = F.wave, lr = lane & 15, lq = lane >> 4;
    LAS unsigned char* tile = F.lds;
    LAS float* part = (LAS float*)(F.lds + 66560);
    LAS float* lgt = (LAS float*)(F.lds + 66560 + 24576);
    LAS int* hist = (LAS int*)(F.lds + 66560 + 24576 + 4096);
    LAS int* tke = hist + 64; LAS int* tkp = tke + 256; LAS float* tkg = (LAS float*)(tkp + 256);
    bf16* HB = WSP(bf16, WS_HB);
    const bf16* WF = MODE == 0 ? WSP(bf16, WS_GWF) + (size_t)l * 32 * 2048 : WSP(bf16, WS_RTT) + (size_t)l * 48 * 2048;
    LAS float* rb = (LAS float*)(tkg + 256);
    if (MODE == 1) { if (F.tid < 64) hist[F.tid] = 0; if (F.tid < 4) rb[F.tid] = A->in[19][l * 4 + F.tid]; if (F.tid >= 64 && F.tid < 96) rb[4 + F.tid - 64] = A->in[21][l * 32 + F.tid - 64]; }
    int ntok = 0;
    typename XRow<XT>::raw_t pf0[8], pf1[8];
    if (F.bx < M / 16) {
#pragma unroll
        for (int j = 0; j < 8; ++j) { pf0[j] = XRow<XT>::ld(xin + (size_t)(F.bx * 16 + 2 * w) * D, lane, j); pf1[j] = XRow<XT>::ld(xin + (size_t)(F.bx * 16 + 2 * w + 1) * D, lane, j); } }
    for (int grp = F.bx; grp < M / 16; grp += F.G, ntok += 16) {
        if (MODE == 1 && grp == F.bx) { SUBSTAMP(120, tpa); }

        {
            const int r0 = 2 * w, m0 = grp * 16 + r0, b = m0 >> 11;
            f32x4 v0[8], v1[8];
#pragma unroll
            for (int j = 0; j < 8; ++j) { v0[j] = XRow<XT>::cv(pf0[j]); v1[j] = XRow<XT>::cv(pf1[j]); }
            if (COMBINE) {
                const LAS int* est = (const LAS int*)(F.lds + LDSCTL_OFF);
                const f32x4* g2 = (const f32x4*)(modg2 + (size_t)b * 12288) + lane;
                f32x4 gv[8];
#pragma unroll
                for (int j = 0; j < 8; ++j) gv[j] = g2[64 * j];
                const int* te = WSP(int, WS_TOKE); const int* tp = WSP(int, WS_TOKP); const float* tg = WSP(float, WS_TOKG);
                const v4u tev = *(const v4u*)(te + 2 * m0), tpv = *(const v4u*)(tp + 2 * m0); const f32x4 tgv = *(const f32x4*)(tg + 2 * m0);
                const int sa0 = est[tev.x] + (int)tpv.x, sb0 = est[tev.y] + (int)tpv.y, sa1 = est[tev.z] + (int)tpv.z, sb1 = est[tev.w] + (int)tpv.w;
                const v2u* ya0 = (const v2u*)(WSP(bf16, WS_Y) + (size_t)sa0 * D) + lane; const v2u* yb0 = (const v2u*)(WSP(bf16, WS_Y) + (size_t)sb0 * D) + lane;
                const v2u* ya1 = (const v2u*)(WSP(bf16, WS_Y) + (size_t)sa1 * D) + lane; const v2u* yb1 = (const v2u*)(WSP(bf16, WS_Y) + (size_t)sb1 * D) + lane;
                v2u a0[8], b0[8], a1[8], b1[8];
#pragma unroll
                for (int j = 0; j < 8; ++j) { a0[j] = ya0[64 * j]; b0[j] = yb0[64 * j]; a1[j] = ya1[64 * j]; b1[j] = yb1[64 * j]; }
                __builtin_amdgcn_sched_barrier(0);
                f32x4* xo0 = (f32x4*)(xout + (size_t)m0 * D) + lane; f32x4* xo1 = xo0 + D / 4;
                const float ga0 = tgv[0], gb0 = tgv[1], ga1 = tgv[2], gb1 = tgv[3];
#pragma unroll
                for (int j = 0; j < 8; ++j) {
                    f32x4 y; y.x = ga0 * bflo(a0[j].x) + gb0 * bflo(b0[j].x); y.y = ga0 * bfhi(a0[j].x) + gb0 * bfhi(b0[j].x); y.z = ga0 * bflo(a0[j].y) + gb0 * bflo(b0[j].y); y.w = ga0 * bfhi(a0[j].y) + gb0 * bfhi(b0[j].y);
                    v0[j] = v0[j] + gv[j] * y; xo0[64 * j] = v0[j];
                    f32x4 z; z.x = ga1 * bflo(a1[j].x) + gb1 * bflo(b1[j].x); z.y = ga1 * bfhi(a1[j].x) + gb1 * bfhi(b1[j].x); z.z = ga1 * bflo(a1[j].y) + gb1 * bflo(b1[j].y); z.w = ga1 * bfhi(a1[j].y) + gb1 * bfhi(b1[j].y);
                    v1[j] = v1[j] + gv[j] * z; xo1[64 * j] = v1[j]; }
            }
            float ss0 = 0.f, ss1 = 0.f;
#pragma unroll
            for (int j = 0; j < 8; ++j) { ss0 += (v0[j].x * v0[j].x + v0[j].y * v0[j].y) + (v0[j].z * v0[j].z + v0[j].w * v0[j].w); ss1 += (v1[j].x * v1[j].x + v1[j].y * v1[j].y) + (v1[j].z * v1[j].z + v1[j].w * v1[j].w); }
#pragma unroll
            for (int o = 1; o < 64; o <<= 1) { ss0 += __shfl_xor(ss0, o); ss1 += __shfl_xor(ss1, o); }
            const float rstd0 = __builtin_amdgcn_rsqf(ss0 * (1.0f / D) + EPS), rstd1 = __builtin_amdgcn_rsqf(ss1 * (1.0f / D) + EPS);
            (void)gain;
            const f32x4* sc = (const f32x4*)(modsc + (size_t)b * 12288) + lane; const f32x4* sh = (const f32x4*)(modsh + (size_t)b * 12288) + lane;
            v2u* o8 = (v2u*)(HB + (size_t)m0 * D) + lane; LAS v2u* t8 = (LAS v2u*)(tile + r0 * TP) + lane;
#pragma unroll
            for (int j = 0; j < 8; ++j) { const f32x4 s = sc[64 * j], h = sh[64 * j];
                const f32x4 y0 = v0[j] * rstd0 * s + h, y1 = v1[j] * rstd1 * s + h;
                v2u pw; pw.x = pk2(y0.x, y0.y); pw.y = pk2(y0.z, y0.w); o8[64 * j] = pw; t8[64 * j] = pw;
                v2u qw; qw.x = pk2(y1.x, y1.y); qw.y = pk2(y1.z, y1.w); o8[D / 4 + 64 * j] = qw; *(LAS v2u*)((LAS unsigned char*)(t8 + 64 * j) + TP) = qw; }
        }
        bf16x8 bw[8][NT];
#pragma unroll
        for (int u = 0; u < 8; ++u)
#pragma unroll
            for (int nt = 0; nt < NT; ++nt) bw[u][nt] = *(const bf16x8*)(WF + ((size_t)((8 * w + u) * NT + nt) * 64 + lane) * 8);
        __builtin_amdgcn_sched_barrier(0);
        { const int gn_ = grp + F.G < M / 16 ? grp + F.G : grp;
#pragma unroll
          for (int j = 0; j < 8; ++j) pf0[j] = XRow<XT>::ld(xin + (size_t)(gn_ * 16 + 2 * w) * D, lane, j); }
        __builtin_amdgcn_sched_barrier(0);
        LBAR();
        if (MODE == 1 && grp == F.bx) { SUBSTAMP(120, tpb); SUBSTAMP(121, tpa); }
        {
            f32x4 acc[NT];
#pragma unroll
            for (int nt = 0; nt < NT; ++nt) acc[nt] = (f32x4){0.f, 0.f, 0.f, 0.f};
#pragma unroll
            for (int u = 0; u < 8; ++u) { const bf16x8 a = *(const LAS bf16x8*)(tile + lr * TP + ((8 * w + u) * 32 + 8 * lq) * 2);
#pragma unroll
                for (int nt = 0; nt < NT; ++nt) acc[nt] = __builtin_amdgcn_mfma_f32_16x16x32_bf16(a, bw[u][nt], acc[nt], 0, 0, 0); }
#pragma unroll
            for (int nt = 0; nt < NT; ++nt)
#pragma unroll
                for (int g = 0; g < 4; ++g) part[(w * 16 + 4 * lq + g) * 48 + nt * 16 + lr] = acc[nt][g];
        }
        LBAR();
        if (MODE == 1 && grp == F.bx) { SUBSTAMP(121, tpb); SUBSTAMP(122, tpa); }
        for (int i = F.tid; i < 16 * NT * 16; i += NTHR) { const int row = i / (NT * 16), col = i - row * (NT * 16); float sum = 0.f;
#pragma unroll
            for (int ww = 0; ww < 8; ++ww) sum += part[(ww * 16 + row) * 48 + col];
            lgt[row * 52 + col] = sum; }
        LBAR();
        { const int gn_ = grp + F.G < M / 16 ? grp + F.G : grp;
#pragma unroll
          for (int j = 0; j < 8; ++j) pf1[j] = XRow<XT>::ld(xin + (size_t)(gn_ * 16 + 2 * w + 1) * D, lane, j); }
        if (MODE == 0) {
            if (F.tid < 20 * 16) { const int col = F.tid >> 4, row = F.tid & 15; WSP(float, WS_GT)[(size_t)col * M + grp * 16 + row] = lgt[row * 52 + col]; }
        } else if (w == 0 && lane < 16) {
            const LAS float* bg = rb; const LAS float* be = rb + 4;
            const LAS float* row = lgt + lane * 52;
            float g4[4]; int gi = 0; float gm = -3.0e38f;
#pragma unroll
            for (int i = 0; i < 4; ++i) { g4[i] = row[i] + bg[i]; if (g4[i] > gm) { gm = g4[i]; gi = i; } }
            float gs = 0.f;
#pragma unroll
            for (int i = 0; i < 4; ++i) gs += __expf(g4[i] - gm);
            const float pgrp = 1.0f / gs;
            float la = -3.0e38f, lb = -3.0e38f; int ia = 0, ib = 0;
#pragma unroll
            for (int i = 0; i < 8; ++i) { const float v = row[4 + gi * 8 + i] + be[gi * 8 + i];
                if (v > la) { lb = la; ib = ia; la = v; ia = i; } else if (v > lb) { lb = v; ib = i; } }
            const float eb = __expf(lb - la), inv = 1.0f / (1.0f + eb);
            const int e0 = gi * 8 + ia, e1 = gi * 8 + ib, t = ntok + lane;
            tke[2 * t] = e0; tke[2 * t + 1] = e1; tkg[2 * t] = pgrp * inv; tkg[2 * t + 1] = pgrp * eb * inv;
            tkp[2 * t] = __hip_atomic_fetch_add(hist + e0, 1, __ATOMIC_RELAXED, __HIP_MEMORY_SCOPE_WORKGROUP);
            tkp[2 * t + 1] = __hip_atomic_fetch_add(hist + e1, 1, __ATOMIC_RELAXED, __HIP_MEMORY_SCOPE_WORKGROUP);
        }
        if (MODE == 1 && grp == F.bx) { SUBSTAMP(122, tpb); }
    }
    if (MODE == 1) {
        __syncthreads();
        if (F.tid < 32) { const int c = hist[F.tid]; int base = 0; if (c) base = (int)__hip_atomic_fetch_add((unsigned*)(F.ctl + CW_CNT + l * 32 + F.tid), (unsigned)c, RLX_AGENT); hist[32 + F.tid] = base; }
        __syncthreads();
        for (int i = F.tid; i < 2 * ntok; i += NTHR) { const int t = i >> 1, j = i & 1, step = t >> 4, r = t & 15;
            const int m = (F.bx + step * F.G) * 16 + r; const int e = tke[i];
            const int pos = hist[32 + e] + tkp[i];
            WSP(int, WS_TOKE)[2 * m + j] = e; WSP(int, WS_TOKP)[2 * m + j] = pos; WSP(float, WS_TOKG)[2 * m + j] = tkg[i]; WSP(int, WS_TOKL)[e * 16384 + pos] = m; }
        __syncthreads();
    }
}

__device__ __forceinline__ float gelu_tanh(float x) { const float u = 0.7978845608028654f * (x + 0.044715f * x * x * x); const float e = __expf(2.0f * u); const float t = 1.0f - 2.0f * __builtin_amdgcn_rcpf(e + 1.0f); return 0.5f * x * (1.0f + t); }
__device__ __forceinline__ void compress_item(Frame& F, KArgs A, int l, int item) {
    const int b = item >> 5, h = (item >> 3) & 3, kv = (item >> 2) & 1, qr4 = item & 3, lane = F.lane, w = F.wave;
    const bf16* Z = WSP(bf16, WS_Z) + (size_t)b * T * ZW + (kv ? Z_NVC : Z_NKC) + h * HD;
    const bf16* W1 = WSP(bf16, WS_CW1T) + ((size_t)l * 2 + kv) * 128 * 4096;
    const bf16* W2 = WSP(bf16, WS_CW2T) + ((size_t)l * 2 + kv) * 128 * 128;
    const float* pe = A->in[14] + ((size_t)l * 2 + kv) * 4096;
    const int lr = lane & 15, lq = lane >> 4, kq = w;
    const int n = qr4 * 32 + lr;
    f32x4 acc[8], acd[8];
#pragma unroll
    for (int i = 0; i < 8; ++i) { acc[i] = (f32x4){0.f, 0.f, 0.f, 0.f}; acd[i] = (f32x4){0.f, 0.f, 0.f, 0.f}; }
    v4u ar, as, arn, asn; f32x4 e0, e1, e0n, e1n; bf16x8 bw[8], bwn[8];
#define CMP_LOAD(AR, AS, E0, E1, BW, KS) do { const int ks_ = (KS); const int p_ = ks_ >> 2, d_ = (ks_ & 3) * 32 + 8 * lq; int tok_ = 16 * n + p_, tok2_ = tok_ + 256; tok_ = tok_ > T - 1 ? T - 1 : tok_; tok2_ = tok2_ > T - 1 ? T - 1 : tok2_; \
        AR = *(const v4u*)(Z + (size_t)tok_ * ZW + d_); AS = *(const v4u*)(Z + (size_t)tok2_ * ZW + d_); E0 = *(const f32x4*)(pe + ks_ * 32 + 8 * lq); E1 = *(const f32x4*)(pe + ks_ * 32 + 8 * lq + 4); \
        _Pragma("unroll") for (int nt = 0; nt < 8; ++nt) BW[nt] = *(const bf16x8*)(W1 + ((size_t)(ks_ * 8 + nt) * 64 + lane) * 8); } while (0)
#define CMP_PK(AR, E0, E1) ({ v4u ap; ap.x = pk2(bflo(AR.x) + E0.x, bfhi(AR.x) + E0.y); ap.y = pk2(bflo(AR.y) + E0.z, bfhi(AR.y) + E0.w); \
        ap.z = pk2(bflo(AR.z) + E1.x, bfhi(AR.z) + E1.y); ap.w = pk2(bflo(AR.w) + E1.z, bfhi(AR.w) + E1.w); __builtin_bit_cast(bf16x8, ap); })
#define CMP_MMA(AR, AS, E0, E1, BW) do { const bf16x8 a = CMP_PK(AR, E0, E1), a2 = CMP_PK(AS, E0, E1); \
        _Pragma("unroll") for (int nt = 0; nt < 8; ++nt) { acc[nt] = __builtin_amdgcn_mfma_f32_16x16x32_bf16(a, BW[nt], acc[nt], 0, 0, 0); acd[nt] = __builtin_amdgcn_mfma_f32_16x16x32_bf16(a2, BW[nt], acd[nt], 0, 0, 0); } } while (0)
    CMP_LOAD(ar, as, e0, e1, bw, kq * 16);
#pragma unroll 1
    for (int k2 = 0; k2 < 16; k2 += 2) {
        CMP_LOAD(arn, asn, e0n, e1n, bwn, kq * 16 + k2 + 1);
        __builtin_amdgcn_sched_barrier(0);
        CMP_MMA(ar, as, e0, e1, bw);
        __builtin_amdgcn_sched_barrier(0);
        CMP_LOAD(ar, as, e0, e1, bw, kq * 16 + ((k2 + 2) & 15));
        __builtin_amdgcn_sched_barrier(0);
        CMP_MMA(arn, asn, e0n, e1n, bwn);
        __builtin_amdgcn_sched_barrier(0);
    }
#undef CMP_LOAD
#undef CMP_MMA
#undef CMP_PK
    LAS float* part = (LAS float*)(F.lds + RING_OFF);
    { LAS float* pw = part + (size_t)((w & 3) * 32) * 132;
      if (w >= 4) {
#pragma unroll
        for (int nt = 0; nt < 8; ++nt)
#pragma unroll
            for (int g = 0; g < 4; ++g) { pw[(4 * lq + g) * 132 + nt * 16 + lr] = acc[nt][g]; pw[(16 + 4 * lq + g) * 132 + nt * 16 + lr] = acd[nt][g]; } }
      __syncthreads();
      if (w < 4) {
#pragma unroll
        for (int nt = 0; nt < 8; ++nt)
#pragma unroll
            for (int g = 0; g < 4; ++g) { const int o0 = (4 * lq + g) * 132 + nt * 16 + lr, o1 = (16 + 4 * lq + g) * 132 + nt * 16 + lr; pw[o0] += acc[nt][g]; pw[o1] += acd[nt][g]; } }
      __syncthreads(); }
    if (w < 2) {
        LAS bf16* hid = (LAS bf16*)(F.lds + 73728 + w * 4352);
#pragma unroll
        for (int nt = 0; nt < 8; ++nt)
#pragma unroll
            for (int g = 0; g < 4; ++g) { const int o = (w * 16 + 4 * lq + g) * 132 + nt * 16 + lr;
                const float s = (part[o] + part[32 * 132 + o]) + (part[64 * 132 + o] + part[96 * 132 + o]);
                hid[(4 * lq + g) * 136 + nt * 16 + lr] = (bf16)f2bf(gelu_tanh(s)); }
        LDS_WAIT(); asm volatile("" ::: "memory");
        f32x4 ac2[8];
#pragma unroll
        for (int i = 0; i < 8; ++i) ac2[i] = (f32x4){0.f, 0.f, 0.f, 0.f};
#pragma unroll
        for (int ks = 0; ks < 4; ++ks) { const bf16x8 a = *(const LAS bf16x8*)(hid + lr * 136 + ks * 32 + 8 * lq);
#pragma unroll
            for (int nt = 0; nt < 8; ++nt) { const bf16x8 bw = *(const bf16x8*)(W2 + (size_t)(nt * 16 + lr) * 128 + ks * 32 + 8 * lq);
                ac2[nt] = __builtin_amdgcn_mfma_f32_16x16x32_bf16(a, bw, ac2[nt], 0, 0, 0); } }
        bf16* O = WSP(bf16, kv ? WS_VCMP : WS_KCMP) + (size_t)(b * 4 + h) * 128 * 128;
        float rn[4] = {1.f, 1.f, 1.f, 1.f};
        if (kv == 0) {
#pragma unroll
            for (int g = 0; g < 4; ++g) { float ss = 0.f;
#pragma unroll
                for (int nt = 0; nt < 8; ++nt) ss += ac2[nt][g] * ac2[nt][g];
#pragma unroll
                for (int x = 1; x < 16; x <<= 1) ss += __shfl_xor(ss, x);
                rn[g] = __builtin_amdgcn_rsqf(ss * (1.0f / 128.0f) + EPS); }
        }
        const float* kg = A->in[13] + (size_t)l * 3 * 128;
#pragma unroll
        for (int nt = 0; nt < 8; ++nt) { const float g0 = kv == 0 ? kg[nt * 16 + lr] : 1.0f;
#pragma unroll
            for (int g = 0; g < 4; ++g) O[(size_t)(qr4 * 32 + w * 16 + 4 * lq + g) * 128 + nt * 16 + lr] = (bf16)f2bf(ac2[nt][g] * rn[g] * g0); }
    }
}
__device__ __forceinline__ void cumsum_item(Frame& F, KArgs A, int l, int b) {
    if (F.wave >= 4) return;
    const int h = F.wave, lane = F.lane;
    const float* Gf = WSP(float, WS_GT) + (size_t)(4 + h) * M + (size_t)b * T + lane * 32;
    const float* Gi = WSP(float, WS_GT) + (size_t)h * M + (size_t)b * T + lane * 32;
    const float bi = A->in[7][(l * 2 + 0) * 4 + h], bf_ = A->in[7][(l * 2 + 1) * 4 + h];
    float lf[32]; float run = 0.f;
#pragma unroll
    for (int i4 = 0; i4 < 8; ++i4) { const f32x4 xv = *(const f32x4*)(Gf + 4 * i4);
#pragma unroll
        for (int j = 0; j < 4; ++j) { const float x = xv[j] + bf_; const float ls = fminf(x, 0.f) - __logf(1.0f + __expf(-fabsf(x))); run += ls; lf[4 * i4 + j] = run; } }
    float tot = run, inc = run;
#pragma unroll
    for (int x = 1; x < 64; x <<= 1) { const float t = __shfl_up(inc, x); if (lane >= x) inc += t; }
    const float excl = inc - tot;
    float* Fq = WSP(float, WS_FQ) + (size_t)(b * 4 + h) * T + lane * 32; float* Gk = WSP(float, WS_GK) + (size_t)(b * 4 + h) * T + lane * 32;
#pragma unroll
    for (int i4 = 0; i4 < 8; ++i4) { const f32x4 iv = *(const f32x4*)(Gi + 4 * i4); f32x4 fo, go;
#pragma unroll
        for (int j = 0; j < 4; ++j) { const float f = excl + lf[4 * i4 + j]; fo[j] = f * LOG2E; go[j] = (iv[j] + bi - f) * LOG2E; lf[4 * i4 + j] = go[j]; }
        *(f32x4*)(Fq + 4 * i4) = fo; *(f32x4*)(Gk + 4 * i4) = go; }
    const float oth = __shfl_xor(lf[0], 1); const float ref = (lane & 1) ? oth : lf[0];
    float* Ek = WSP(float, WS_EK) + (size_t)(b * 4 + h) * T + lane * 32;
#pragma unroll
    for (int i4 = 0; i4 < 8; ++i4) { f32x4 eo;
#pragma unroll
        for (int j = 0; j < 4; ++j) eo[j] = __builtin_amdgcn_exp2f(lf[4 * i4 + j] - ref);
        *(f32x4*)(Ek + 4 * i4) = eo; }
}
__device__ __forceinline__ void rms_seg(bf16* p, const v4u w, const float* __restrict__ g, int lane, float (&y)[8], bool wr = true) {
    float x[8] = {bflo(w.x), bfhi(w.x), bflo(w.y), bfhi(w.y), bflo(w.z), bfhi(w.z), bflo(w.w), bfhi(w.w)};
    float ss = 0.f;
#pragma unroll
    for (int i = 0; i < 8; ++i) ss += x[i] * x[i];
#pragma unroll
    for (int s = 1; s < 16; s <<= 1) ss += __shfl_xor(ss, s);
    const float rn = __builtin_amdgcn_rsqf(ss * (1.0f / 128.0f) + EPS);
    const f32x4 g0 = *(const f32x4*)(g + 8 * (lane & 15)), g1 = *(const f32x4*)(g + 8 * (lane & 15) + 4);
    y[0] = x[0] * rn * g0.x; y[1] = x[1] * rn * g0.y; y[2] = x[2] * rn * g0.z; y[3] = x[3] * rn * g0.w;
    y[4] = x[4] * rn * g1.x; y[5] = x[5] * rn * g1.y; y[6] = x[6] * rn * g1.z; y[7] = x[7] * rn * g1.w;
    v4u o; o.x = pk2(y[0], y[1]); o.y = pk2(y[2], y[3]); o.z = pk2(y[4], y[5]); o.w = pk2(y[6], y[7]);
    if (wr) *(v4u*)(p + 8 * lane) = o;
}
__device__ __forceinline__ void token_item(Frame& F, KArgs A, int l, int item, bool wr = true) {
    const int lane = F.lane, w = F.wave;
    const int m0 = item * 64 + w * 8, b = m0 >> 11, t0 = m0 & (T - 1);
    bf16* Z = WSP(bf16, WS_Z); bf16* QKM = WSP(bf16, WS_QKM);
    const float* cw = A->in[8] + (size_t)l * 4 * 1024;
    float wq[4][8], wk[4][8];
#pragma unroll
    for (int j = 0; j < 4; ++j)
#pragma unroll
        for (int i = 0; i < 8; ++i) { wq[j][i] = cw[j * 1024 + 8 * lane + i]; wk[j][i] = cw[j * 1024 + 512 + 8 * lane + i]; }
    float hq[3][8], hk[3][8];
#pragma unroll
    for (int j = 0; j < 3; ++j) { const int tt = t0 - 3 + j;
        if (tt >= 0) { const v4u a = *(const v4u*)(Z + (size_t)(m0 - 3 + j) * ZW + Z_MQ + 8 * lane), c = *(const v4u*)(Z + (size_t)(m0 - 3 + j) * ZW + Z_MK + 8 * lane);
            hq[j][0] = bflo(a.x); hq[j][1] = bfhi(a.x); hq[j][2] = bflo(a.y); hq[j][3] = bfhi(a.y); hq[j][4] = bflo(a.z); hq[j][5] = bfhi(a.z); hq[j][6] = bflo(a.w); hq[j][7] = bfhi(a.w);
            hk[j][0] = bflo(c.x); hk[j][1] = bfhi(c.x); hk[j][2] = bflo(c.y); hk[j][3] = bfhi(c.y); hk[j][4] = bflo(c.z); hk[j][5] = bfhi(c.z); hk[j][6] = bflo(c.w); hk[j][7] = bfhi(c.w); }
        else {
#pragma unroll
            for (int i = 0; i < 8; ++i) { hq[j][i] = 0.f; hk[j][i] = 0.f; } } }
    float ksum[8];
#pragma unroll
    for (int i = 0; i < 8; ++i) ksum[i] = 0.f;
#pragma unroll 8
    for (int tk = 0; tk < 8; ++tk) {
        const int m = m0 + tk; bf16* zr = Z + (size_t)m * ZW;
        const v4u a = *(const v4u*)(zr + Z_MQ + 8 * lane), c = *(const v4u*)(zr + Z_MK + 8 * lane);
        const v4u s_bk = *(const v4u*)(zr + Z_BK + 8 * lane);
        float cq[8] = {bflo(a.x), bfhi(a.x), bflo(a.y), bfhi(a.y), bflo(a.z), bfhi(a.z), bflo(a.w), bfhi(a.w)};
        float ck[8] = {bflo(c.x), bfhi(c.x), bflo(c.y), bfhi(c.y), bflo(c.z), bfhi(c.z), bflo(c.w), bfhi(c.w)};
        float oq[8], ok[8];
#pragma unroll
        for (int i = 0; i < 8; ++i) { oq[i] = silu2_f(wq[0][i] * hq[0][i] + wq[1][i] * hq[1][i] + wq[2][i] * hq[2][i] + wq[3][i] * cq[i]);
            ok[i] = silu2_f(wk[0][i] * hk[0][i] + wk[1][i] * hk[1][i] + wk[2][i] * hk[2][i] + wk[3][i] * ck[i]);
            hq[0][i] = hq[1][i]; hq[1][i] = hq[2][i]; hq[2][i] = cq[i]; hk[0][i] = hk[1][i]; hk[1][i] = hk[2][i]; hk[2][i] = ck[i]; }
        v4u o; o.x = pk2(oq[0], oq[1]); o.y = pk2(oq[2], oq[3]); o.z = pk2(oq[4], oq[5]); o.w = pk2(oq[6], oq[7]);
        if (wr) *(v4u*)(QKM + (size_t)m * 1024 + 8 * lane) = o;
        o.x = pk2(ok[0], ok[1]); o.y = pk2(ok[2], ok[3]); o.z = pk2(ok[4], ok[5]); o.w = pk2(ok[6], ok[7]);
        if (wr) *(v4u*)(QKM + (size_t)m * 1024 + 512 + 8 * lane) = o;
        ksum[0] += bflo(s_bk.x); ksum[1] += bfhi(s_bk.x); ksum[2] += bflo(s_bk.y); ksum[3] += bfhi(s_bk.y); ksum[4] += bflo(s_bk.z); ksum[5] += bfhi(s_bk.z); ksum[6] += bflo(s_bk.w); ksum[7] += bfhi(s_bk.w);
    }
    LAS float* ka = (LAS float*)(F.lds + RING_OFF);
#pragma unroll
    for (int i = 0; i < 8; ++i) ka[w * 512 + 8 * lane + i] = ksum[i];
    __syncthreads();
    { const int col = F.tid; float s = 0.f;
#pragma unroll
      for (int ww = 0; ww < 8; ++ww) s += ka[ww * 512 + col];
      const int t64 = (item * 64) & (T - 1), blk = t64 >> 8, sub = (t64 >> 6) & 3, h = col >> 7, d = col & 127;
      if (wr) WSP(float, WS_KPART)[((((size_t)(item >> 5) * 4 + h) * 8 + blk) * 4 + sub) * 128 + d] = s; }
    __syncthreads();
}
__device__ __forceinline__ void prep_phase(Frame& F, KArgs A, int l, unsigned long long& tpa, unsigned long long& tpb) {
    constexpr int N_CMP = 256, N_CUM = 8, N_TOK = M / 64;
    SUBSTAMP(100, tpa);
    for (int rep = 0; rep < (((DUP_MASK >> 12) & 1u) ? 2 : 1); ++rep)
    if (EN2(0)) for (int it = F.bx; it < N_CMP; it += F.G) { compress_item(F, A, l, it); __syncthreads(); }
    SUBSTAMP(100, tpb); SUBSTAMP(101, tpa);
    if (EN2(1)) for (int it = F.bx; it < N_CUM; it += F.G) cumsum_item(F, A, l, it);
    SUBSTAMP(101, tpb); SUBSTAMP(102, tpa);
    if (EN2(2)) for (int it = F.G - 1 - F.bx; it < N_TOK; it += F.G) token_item(F, A, l, it);
    SUBSTAMP(102, tpb);
    if ((DUP_MASK >> 13) & 1u) { __syncthreads(); for (int it = F.G - 1 - F.bx; it < N_TOK; it += F.G) token_item(F, A, l, it, A->ph_hi == 12345); }
}
__device__ __forceinline__ unsigned range_mask(int lo, int hi) {
    const unsigned a = hi >= 31 ? 0xffffffffu : ((1u << (hi + 1)) - 1u); return a & ~((1u << lo) - 1u);
}
#define ATT_IDS() int tid_ = threadIdx.x; asm volatile("" : "+v"(tid_)); const int tid = tid_, wid = __builtin_amdgcn_readfirstlane(tid >> 6), lane = tid & 63, r32 = lane & 31, hi = lane >> 5; (void)tid; (void)lane
#define ATT_IDS_B() int tidb_ = threadIdx.x; asm volatile("" : "+v"(tidb_)); const int wb = __builtin_amdgcn_readfirstlane(tidb_ >> 6), r32b = tidb_ & 31, hib = (tidb_ >> 5) & 1
template <int TYPE>
__device__ __forceinline__ void unit_state(Frame& F, KArgs A, int l, int b, int h, int blk) {
    using namespace att; ATT_IDS();
    LAS char* lds = (LAS char*)F.lds;
    const bf16* Z = WSP(bf16, WS_Z) + (size_t)b * T * ZW;
    const bf16* QKM = WSP(bf16, WS_QKM) + (size_t)b * T * 1024;
    const bf16 *Kh, *Vh; int ldk; const float* G2 = nullptr; float fend = 0.f, sl2 = 0.f;
    if (TYPE == 0) { Kh = QKM + 512 + h * HD; ldk = 1024; Vh = Z + Z_MV + h * HD; G2 = WSP(float, WS_GK) + (size_t)(b * 4 + h) * T; fend = WSP(float, WS_FQ)[(size_t)(b * 4 + h) * T + blk * 256 + 255]; }
    else { Kh = Z + Z_RK + h * HD; ldk = ZW; Vh = Z + Z_RV + h * HD; sl2 = -log2f(1.0f - exp2f(-5.0f - (float)h)); }
    const int sr = tid >> 4, sc = (tid & 15) * 8;
    const int D0 = wid & 3, D1 = (wid >> 2) * 2;
    const int kbase = (int)(unsigned)(uintptr_t)lds + v_rd_base(lane) + D0 * 512, vbase = (int)(unsigned)(uintptr_t)(lds + SHM_V) + v_rd_base(lane) + D1 * 512;
    f32x16 acc0 = {}, acc1 = {};
    float nacc[8] = {};
#pragma unroll 1
    for (int i = 0; i < 4; ++i) {
        const int k0 = blk * 256 + i * 64;
        const v4u kq0 = *(const v4u*)(Kh + (size_t)(k0 + sr) * ldk + sc), kq1 = *(const v4u*)(Kh + (size_t)(k0 + 32 + sr) * ldk + sc);
        const v4u vq0 = *(const v4u*)(Vh + (size_t)(k0 + sr) * ZW + sc), vq1 = *(const v4u*)(Vh + (size_t)(k0 + 32 + sr) * ZW + sc);
        float w0, w1;
        if (TYPE == 0) { w0 = exp2f(G2[k0 + sr] + fend); w1 = exp2f(G2[k0 + 32 + sr] + fend); }
        else { w0 = exp2f(-sl2 * (float)(255 - (i * 64 + sr))); w1 = exp2f(-sl2 * (float)(255 - (i * 64 + 32 + sr))); }
        v4u ks0, ks1;
#pragma unroll
        for (int j = 0; j < 4; ++j) { const float a0 = bflo(kq0[j]) * w0, a1 = bfhi(kq0[j]) * w0, c0 = bflo(kq1[j]) * w1, c1 = bfhi(kq1[j]) * w1;
            nacc[2 * j] += a0 + c0; nacc[2 * j + 1] += a1 + c1; ks0[j] = pk2(a0, a1); ks1[j] = pk2(c0, c1); }
        __syncthreads();
        *(LAS v4u*)(lds + v_st(sr, sc)) = ks0; *(LAS v4u*)(lds + v_st(32 + sr, sc)) = ks1;
        *(LAS v4u*)(lds + SHM_V + v_st(sr, sc)) = vq0; *(LAS v4u*)(lds + SHM_V + v_st(32 + sr, sc)) = vq1;
        __syncthreads();
#define ST_F(BASE, D, KS) ({ const s16x4 lo_ = tr_read<v_rd_off(D, KS, 0)>(BASE), hi_ = tr_read<v_rd_off(D, KS, 1)>(BASE); asm volatile("s_waitcnt lgkmcnt(0)" ::: "memory"); (bf16x8){lo_[0], lo_[1], lo_[2], lo_[3], hi_[0], hi_[1], hi_[2], hi_[3]}; })
#define ST_KS(KS) do { const bf16x8 fa = ST_F(kbase, 0, KS), fb0 = ST_F(vbase, 0, KS), fb1 = ST_F(vbase, 1, KS); \
        acc0 = __builtin_amdgcn_mfma_f32_32x32x16_bf16(fa, fb0, acc0, 0, 0, 0); acc1 = __builtin_amdgcn_mfma_f32_32x32x16_bf16(fa, fb1, acc1, 0, 0, 0); } while (0)
        ST_KS(0); ST_KS(1); ST_KS(2); ST_KS(3);
#undef ST_KS
#undef ST_F
    }
    float* U = WSP(float, WS_US) + ((size_t)((TYPE == 0 ? 0 : 32) + b * 4 + h) * 7 + blk) * 16384 + (size_t)(D0 * 32) * 128 + D1 * 32 + r32;
#pragma unroll
    for (int r = 0; r < 16; ++r) { U[(size_t)crow(r, hi) * 128] = acc0[r]; U[(size_t)crow(r, hi) * 128 + 32] = acc1[r]; }
    if (TYPE == 0) {
        LAS float* nr = (LAS float*)(lds + OFF_KM);
        __syncthreads();
#pragma unroll
        for (int j = 0; j < 8; ++j) { float v = nacc[j]; v += __shfl_xor(v, 16); v += __shfl_xor(v, 32); if (lane < 16) nr[wid * 128 + sc + j] = v; }
        __syncthreads();
        if (tid < 128) { float v = 0.f;
#pragma unroll
            for (int w = 0; w < 8; ++w) v += nr[w * 128 + tid];
            WSP(float, WS_NS)[((size_t)(b * 4 + h) * 7 + blk) * 128 + tid] = v; }
    }
    __syncthreads();
    if (tid == 0) { __builtin_amdgcn_fence(__ATOMIC_RELEASE, "agent");
        __hip_atomic_fetch_add((unsigned*)(F.ctl + CW_QUEUE + 64 * (l * 8 + 6)), 1u, RLX_AGENT); }
}
template <int TYPE>
__device__ __forceinline__ void unit_linear(Frame& F, KArgs A, int l, int b, int h, int qb, unsigned long long& tpa, unsigned long long& tpb) {
    using namespace att; ATT_IDS();
    unsigned long long t_acc0 = 0ull; (void)t_acc0;
#ifdef TPROBE
#define ACC_BEGIN(id) do { if (TPROBE == (id) && l == 0) t_acc0 = __builtin_amdgcn_s_memrealtime(); } while (0)
#define ACC_END(id) do { if (TPROBE == (id) && l == 0) tpb += __builtin_amdgcn_s_memrealtime() - t_acc0; } while (0)
#else
#define ACC_BEGIN(id) do {} while (0)
#define ACC_END(id) do {} while (0)
#endif
    ACC_BEGIN(130 + 3 * TYPE / 2);
    LAS char* lds = (LAS char*)F.lds;
    const int q0 = qb * 256, q0w = q0 + wid * 32;
    bf16* Z = WSP(bf16, WS_Z) + (size_t)b * T * ZW;
    const bf16* QKM = WSP(bf16, WS_QKM) + (size_t)b * T * 1024;
    bf16x8 qr[8]; LaneCtx lc; lc.tq = q0w + r32; lc.qmask = 0u; lc.a = 0.f; lc.slope2 = 0.f;
    const bf16 *Kh, *Vh; int ldk; const float* Gk = nullptr;
    if (TYPE == 0) { load_q(qr, QKM + (size_t)lc.tq * 1024 + h * HD + hi * 8); Kh = QKM + 512 + h * HD; ldk = 1024; Vh = Z + Z_MV + h * HD;
        Gk = WSP(float, WS_GK) + (size_t)(b * 4 + h) * T; lc.a = WSP(float, WS_FQ)[(size_t)(b * 4 + h) * T + lc.tq]; }
    else { load_q(qr, Z + (size_t)lc.tq * ZW + Z_RQ + h * HD + hi * 8); Kh = Z + Z_RK + h * HD; ldk = ZW; Vh = Z + Z_RV + h * HD;
        lc.slope2 = -log2f(1.0f - exp2f(-5.0f - (float)h)); }
    f32x16 o[4] = {}; float m_reg = -1e29f, l_reg = 0.f;
    if (qb > 0) {
        const float* US = WSP(float, WS_US) + ((size_t)((TYPE == 0 ? 0 : 32) + b * 4 + h) * 7) * 16384;
        const float* F2 = WSP(float, WS_FQ) + (size_t)(b * 4 + h) * T;
        const float fprev = TYPE == 0 ? F2[q0 - 1] : 0.f;
        const int sr = tid >> 4, sc = (tid & 15) * 8;
        f32x4 sa[4][2] = {}; float nt = 0.f;
#pragma unroll 1
        for (int B = 0; B < qb; ++B) {
            const float cf = TYPE == 0 ? exp2f(fprev - F2[B * 256 + 255]) : exp2f(-lc.slope2 * 256.0f * (float)(qb - 1 - B));
            const float* Ub = US + (size_t)B * 16384 + (size_t)sr * 128 + sc;
#pragma unroll
            for (int r4 = 0; r4 < 4; ++r4) { sa[r4][0] += cf * *(const f32x4*)(Ub + r4 * 32 * 128); sa[r4][1] += cf * *(const f32x4*)(Ub + r4 * 32 * 128 + 4); }
            if (TYPE == 0 && tid < 128) nt += cf * WSP(float, WS_NS)[((size_t)(b * 4 + h) * 7 + B) * 128 + tid];
        }
#pragma unroll
        for (int r4 = 0; r4 < 4; ++r4) { v4u w; w.x = pk2(sa[r4][0][0], sa[r4][0][1]); w.y = pk2(sa[r4][0][2], sa[r4][0][3]); w.z = pk2(sa[r4][1][0], sa[r4][1][1]); w.w = pk2(sa[r4][1][2], sa[r4][1][3]);
            *(LAS v4u*)(lds + (r4 >> 1) * SHM_V + v_st((r4 & 1) * 32 + sr, sc)) = w; }
        LAS float* ntab = (LAS float*)(lds + OFF_KM);
        if (TYPE == 0 && tid < 128) ntab[tid] = nt;
        __syncthreads();
        const int vbs = (int)(unsigned)(uintptr_t)lds + v_rd_base(lane);
        pv_d0(o, vbs, qr[0], qr[1], qr[2], qr[3]); pv_d0(o, vbs + SHM_V, qr[4], qr[5], qr[6], qr[7]);
        const float rowfac = SCALE * (TYPE == 0 ? exp2f(lc.a - fprev) : exp2f(-lc.slope2 * (float)(lc.tq - q0 + 1)));
        rescale_o(o, rowfac, (LAS float*)(lds + OFF_WS) + wid * 128, r32, hi);
        if (TYPE == 0) { float dn = 0.f;
#pragma unroll
            for (int d0 = 0; d0 < 8; ++d0) { const f32x4 n0 = *(const LAS f32x4*)(ntab + 16 * d0 + 8 * hi), n1 = *(const LAS f32x4*)(ntab + 16 * d0 + 8 * hi + 4);
                const v4u qw = __builtin_bit_cast(v4u, qr[d0]);
                dn += bflo(qw.x) * n0[0] + bfhi(qw.x) * n0[1] + bflo(qw.y) * n0[2] + bfhi(qw.y) * n0[3] + bflo(qw.z) * n1[0] + bfhi(qw.z) * n1[1] + bflo(qw.w) * n1[2] + bfhi(qw.w) * n1[3]; }
            l_reg = dn * rowfac; }
        __syncthreads();
    }
    const unsigned tmask = 0xFu << (4 * qb), wmask = tmask;
    ACC_END(130 + 3 * TYPE / 2); ACC_BEGIN(131 + 3 * TYPE / 2);
    attn_pass<TYPE == 0 ? MD_MLSTM : MD_RET>(lds, Kh, ldk, Vh, ZW, Gk, Gk ? Gk + (WS_EK - WS_GK) / 4 : nullptr, tmask, wmask, qb, qr, o, m_reg, l_reg, lc);
    ACC_END(131 + 3 * TYPE / 2); ACC_BEGIN(132 + 3 * TYPE / 2);
    ATT_IDS_B(); const int q0wb = q0 + wb * 32;
    LAS float* sl = (LAS float*)(lds + OFF_WS) + wb * 128 + 64;
    float fr[16];
    if (TYPE == 0) { const float den = l_reg + __shfl_xor(l_reg, 32); const float inv = __builtin_amdgcn_rcpf(fmaxf(fabsf(den), 1.0f)); row_bcast(inv, fr, sl, r32b, hib); }
    else { float one = 1.0f; asm volatile("" : "+v"(one)); row_bcast(one, fr, sl, r32b, hib); }
    bf16* Yp = WSP(bf16, WS_YCAT) + ((size_t)b * T + q0wb) * KO + (TYPE == 0 ? 0 : 1024) + h * HD;
    const bf16* gate = Z + (size_t)q0wb * ZW + (TYPE == 0 ? Z_MO : Z_RG) + h * HD;
    const float* gain = (TYPE == 0 ? A->in[9] : A->in[11]) + (size_t)l * HD;
    store_rms_gate<TYPE == 0 ? 0 : 1>(o, fr, gain, gate, ZW, Yp, KO, r32b, hib);
    ACC_END(132 + 3 * TYPE / 2);
#undef ACC_BEGIN
#undef ACC_END
}
__device__ __forceinline__ void unit_moba(Frame& F, KArgs A, int l, int b, int h, int qb) {
    using namespace att; ATT_IDS();
    LAS char* lds = (LAS char*)F.lds;
    const int q0 = qb * 256, q0w = q0 + wid * 32;
    const bf16* Z = WSP(bf16, WS_Z) + (size_t)b * T * ZW;
    bf16x8 qr[8]; LaneCtx lc; lc.tq = q0w + r32; lc.a = 0.f; lc.slope2 = exp2f(-(float)(2 * h + 1)) * LOG2E; lc.qmask = 0u;
    load_q(qr, Z + (size_t)lc.tq * ZW + Z_BQ + h * HD + hi * 8);
    LAS float* km = (LAS float*)(lds + OFF_KM); LAS unsigned* un = (LAS unsigned*)(lds + OFF_UN);
    const float* kp = WSP(float, WS_KPART) + (size_t)(b * 4 + h) * 8 * 4 * 128;
    for (int idx = tid; idx < qb * 128; idx += NTHR) { const int blk = idx >> 7, d = idx & 127; const float* p = kp + (size_t)blk * 512 + d;
        km[idx] = ((p[0] + p[128]) + (p[256] + p[384])) * (1.0f / 256.0f); }
    if (tid == 0) un[0] = 0u;
    __syncthreads();
    float gv[7];
#pragma unroll
    for (int blk = 0; blk < 7; ++blk) { float g = 0.f;
        if (blk < qb) {
#pragma unroll
            for (int d0 = 0; d0 < 8; ++d0) { const f32x4 k0 = *(const LAS f32x4*)(km + blk * 128 + d0 * 16 + hi * 8), k1 = *(const LAS f32x4*)(km + blk * 128 + d0 * 16 + hi * 8 + 4);
                g += bf2f((bf16)qr[d0][0]) * k0.x + bf2f((bf16)qr[d0][1]) * k0.y + bf2f((bf16)qr[d0][2]) * k0.z + bf2f((bf16)qr[d0][3]) * k0.w
                   + bf2f((bf16)qr[d0][4]) * k1.x + bf2f((bf16)qr[d0][5]) * k1.y + bf2f((bf16)qr[d0][6]) * k1.z + bf2f((bf16)qr[d0][7]) * k1.w; }
            g += __shfl_xor(g, 32); }
        gv[blk] = g; }
    unsigned sel = 0u;
#pragma unroll
    for (int pass = 0; pass < 3; ++pass) { float best = -3.0e38f; int bi = -1;
#pragma unroll
        for (int blk = 0; blk < 7; ++blk) if (blk < qb && !((sel >> blk) & 1u) && gv[blk] > best) { best = gv[blk]; bi = blk; }
        if (bi >= 0) sel |= 1u << bi; }
    lc.qmask = sel;
    const unsigned wsel = wave_or(sel);
    if (lane == 0 && wsel) __hip_atomic_fetch_or(un, wsel, __ATOMIC_RELAXED, __HIP_MEMORY_SCOPE_WORKGROUP);
    __syncthreads();
    const unsigned usel = un[0];
    unsigned tmask = 0xFu << (4 * qb), wmask = causal_tiles(q0w + 31) & (0xFu << (4 * qb));
#pragma unroll
    for (int blk = 0; blk < 7; ++blk) { if ((usel >> blk) & 1u) tmask |= 0xFu << (4 * blk); if ((wsel >> blk) & 1u) wmask |= 0xFu << (4 * blk); }
    f32x16 o[4] = {}; float m_reg = -1e29f, l_reg = 0.f;
    attn_pass<MD_MOBA>(lds, Z + Z_BK + h * HD, ZW, Z + Z_BV + h * HD, ZW, nullptr, nullptr, tmask, wmask, qb, qr, o, m_reg, l_reg, lc);
    const float lsum = l_reg + __shfl_xor(l_reg, 32);
    epi_store<0>(o, __builtin_amdgcn_rcpf(lsum), nullptr, nullptr, 0, WSP(bf16, WS_YCAT) + ((size_t)b * T + q0w) * KO + 512 + h * HD, KO, (LAS float*)(lds + wid * 8448), lane);
}
__device__ __forceinline__ void unit_nsa_cs(Frame& F, KArgs A, int l, int b, int h, int qb) {
    using namespace att; ATT_IDS();
    LAS char* lds = (LAS char*)F.lds;
    const int q0 = qb * 256, q0w = q0 + wid * 32;
    const bf16* Z = WSP(bf16, WS_Z) + (size_t)b * T * ZW;
    bf16x8 qr[8]; LaneCtx lc; lc.tq = q0w + r32; lc.a = 0.f; lc.slope2 = exp2f(-(float)(2 * h + 2)) * LOG2E; lc.qmask = 0u;
    load_q(qr, Z + (size_t)lc.tq * ZW + Z_NQ + h * HD + hi * 8);
    LAS char* V_lds = lds; LAS char* K_lds = lds + OFF_K; LAS unsigned* un = (LAS unsigned*)(lds + OFF_UN);
    LAS float* sl = (LAS float*)(lds + OFF_WS) + wid * 128 + 64;
    const float* gt = WSP(float, WS_GT) + (size_t)(8 + h) * M + (size_t)b * T + lc.tq;
    const float g0 = sigmoid_f(gt[0]), g1 = sigmoid_f(gt[(size_t)4 * M]);
    f32x16 o[4] = {};
    bf16* Yn = WSP(bf16, WS_YCAT) + ((size_t)b * T + q0w) * KO + 1536 + h * HD;
    {
        const bf16* Kc = WSP(bf16, WS_KCMP) + (size_t)(b * 4 + h) * 128 * 128; const bf16* Vc = WSP(bf16, WS_VCMP) + (size_t)(b * 4 + h) * 128 * 128;
        const int sr = tid >> 4, sc = (tid & 15) * 8, vst0 = v_st(sr, sc), vst1 = v_st(32 + sr, sc), kc = sc * 2;
        if (tid == 0) un[0] = 0u;
#pragma unroll
        for (int t2 = 0; t2 < 2; ++t2) {
            const bf16x8 ks0 = *(const bf16x8*)(Kc + (size_t)(t2 * 64 + sr) * 128 + sc), ks1 = *(const bf16x8*)(Kc + (size_t)(t2 * 64 + 32 + sr) * 128 + sc);
            const bf16x8 vs0 = *(const bf16x8*)(Vc + (size_t)(t2 * 64 + sr) * 128 + sc), vs1 = *(const bf16x8*)(Vc + (size_t)(t2 * 64 + 32 + sr) * 128 + sc);
            *(LAS bf16x8*)(V_lds + t2 * SHM_V + vst0) = vs0; *(LAS bf16x8*)(V_lds + t2 * SHM_V + vst1) = vs1;
            *(LAS bf16x8*)(K_lds + t2 * SHM_K + KSWZ(sr, kc)) = ks0; *(LAS bf16x8*)(K_lds + t2 * SHM_K + KSWZ(32 + sr, kc)) = ks1; }
        __syncthreads();
        f32x16 sA0, sA1, sB0, sB1;
        { const KAddr ka = k_addr(r32, hi); qkt(sA0, sA1, K_lds, qr, ka); qkt(sB0, sB1, K_lds + SHM_K, qr, ka); }
        constexpr float C1 = SCALE * LOG2E;
        const int basec = lc.tq - 31 - 64 * hi;
        const float biasc = -lc.slope2 * (float)basec;
        float mx = -1e30f;
#pragma unroll
        for (int r = 0; r < 16; ++r) { const int c = crc(r);
            const float s0 = fmaf(sA0[r], C1, fmaf(lc.slope2, 16.0f * (float)c, biasc)), s1 = fmaf(sA1[r], C1, fmaf(lc.slope2, 16.0f * (float)(c + 32), biasc));
            const float s2 = fmaf(sB0[r], C1, fmaf(lc.slope2, 16.0f * (float)(c + 64), biasc)), s3 = fmaf(sB1[r], C1, fmaf(lc.slope2, 16.0f * (float)(c + 96), biasc));
            sA0[r] = (16 * c <= basec) ? s0 : -1e30f; sA1[r] = (16 * (c + 32) <= basec) ? s1 : -1e30f;
            sB0[r] = (16 * (c + 64) <= basec) ? s2 : -1e30f; sB1[r] = (16 * (c + 96) <= basec && (c + 96 + 4 * hi) < 127) ? s3 : -1e30f;
            mx = fmaxf(fmaxf(mx, fmaxf(sA0[r], sA1[r])), fmaxf(sB0[r], sB1[r])); }
        mx = fmaxf(swap_max(mx), -1e29f);
        float ps = 0.f;
#pragma unroll
        for (int r = 0; r < 16; ++r) { sA0[r] = __builtin_amdgcn_exp2f(sA0[r] - mx); sA1[r] = __builtin_amdgcn_exp2f(sA1[r] - mx); sB0[r] = __builtin_amdgcn_exp2f(sB0[r] - mx); sB1[r] = __builtin_amdgcn_exp2f(sB1[r] - mx);
            ps += (sA0[r] + sA1[r]) + (sB0[r] + sB1[r]); }
        const float lc_sum = swap_sum(ps);
        const int vb0 = (int)(unsigned)(uintptr_t)V_lds + v_rd_base(lane);
        float Gs[16], last[16];
#pragma unroll
        for (int a = 0; a < 4; ++a) {
            Gs[a] = (sA0[4 * a] + sA0[4 * a + 1]) + (sA0[4 * a + 2] + sA0[4 * a + 3]); last[a] = sA0[4 * a + 3];
            Gs[4 + a] = (sA1[4 * a] + sA1[4 * a + 1]) + (sA1[4 * a + 2] + sA1[4 * a + 3]); last[4 + a] = sA1[4 * a + 3];
            Gs[8 + a] = (sB0[4 * a] + sB0[4 * a + 1]) + (sB0[4 * a + 2] + sB0[4 * a + 3]); last[8 + a] = sB0[4 * a + 3];
            Gs[12 + a] = (sB1[4 * a] + sB1[4 * a + 1]) + (sB1[4 * a + 2] + sB1[4 * a + 3]); last[12 + a] = sB1[4 * a + 3]; }
        bf16x8 pA0, pA1, pA2, pA3, pB0, pB1, pB2, pB3;
        pack_p(sA0, sA1, pA0, pA1, pA2, pA3); pack_p(sB0, sB1, pB0, pB1, pB2, pB3);
        asm volatile("" : "+v"(pA0), "+v"(pA1), "+v"(pA2), "+v"(pA3), "+v"(pB0), "+v"(pB1), "+v"(pB2), "+v"(pB3));
        const int cur = lc.tq >> 6;
        float val[16]; float prevo = 0.f;
#pragma unroll
        for (int i = 0; i < 16; ++i) { const float ol = __shfl_xor(last[i], 32); const float add = hi ? ol : prevo; prevo = ol;
            val[i] = (2 * i + hi < cur) ? (Gs[i] + add) : -1.0f; }
        float cv[6]; int cj[6];
#pragma unroll
        for (int pass = 0; pass < 3; ++pass) { float best = -0.5f; int bi = 64;
#pragma unroll
            for (int i = 0; i < 16; ++i) if (val[i] > best) { best = val[i]; bi = 2 * i + hi; }
            cv[pass] = bi < 64 ? best : -1.0f; cj[pass] = bi;
#pragma unroll
            for (int i = 0; i < 16; ++i) if (2 * i + hi == bi) val[i] = -2.0f; }
#pragma unroll
        for (int k = 0; k < 3; ++k) { cv[3 + k] = __shfl_xor(cv[k], 32); cj[3 + k] = __shfl_xor(cj[k], 32); }
        unsigned sel = 0u;
#pragma unroll
        for (int pass = 0; pass < 3; ++pass) { float best = -0.5f; int bj = 64;
#pragma unroll
            for (int k = 0; k < 6; ++k) if (cv[k] > best || (cv[k] == best && cv[k] >= 0.f && cj[k] < bj)) { best = cv[k]; bj = cj[k]; }
            if (bj < 64) { sel |= 1u << bj;
#pragma unroll
                for (int k = 0; k < 6; ++k) if (cj[k] == bj) cv[k] = -2.0f; } }
        lc.qmask = sel | (1u << cur);
        pv_d0(o, vb0, pA0, pA1, pA2, pA3); pv_d0(o, vb0 + SHM_V, pB0, pB1, pB2, pB3);
        __syncthreads();
        epi_store<0>(o, lc_sum > 0.f ? g0 * __builtin_amdgcn_rcpf(lc_sum) : 0.f, nullptr, nullptr, 0, Yn, KO, (LAS float*)(lds + wid * 8448), lane);
    }
    const unsigned wsel = wave_or(lc.qmask);
    if (lane == 0) __hip_atomic_fetch_or(un, wsel, __ATOMIC_RELAXED, __HIP_MEMORY_SCOPE_WORKGROUP);
    __syncthreads();
    const unsigned usel = un[0];
#pragma unroll
    for (int d = 0; d < 4; ++d) o[d] = f32x16{};
    float m_reg = -1e29f, l_reg = 0.f;
    attn_pass<MD_SEL>(lds, Z + Z_NKS + h * HD, ZW, Z + Z_NVS + h * HD, ZW, nullptr, nullptr, usel, wsel, qb, qr, o, m_reg, l_reg, lc);
    const float lsum = l_reg + __shfl_xor(l_reg, 32);
    epi_store<1>(o, g1 * __builtin_amdgcn_rcpf(lsum), nullptr, nullptr, 0, Yn, KO, (LAS float*)(lds + wid * 8448), lane);
    {
        const int tlo = q0 >= 511 ? (q0 - 511) >> 6 : 0;
        const unsigned tmw = range_mask(tlo, (q0 + 255) >> 6);
#pragma unroll
        for (int d = 0; d < 4; ++d) o[d] = f32x16{};
        m_reg = -1e29f; l_reg = 0.f; lc.qmask = 0u;
        attn_pass<MD_WIN>(lds, Z + Z_NKW + h * HD, ZW, Z + Z_NVW + h * HD, ZW, nullptr, nullptr, tmw, tmw, qb, qr, o, m_reg, l_reg, lc);
        const float lw = l_reg + __shfl_xor(l_reg, 32);
        const float g2 = sigmoid_f(gt[(size_t)8 * M]);
        epi_store<1>(o, g2 * __builtin_amdgcn_rcpf(lw), nullptr, nullptr, 0, Yn, KO, (LAS float*)(lds + wid * 8448), lane);
    }
}
#define MIXER_QUEUE(kind, CALL) do { for (;;) { __syncthreads(); \
        if (F.tid == 0) uq[0] = (int)__hip_atomic_fetch_add((unsigned*)(F.ctl + CW_QUEUE + 64 * (qset * 16 + l * 8 + (kind))), 1u, RLX_AGENT); \
        __syncthreads(); const int u = __builtin_amdgcn_readfirstlane(uq[0]); if (u >= 256) break; \
        const int qb = 7 - (u >> 5), bh = u & 31, b = bh >> 2, h = bh & 3; CALL; } } while (0)
#define STATE_QUEUE(kind, CALL) do { for (;;) { __syncthreads(); \
        if (F.tid == 0) uq[0] = (int)__hip_atomic_fetch_add((unsigned*)(F.ctl + CW_QUEUE + 64 * (qset * 16 + l * 8 + (kind))), 1u, RLX_AGENT); \
        __syncthreads(); const int u = __builtin_amdgcn_readfirstlane(uq[0]); if (u >= 224) break; \
        const int bh = u / 7, blk = u - bh * 7, b = bh >> 2, h = bh & 3; CALL; } } while (0)
__device__ __forceinline__ void mixer_phase(Frame& F, KArgs A, int l, int qset, unsigned long long& tpa, unsigned long long& tpb) {
    LAS int* uq = (LAS int*)(F.lds + att::OFF_UN + 64);
    SUBSTAMP(110, tpa); SUBSTAMP(111, tpa); SUBSTAMP(112, tpa); SUBSTAMP(113, tpa); SUBSTAMP(114, tpa);
    STATE_QUEUE(4, unit_state<0>(F, A, l, b, h, blk));
    STATE_QUEUE(5, unit_state<2>(F, A, l, b, h, blk));
    if (EN2(6)) MIXER_QUEUE(3, unit_nsa_cs(F, A, l, b, h, qb));
    { if (F.tid == 0) { while (__hip_atomic_load((unsigned*)(F.ctl + CW_QUEUE + 64 * (l * 8 + 6)), RLX_AGENT) < 448u) __builtin_amdgcn_s_sleep(4); }
      __syncthreads(); __builtin_amdgcn_fence(__ATOMIC_ACQUIRE, "agent"); }
    SUBSTAMP(110, tpb);
    if (EN2(3)) MIXER_QUEUE(0, unit_linear<0>(F, A, l, b, h, qb, tpa, tpb));
    SUBSTAMP(111, tpb);
    if (EN2(4)) MIXER_QUEUE(1, unit_moba(F, A, l, b, h, qb));
    SUBSTAMP(112, tpb);
    if (EN2(5)) MIXER_QUEUE(2, unit_linear<2>(F, A, l, b, h, qb, tpa, tpb));
    SUBSTAMP(113, tpb);
    SUBSTAMP(114, tpb);
}
__device__ __forceinline__ void expert_starts(Frame& F, int l, LAS int* st, int shift) {
    if (F.tid == 0) { int run = 0;
        for (int e = 0; e < NE; ++e) { st[e] = run; const int c = (int)__hip_atomic_load(F.ctl + CW_CNT + l * 32 + e, RLX_AGENT); st[33 + e] = c; run += ((c + 255) >> 8) << (8 - shift); }
        st[NE] = run; }
    __syncthreads();
}
constexpr int NPHASE = 22;
#ifndef PH_MASK
#define PH_MASK 0xFFFFu
#endif
#define EN(j) ((PH_MASK >> (j)) & 1u)
#ifndef DUP_MASK
#define DUP_MASK 0u
#endif
#define REPS(j, l) ((((DUP_MASK) >> (j)) & 1u) && ((l) == 0 || !(((DUP_MASK) >> 16) & 1u)) ? 2 : 1)
#define DUPBAR(rep) do { if (rep) { SITE_FRAME(); XcdBarrier bar; bar.bar = (unsigned*)(F.ctl + CW_BAR); bar.x = xb_xcc_id(); bar.st = F.MISC + 8; xcd_barrier(bar); } } while (0)
#define SITE_FRAME() KArgs A = (KArgs)__builtin_amdgcn_kernarg_segment_ptr(); asm volatile("" : "+s"(A)); Frame F; \
    F.lds = (LAS unsigned char*)lds; F.MISC = (volatile LAS unsigned*)(F.lds + MISC_OFF); F.tid = threadIdx.x; asm volatile("" : "+v"(F.tid)); F.lane = F.tid & 63; F.wave = __builtin_amdgcn_readfirstlane(F.tid >> 6); \
    F.G = gridDim.x; F.bx = blockIdx.x; F.ws = A->ws; F.out = A->out; F.ctl = (gu32*)(F.ws + WS_CTL)
__global__ void __launch_bounds__(NTHR, 2) fwd_kernel(Args args) {
    extern __shared__ __attribute__((aligned(16))) unsigned char lds[];
    int lo, hi;
    unsigned long long tp_a = 0ull, tp_b = 0ull;
#ifdef TPROBE
#define TP_STAMP(k) do { if ((k) == TPROBE) tp_a = __builtin_amdgcn_s_memrealtime(); if ((k) == TPROBE + 1) tp_b = __builtin_amdgcn_s_memrealtime(); } while (0)
#else
#define TP_STAMP(k) do {} while (0)
#endif
    {
        SITE_FRAME();
        for (int u = F.tid; u < (LDS_BYTES - LDSCTL_OFF) / 4; u += NTHR) ((LAS unsigned*)(F.lds + LDSCTL_OFF))[u] = 0u;
        __syncthreads();
        lo = A->ph_lo; hi = A->ph_hi;
        if (hi - lo > 1) (void)xcd_barrier_post((unsigned*)(F.ctl + CW_BAR), F.MISC + 8);
    }
#define IN(k) (lo <= (k) && (k) < hi)
#define SEAM(k) do { if (IN(k) && IN((k) + 1)) { { SITE_FRAME(); XcdBarrier bar; bar.bar = (unsigned*)(F.ctl + CW_BAR); bar.x = xb_xcc_id(); bar.st = F.MISC + 8; xcd_barrier(bar); } TP_STAMP((k) + 1); } } while (0)
    TP_STAMP(0);
    for (int rep = 0; rep < REPS(10, 0); ++rep) { DUPBAR(rep); if (EN(10) && IN(0)) { SITE_FRAME(); p0_prologue(F, A); __syncthreads(); } }
    SEAM(0);
    for (int l = 0; l < NL; ++l) {
        const int pb = 1 + 10 * l;
        for (int rep = 0; rep < REPS(0, l); ++rep) { DUPBAR(rep); if (EN(0) && IN(pb + 0)) {
            SITE_FRAME(); const float* modl = WSP(float, WS_MOD) + (size_t)l * 8 * 12288;
            if (l == 0) normgemm_phase<false, 0, float>(F, A, l, A->in[0], nullptr, A->in[2], modl, modl + 2048, nullptr, tp_a, tp_b);
            else { expert_starts(F, l - 1, (LAS int*)(F.lds + LDSCTL_OFF), 0); normgemm_phase<true, 0, bf16>(F, A, l, WSP(bf16, WS_X1), F.out, A->in[2] + (size_t)l * D, modl, modl + 2048, modl - 8 * 12288 + 5 * 2048, tp_a, tp_b); }
        }
        }
        SEAM(pb + 0);
        for (int rep = 0; rep < REPS(1, l); ++rep) { DUPBAR(rep); if (EN(1) && IN(pb + 1)) {
            SITE_FRAME();
            pg8::Gemm g{WSP(bf16, WS_HB), WSP(bf16, WS_WINT) + (size_t)l * NZP * 2048, M, NZP, D}; pg8::StaticOrder S; S.init(M, NZP, F.G, F.bx);
            pg8::EpiZ E{WSP(bf16, WS_Z), WSP(float, WS_GT), A->in[10] + (size_t)l * 256, A->in[12] + (size_t)l * 128, A->in[13] + (size_t)l * 384, (LAS float*)(F.lds + MISC_OFF + 1024)};
            pg8::gemm_phase<pg8::EpiZ, pg8::StaticOrder, true, true>(F.lds + RING_OFF, g, S, E);
        }
        }
        SEAM(pb + 1);
        for (int rep = 0; rep < REPS(2, l); ++rep) { DUPBAR(rep); if (EN(2) && IN(pb + 2)) { SITE_FRAME(); prep_phase(F, A, l, tp_a, tp_b); }
        }
        SEAM(pb + 2);
        for (int rep = 0; rep < REPS(3, l); ++rep) { DUPBAR(rep); if (EN(3) && IN(pb + 3)) { SITE_FRAME(); mixer_phase(F, A, l, rep, tp_a, tp_b); }
        }
        SEAM(pb + 3);
        for (int rep = 0; rep < REPS(4, l); ++rep) { DUPBAR(rep); if (EN(4) && IN(pb + 4)) {
            SITE_FRAME(); const float* modl = WSP(float, WS_MOD) + (size_t)l * 8 * 12288;
            pg8::Gemm g{WSP(bf16, WS_YCAT), WSP(bf16, WS_WOUTT) + (size_t)l * 2048 * KO, M, D, KO}; pg8::StaticOrder S; S.init(M, D, F.G, F.bx);
            pg8::EpiX1 E{l == 0 ? A->in[0] : (const float*)F.out, WSP(bf16, WS_X1), modl + 2 * 2048};
            pg8::gemm_phase<pg8::EpiX1, pg8::StaticOrder, true, true>(F.lds + RING_OFF, g, S, E);
        }
        }
        SEAM(pb + 4);
        for (int rep = 0; rep < REPS(5, l); ++rep) { DUPBAR(rep); if (EN(5) && IN(pb + 5)) { SITE_FRAME(); const float* modl = WSP(float, WS_MOD) + (size_t)l * 8 * 12288;
            normgemm_phase<false, 1, bf16>(F, A, l, WSP(bf16, WS_X1), nullptr, A->in[3] + (size_t)l * D, modl + 3 * 2048, modl + 4 * 2048, nullptr, tp_a, tp_b); }
        }
        SEAM(pb + 5);
        for (int rep = 0; rep < REPS(6, l); ++rep) { DUPBAR(rep); if (EN(6) && IN(pb + 6)) {   }
        }
        for (int rep = 0; rep < REPS(7, l); ++rep) { DUPBAR(rep); if (EN(7) && IN(pb + 7)) {   }
        }
        for (int rep = 0; rep < REPS(8, l); ++rep) { DUPBAR(rep); if (EN(8) && IN(pb + 8)) {
            SITE_FRAME();
            LAS int* st = (LAS int*)(F.lds + LDSCTL_OFF); expert_starts(F, l, st, 8);
            const int nrt = st[NE];
            pg8::Gemm g{WSP(bf16, WS_HB), WSP(bf16, WS_W13T) + (size_t)l * NE * 1024 * 2048, SLOTS, NE * 1024, D};
            pg8::GroupedOrder S{nrt * 4, 4, F.G, F.bx, (const LAS int*)st, WSP(int, WS_TOKL)};
            pg8::EpiH E{WSP(bf16, WS_HBUF)};
            pg8::gemm_phase<pg8::EpiH, pg8::GroupedOrder, true, true, true>(F.lds + RING_OFF, g, S, E);
            __syncthreads();
        }
        }
        SEAM(pb + 8);
        for (int rep = 0; rep < REPS(9, l); ++rep) { DUPBAR(rep); if (EN(9) && IN(pb + 9)) {
            SITE_FRAME();
            LAS int* st = (LAS int*)(F.lds + LDSCTL_OFF); expert_starts(F, l, st, 8);
            const int nrt = st[NE];
            pg8::Gemm g{WSP(bf16, WS_HBUF), WSP(bf16, WS_W2T) + (size_t)l * NE * 2048 * DE, SLOTS, NE * 2048, DE};
            pg8::GroupedOrder S{nrt * 8, 8, F.G, F.bx, (const LAS int*)st, nullptr};
            pg8::EpiY E{WSP(bf16, WS_Y)};
            pg8::gemm_phase<pg8::EpiY, pg8::GroupedOrder, true, true>(F.lds + RING_OFF, g, S, E);
            __syncthreads();
        }
        }
        SEAM(pb + 9);
    }
    if (EN(11) && IN(21)) { SITE_FRAME(); expert_starts(F, NL - 1, (LAS int*)(F.lds + LDSCTL_OFF), 0); norm_phase<true, false, bf16>(F, WSP(bf16, WS_X1), F.out, nullptr, nullptr, nullptr, WSP(float, WS_MOD) + (size_t)1 * 8 * 12288 + 5 * 2048); }
#ifdef TPROBE
    if (TPROBE == 21) tp_b = __builtin_amdgcn_s_memrealtime();
    if (blockIdx.x == 0) { const unsigned long long dt = (tp_b - tp_a) * 20ull, t0 = __builtin_amdgcn_s_memrealtime(); while (__builtin_amdgcn_s_memrealtime() - t0 < dt) __builtin_amdgcn_s_sleep(8); }
#endif
#undef IN
#undef SEAM
}

#ifndef MK_PER_PHASE
#define MK_PER_PHASE 0
#endif
extern "C" void kernel_launch(void* const* d_in, const int* in_sizes, int n_in, void* d_out, int out_size, void* d_ws, size_t ws_size, hipStream_t stream) {
    static int grid = 0;
    if (grid == 0) {
        if (n_in != 25 || in_sizes[0] != M * D || out_size != M * D || ws_size < WS_END) { fprintf(stderr, "kernel_launch: shape/workspace mismatch (n_in %d, ws %zu, need %zu)\n", n_in, ws_size, (size_t)WS_END); grid = -1; return; }
        int dev = 0, cus = 0, per_cu = 0;
        if (hipGetDevice(&dev) != hipSuccess || hipDeviceGetAttribute(&cus, hipDeviceAttributeMultiprocessorCount, dev) != hipSuccess) { grid = -1; return; }
        if (hipFuncSetAttribute((const void*)fwd_kernel, hipFuncAttributeMaxDynamicSharedMemorySize, LDS_BYTES) != hipSuccess) { fprintf(stderr, "kernel_launch: hipFuncSetAttribute failed\n"); grid = -1; return; }
        if (hipOccupancyMaxActiveBlocksPerMultiprocessor(&per_cu, (const void*)fwd_kernel, NTHR, LDS_BYTES) != hipSuccess || per_cu < 1) { fprintf(stderr, "kernel_launch: occupancy query says %d\n", per_cu); }
        (void)hipGetLastError();
        grid = cus;
    }
    if (grid < 0) return;
    if (hipMemsetAsync((char*)d_ws + WS_CTL, 0, CTL_ZERO_BYTES, stream) != hipSuccess) { fprintf(stderr, "kernel_launch: memset failed\n"); return; }
    Args a{};
    for (int i = 0; i < 25; ++i) a.in[i] = (const float*)d_in[i];
    a.out = (float*)d_out; a.ws = (unsigned char*)d_ws;
#if MK_PER_PHASE
    for (int p = 0; p < NPHASE; ++p) { a.ph_lo = p; a.ph_hi = p + 1; hipLaunchKernelGGL(fwd_kernel, dim3(grid), dim3(NTHR), LDS_BYTES, stream, a); }
#else
    a.ph_lo = 0; a.ph_hi = NPHASE;
    hipLaunchKernelGGL(fwd_kernel, dim3(grid), dim3(NTHR), LDS_BYTES, stream, a);
#endif
    const hipError_t le = hipPeekAtLastError();
    if (le != hipSuccess) fprintf(stderr, "kernel_launch: launch failed: %s\n", hipGetErrorName(le));
}
```

```cpp
#include <hip/hip_runtime.h>
#include <cstdio>
#include <cstdint>
__device__ __forceinline__ int mk_lane_fresh() { int l = __builtin_amdgcn_mbcnt_hi(-1, __builtin_amdgcn_mbcnt_lo(-1, 0)); asm volatile("" : "+v"(l)); return l; }
__device__ __forceinline__ float mk_shx(float v, int mask) { return __builtin_bit_cast(float, __builtin_amdgcn_ds_bpermute((mk_lane_fresh() ^ mask) << 2, __builtin_bit_cast(int, v))); }
__device__ __forceinline__ int mk_shx(int v, int mask) { return __builtin_amdgcn_ds_bpermute((mk_lane_fresh() ^ mask) << 2, v); }
__device__ __forceinline__ unsigned mk_shx(unsigned v, int mask) { return (unsigned)__builtin_amdgcn_ds_bpermute((mk_lane_fresh() ^ mask) << 2, (int)v); }
#define __shfl_xor(v, m) mk_shx((v), (m))
#define MK_PER_PHASE 0
namespace pg8 {
#define PG8_LAS __attribute__((address_space(3)))
typedef unsigned short bf16_t;
typedef short bf16x8 __attribute__((ext_vector_type(8)));
typedef float f32x4 __attribute__((ext_vector_type(4)));
typedef unsigned u32x4 __attribute__((ext_vector_type(4)));
constexpr int BM = 256, BK = 64, HALF = 128, HTB = HALF * BK * 2  , STAGE_BYTES = 8 * HTB, NXCD = 8, WGM = 8;

__host__ __device__ __forceinline__ int lds_byte(int r, int c) { const int st = (r >> 4) * 2 + (c >> 5), rr = r & 15, cc = c & 31, ob = rr * 64 + cc * 2; return st * 1024 + (ob ^ (((ob >> 9) & 1) << 5)); }
__host__ __device__ __forceinline__ void stage_rc(int b, int& R, int& C) { const int st = b / 1024, sb = b % 1024, swz = sb ^ (((sb >> 9) & 1) << 5); R = (st >> 1) * 16 + swz / 64; C = (st & 1) * 32 + (swz % 64) / 2; }
__host__ __device__ __forceinline__ int perm32(int rho) { const int n = rho >> 4, i = rho & 15; return 8 * (i >> 2) + 4 * n + (i & 3); }

struct Unit { int pm, pn; };
struct Gemm { const bf16_t* A; const bf16_t* Bt; int M, N, K; };

struct StaticOrder {
    int nM, nN, nwg, G, c;
    __host__ __device__ void init(int M, int N, int G_, int c_) { nM = M / BM; nN = N / BM; nwg = nM * nN; G = G_; c = c_; }
    __host__ __device__ bool next(int i, Unit& u) const {
        const long L = (long)i * G + c; if (L >= nwg) return false;
        int wgid = (int)L; { const int q = nwg / NXCD, r = nwg % NXCD, xcd = wgid % NXCD, off = wgid / NXCD; wgid = (xcd < r ? xcd * (q + 1) : r * (q + 1) + (xcd - r) * q) + off; }
        const int nig = WGM * nN, gid = wgid / nig, fm = gid * WGM, gsz = (nM - fm) < WGM ? (nM - fm) : WGM;
        u.pm = fm + ((wgid % nig) % gsz); u.pn = (wgid % nig) / gsz; return true;
    }
    __device__ __forceinline__ void a_ready(const Unit&) const {}
    __device__ __forceinline__ void done(const Unit&) const {}
};

__device__ __forceinline__ unsigned cvt_pk_bf16(float lo, float hi) { unsigned r; asm volatile("v_cvt_pk_bf16_f32 %0, %1, %2" : "=v"(r) : "v"(lo), "v"(hi)); return r; }
__device__ __forceinline__ float silu_f(float v) { return v * __builtin_amdgcn_rcpf(1.0f + __expf(-v)); }

struct EpiZ {
    static constexpr bool PERM = true, AFTER_DRAIN = false;
    bf16_t* Z; float* Gt; const float* gbq; const float* gnq; const float* gnk; PG8_LAS float* red;
    __device__ __forceinline__ void operator()(const f32x4 (&acc)[2][2][4][2], const Unit& u, int wr, int wc, int fr, int fq) const {
        const int row0 = u.pm * BM + wr * 64 + fr;
        const int col0 = u.pn * BM + wc * 32 + 8 * fq;
        const int pn = u.pn;
        const float* gp = nullptr;
        if (pn == 8 || pn == 9) gp = gbq; else if (pn == 10 || pn == 11) gp = gbq + 128; else if (pn == 22 || pn == 23) gp = gnq; else if (pn == 28 || pn == 29) gp = gnk + 128; else if (pn == 32 || pn == 33) gp = gnk + 256;
        if (gp == nullptr) {
#pragma unroll
            for (int ai = 0; ai < 2; ++ai)
#pragma unroll
                for (int m = 0; m < 4; ++m) { bf16_t* rowp = Z + (size_t)(row0 + ai * HALF + m * 16) * 9216 + col0;
#pragma unroll
                    for (int bj = 0; bj < 2; ++bj) { const f32x4 v0 = acc[ai][bj][m][0], v1 = acc[ai][bj][m][1];
                        u32x4 w; w.x = cvt_pk_bf16(v0[0], v0[1]); w.y = cvt_pk_bf16(v0[2], v0[3]); w.z = cvt_pk_bf16(v1[0], v1[1]); w.w = cvt_pk_bf16(v1[2], v1[3]);
                        *(u32x4*)(rowp + bj * HALF) = w; } }
        } else {
            const f32x4 g0 = *(const f32x4*)(gp + wc * 32 + 8 * fq), g1 = *(const f32x4*)(gp + wc * 32 + 8 * fq + 4);
#pragma unroll
            for (int ai = 0; ai < 2; ++ai)
#pragma unroll
                for (int m = 0; m < 4; ++m)
#pragma unroll
                    for (int bj = 0; bj < 2; ++bj) { const f32x4 v0 = acc[ai][bj][m][0], v1 = acc[ai][bj][m][1];
                        float ss = (v0[0] * v0[0] + v0[1] * v0[1]) + (v0[2] * v0[2] + v0[3] * v0[3]) + (v1[0] * v1[0] + v1[1] * v1[1]) + (v1[2] * v1[2] + v1[3] * v1[3]);
                        ss += __shfl_xor(ss, 16); ss += __shfl_xor(ss, 32);
                        if (fq == 0) red[((wr * 64 + fr + ai * HALF + m * 16) * 2 + bj) * 4 + wc] = ss; }
            asm volatile("s_waitcnt lgkmcnt(0)" ::: "memory"); __builtin_amdgcn_s_barrier(); asm volatile("" ::: "memory");
#pragma unroll
            for (int ai = 0; ai < 2; ++ai)
#pragma unroll
                for (int m = 0; m < 4; ++m) { bf16_t* rowp = Z + (size_t)(row0 + ai * HALF + m * 16) * 9216 + col0;
#pragma unroll
                    for (int bj = 0; bj < 2; ++bj) { const f32x4 t = *(const PG8_LAS f32x4*)(red + ((wr * 64 + fr + ai * HALF + m * 16) * 2 + bj) * 4);
                        const float rn = __builtin_amdgcn_rsqf(((t[0] + t[1]) + (t[2] + t[3])) * (1.0f / 128.0f) + 1e-6f);
                        const f32x4 v0 = acc[ai][bj][m][0] * rn * g0, v1 = acc[ai][bj][m][1] * rn * g1;
                        u32x4 w; w.x = cvt_pk_bf16(v0[0], v0[1]); w.y = cvt_pk_bf16(v0[2], v0[3]); w.z = cvt_pk_bf16(v1[0], v1[1]); w.w = cvt_pk_bf16(v1[2], v1[3]);
                        *(u32x4*)(rowp + bj * HALF) = w; } }
        }
    }
};
struct EpiX1 {
    static constexpr bool PERM = true, AFTER_DRAIN = false;
    const float* xin; bf16_t* out; const float* g1;
    __device__ __forceinline__ void operator()(const f32x4 (&acc)[2][2][4][2], const Unit& u, int wr, int wc, int fr, int fq) const {
        const int row0 = u.pm * BM + wr * 64 + fr, col0 = u.pn * BM + wc * 32 + 8 * fq;
        const float* gb = g1 + (size_t)(u.pm >> 3) * 12288 + col0;
        f32x4 gv[2][2];
#pragma unroll
        for (int bj = 0; bj < 2; ++bj)
#pragma unroll
            for (int n = 0; n < 2; ++n) gv[bj][n] = *(const f32x4*)(gb + bj * HALF + 4 * n);
#pragma unroll
        for (int ai = 0; ai < 2; ++ai)
#pragma unroll
            for (int m = 0; m < 4; ++m) { const size_t off = (size_t)(row0 + ai * HALF + m * 16) * 2048 + col0;
#pragma unroll
                for (int bj = 0; bj < 2; ++bj) { const f32x4 x0 = *(const f32x4*)(xin + off + bj * HALF), x1 = *(const f32x4*)(xin + off + bj * HALF + 4);
                    const f32x4 v0 = x0 + gv[bj][0] * acc[ai][bj][m][0], v1 = x1 + gv[bj][1] * acc[ai][bj][m][1];
                    u32x4 w; w.x = cvt_pk_bf16(v0[0], v0[1]); w.y = cvt_pk_bf16(v0[2], v0[3]); w.z = cvt_pk_bf16(v1[0], v1[1]); w.w = cvt_pk_bf16(v1[2], v1[3]);
                    *(u32x4*)(out + off + bj * HALF) = w; } }
    }
};
struct EpiH {
    static constexpr bool PERM = true, AFTER_DRAIN = false;
    bf16_t* H;
    __device__ __forceinline__ void operator()(const f32x4 (&acc)[2][2][4][2], const Unit& u, int wr, int wc, int fr, int fq) const {
        const int row0 = u.pm * BM + wr * 64 + fr, col0 = (u.pn & 3) * 128 + wc * 32 + 8 * fq;
#pragma unroll
        for (int ai = 0; ai < 2; ++ai)
#pragma unroll
            for (int m = 0; m < 4; ++m) { const f32x4 a0 = acc[ai][0][m][0], a1 = acc[ai][0][m][1], b0 = acc[ai][1][m][0], b1 = acc[ai][1][m][1];
                u32x4 w; w.x = cvt_pk_bf16(silu_f(a0[0]) * b0[0], silu_f(a0[1]) * b0[1]); w.y = cvt_pk_bf16(silu_f(a0[2]) * b0[2], silu_f(a0[3]) * b0[3]);
                w.z = cvt_pk_bf16(silu_f(a1[0]) * b1[0], silu_f(a1[1]) * b1[1]); w.w = cvt_pk_bf16(silu_f(a1[2]) * b1[2], silu_f(a1[3]) * b1[3]);
                *(u32x4*)(H + (size_t)(row0 + ai * HALF + m * 16) * 512 + col0) = w; }
    }
};
struct EpiY {
    static constexpr bool PERM = true, AFTER_DRAIN = false;
    bf16_t* Y;
    __device__ __forceinline__ void operator()(const f32x4 (&acc)[2][2][4][2], const Unit& u, int wr, int wc, int fr, int fq) const {
        const int row0 = u.pm * BM + wr * 64 + fr, col0 = (u.pn & 7) * BM + wc * 32 + 8 * fq;
#pragma unroll
        for (int ai = 0; ai < 2; ++ai)
#pragma unroll
            for (int m = 0; m < 4; ++m) { bf16_t* rowp = Y + (size_t)(row0 + ai * HALF + m * 16) * 2048 + col0;
#pragma unroll
                for (int bj = 0; bj < 2; ++bj) { const f32x4 v0 = acc[ai][bj][m][0], v1 = acc[ai][bj][m][1];
                    u32x4 w; w.x = cvt_pk_bf16(v0[0], v0[1]); w.y = cvt_pk_bf16(v0[2], v0[3]); w.z = cvt_pk_bf16(v1[0], v1[1]); w.w = cvt_pk_bf16(v1[2], v1[3]);
                    *(u32x4*)(rowp + bj * HALF) = w; } }
    }
};
struct GroupedOrder {
    int nU, NCT, G, c; const PG8_LAS int* tstart; const int* tokl;
    __device__ __forceinline__ bool next(int i, Unit& u) const {
        const long L = (long)i * G + c; if (L >= nU) return false;
        int wgid = (int)L; { const int q = nU / NXCD, r = nU % NXCD, xcd = wgid % NXCD, off = wgid / NXCD; wgid = (xcd < r ? xcd * (q + 1) : r * (q + 1) + (xcd - r) * q) + off; }
        const int rt = wgid / NCT, ct = wgid - rt * NCT;
        int e = 0;
#pragma unroll
        for (int k = 1; k < 32; ++k) e += (tstart[k] <= rt) ? 1 : 0;
        e = __builtin_amdgcn_readfirstlane(e);
        u.pm = rt; u.pn = e * NCT + ct; return true;
    }
    __device__ __forceinline__ int row_token(const Unit& u, int r) const { const int e = u.pn / NCT; const int pos = (u.pm - tstart[e]) * 256 + r, last = tstart[33 + e] - 1; return tokl[e * 16384 + (pos < last ? pos : last)]; }
    __device__ __forceinline__ void a_ready(const Unit&) const {}
    __device__ __forceinline__ void done(const Unit&) const {}
};
template <class Epi, class Sched, bool ALIGN_EPI = false, bool SP2 = false, bool GATHER = false>
__device__ __forceinline__ void gemm_phase(PG8_LAS unsigned char* lds, const Gemm g, const Sched& S, const Epi& E) {
    int tid_ = threadIdx.x; asm volatile("" : "+v"(tid_));
    const int tid = tid_, wid = __builtin_amdgcn_readfirstlane(tid >> 6), lane = tid & 63, wr = wid >> 2, wc = wid & 3, fr = lane & 15, fq = lane >> 4;
    const int K = g.K, nt = K / BK;
    unsigned voffA[2], voffB[2]; int Rrow[2]; unsigned Ccol2[2];
#pragma unroll
    for (int i = 0; i < 2; ++i) { int R, C; stage_rc(tid * 16 + i * 8192, R, C); const int Rb = Epi::PERM ? ((R & ~31) + perm32(R & 31)) : R;
        voffA[i] = (unsigned)(R * K + C) * 2u; voffB[i] = (unsigned)(Rb * K + C) * 2u; Rrow[i] = R; Ccol2[i] = (unsigned)C * 2u; }
    unsigned gC0[2] = {0u, 0u}, gC1[2] = {0u, 0u}, gN0[2] = {0u, 0u}, gN1[2] = {0u, 0u}, sx0[2] = {0u, 0u}, sx1[2] = {0u, 0u};
#define PG8_GROWS(D0, D1, U) do { _Pragma("unroll") for (int _i = 0; _i < 2; ++_i) { D0[_i] = (unsigned)S.row_token(U, Rrow[_i]) * (unsigned)(K * 2) + Ccol2[_i]; D1[_i] = (unsigned)S.row_token(U, HALF + Rrow[_i]) * (unsigned)(K * 2) + Ccol2[_i]; } } while (0)
#define VA0C (GATHER ? gC0 : voffA)
#define VA1C (GATHER ? gC1 : voffA)
#define VA0X (GATHER ? sx0 : voffA)
#define VA1X (GATHER ? sx1 : voffA)
#define AH(p) (GATHER ? (p) : (p) + hstep)
    const size_t kstep = (size_t)(BK * 2);
    const size_t hstep = (size_t)HALF * K * 2;
    const size_t tstep = 2 * hstep;
    const unsigned ldsw = (unsigned)wid * 1024u;
    const int aoff = lds_byte(wr * 64 + fr, fq * 8), boff = lds_byte(wc * 32 + fr, fq * 8);
#define PG8_SA(b, h) (((b) * 2 + (h)) * HTB)
#define PG8_SB(b, h) ((4 + (b) * 2 + (h)) * HTB)
#define PG8_STAGE(bufoff, gbase, voff) do { _Pragma("unroll") for (int _i = 0; _i < 2; ++_i) \
        __builtin_amdgcn_global_load_lds((const unsigned*)((const char*)(gbase) + (voff)[_i]), (PG8_LAS unsigned*)(lds + (bufoff) + ldsw + _i * 8192), 16, 0, 0); } while (0)
#define PG8_LDA(dst, b, h) do { _Pragma("unroll") for (int m = 0; m < 4; ++m) _Pragma("unroll") for (int k = 0; k < 2; ++k) dst[m][k] = *(const PG8_LAS bf16x8*)(lds + PG8_SA(b, h) + aoff + m * 2048 + k * 1024); } while (0)
#define PG8_LDB(dst, b, h) do { _Pragma("unroll") for (int n = 0; n < 2; ++n) _Pragma("unroll") for (int k = 0; k < 2; ++k) dst[n][k] = *(const PG8_LAS bf16x8*)(lds + PG8_SB(b, h) + boff + n * 2048 + k * 1024); } while (0)
#define PG8_MMA(ai, bj, At, Bt) do { __builtin_amdgcn_s_setprio(1); _Pragma("unroll") for (int m = 0; m < 4; ++m) _Pragma("unroll") for (int n = 0; n < 2; ++n) _Pragma("unroll") for (int k = 0; k < 2; ++k) \
        acc[ai][bj][m][n] = __builtin_amdgcn_mfma_f32_16x16x32_bf16(Bt[n][k], At[m][k], acc[ai][bj][m][n], 0, 0, 0); __builtin_amdgcn_s_setprio(0); } while (0)
#define PG8_WAIT_V(n) asm volatile("s_waitcnt vmcnt(" #n ")" ::: "memory")
#define PG8_WAIT_L(n) asm volatile("s_waitcnt lgkmcnt(" #n ")" ::: "memory")
#define PG8_BAR __builtin_amdgcn_s_barrier()
#define PG8_SCHED __builtin_amdgcn_sched_barrier(0)
    Unit cur, nxt; int ui = 0;
    if (!S.next(0, cur)) return;
    f32x4 acc[2][2][4][2];
#pragma unroll
    for (int a = 0; a < 2; ++a)
#pragma unroll
        for (int b = 0; b < 2; ++b)
#pragma unroll
            for (int m = 0; m < 4; ++m)
#pragma unroll
                for (int n = 0; n < 2; ++n) acc[a][b][m][n] = (f32x4){0.f, 0.f, 0.f, 0.f};
    bf16x8 At[4][2], B0[2][2], B1[2][2];
    const char* cA = (const char*)g.A + (GATHER ? (size_t)0 : (size_t)cur.pm * tstep); const char* cB = (const char*)g.Bt + (size_t)cur.pn * tstep;
    S.a_ready(cur);
    if constexpr (GATHER) { PG8_GROWS(gC0, gC1, cur); }
    if constexpr (SP2) {
        PG8_STAGE(PG8_SB(0, 0), cB, voffB); PG8_STAGE(PG8_SB(0, 1), cB + hstep, voffB); PG8_STAGE(PG8_SA(0, 0), cA, VA0C); PG8_STAGE(PG8_SA(0, 1), AH(cA), VA1C);
        if (wr == 1) PG8_BAR;
        PG8_WAIT_V(2); PG8_BAR;
        PG8_STAGE(PG8_SB(1, 0), cB + kstep, voffB); PG8_STAGE(PG8_SA(1, 0), cA + kstep, VA0C); PG8_STAGE(PG8_SB(1, 1), cB + hstep + kstep, voffB);
        PG8_WAIT_V(6); PG8_BAR;
    } else {
        PG8_STAGE(PG8_SB(0, 0), cB, voffB); PG8_STAGE(PG8_SA(0, 0), cA, voffA); PG8_STAGE(PG8_SB(0, 1), cB + hstep, voffB); PG8_STAGE(PG8_SA(0, 1), cA + hstep, voffA);
        if (wr == 1) PG8_BAR;
        PG8_WAIT_V(4); PG8_BAR;
        PG8_STAGE(PG8_SB(1, 0), cB + kstep, voffB); PG8_STAGE(PG8_SA(1, 0), cA + kstep, voffA); PG8_STAGE(PG8_SB(1, 1), cB + hstep + kstep, voffB);
        PG8_WAIT_V(6); PG8_BAR;
    }
    for (;;) {
        const bool has_next = S.next(ui + 1, nxt);
        const char* nA = (has_next && !GATHER) ? (const char*)g.A + (size_t)nxt.pm * tstep : cA; const char* nB = has_next ? (const char*)g.Bt + (size_t)nxt.pn * tstep : cB;
        if constexpr (GATHER) { if (has_next) { PG8_GROWS(gN0, gN1, nxt); } else { _Pragma("unroll") for (int _i = 0; _i < 2; ++_i) { gN0[_i] = gC0[_i]; gN1[_i] = gC1[_i]; } } }
        for (int t = 0; t < nt; t += 2) {
            const bool last = (t == nt - 2);
            const char* a1 = cA + (size_t)(t + 1) * kstep;
            const char* a2 = last ? nA : cA + (size_t)(t + 2) * kstep; const char* b2 = last ? nB : cB + (size_t)(t + 2) * kstep;
            const char* a3 = a2 + kstep; const char* b3 = b2 + kstep;
            if (last && has_next) S.a_ready(nxt);
            if constexpr (GATHER) { _Pragma("unroll") for (int _i = 0; _i < 2; ++_i) { sx0[_i] = last ? gN0[_i] : gC0[_i]; sx1[_i] = last ? gN1[_i] : gC1[_i]; } }
            if constexpr (SP2) {
            PG8_LDB(B0, 0, 0); PG8_LDB(B1, 0, 1); PG8_SCHED; PG8_LDA(At, 0, 0); PG8_STAGE(PG8_SA(1, 1), AH(a1), VA1C);
            PG8_WAIT_V(8); PG8_WAIT_L(0); PG8_BAR; PG8_MMA(0, 0, At, B0); PG8_MMA(0, 1, At, B1); PG8_BAR; PG8_SCHED;
            PG8_LDA(At, 0, 1); PG8_STAGE(PG8_SB(0, 0), b2, voffB); PG8_STAGE(PG8_SB(0, 1), b2 + hstep, voffB); PG8_STAGE(PG8_SA(0, 0), a2, VA0X);
            PG8_WAIT_V(8); PG8_WAIT_L(0); PG8_BAR; PG8_MMA(1, 0, At, B0); PG8_MMA(1, 1, At, B1); PG8_BAR; PG8_SCHED;
            PG8_LDB(B0, 1, 0); PG8_LDB(B1, 1, 1); PG8_SCHED; PG8_LDA(At, 1, 0); PG8_STAGE(PG8_SA(0, 1), AH(a2), VA1X);
            PG8_WAIT_V(8); PG8_WAIT_L(0); PG8_BAR; PG8_MMA(0, 0, At, B0); PG8_MMA(0, 1, At, B1); PG8_BAR; PG8_SCHED;
            PG8_LDA(At, 1, 1); PG8_STAGE(PG8_SB(1, 0), b3, voffB); PG8_STAGE(PG8_SB(1, 1), b3 + hstep, voffB); PG8_STAGE(PG8_SA(1, 0), a3, VA0X);
            PG8_WAIT_V(8); PG8_WAIT_L(0); PG8_BAR; PG8_MMA(1, 0, At, B0); PG8_MMA(1, 1, At, B1); PG8_BAR; PG8_SCHED;
            } else {
            PG8_LDB(B0, 0, 0); PG8_SCHED; PG8_LDA(At, 0, 0); PG8_STAGE(PG8_SA(1, 1), a1 + hstep, voffA);
            PG8_WAIT_L(8); PG8_BAR; PG8_WAIT_L(0); PG8_MMA(0, 0, At, B0); PG8_BAR; PG8_SCHED;
            PG8_LDB(B1, 0, 1); PG8_STAGE(PG8_SB(0, 0), b2, voffB);
            PG8_BAR; PG8_WAIT_L(0); PG8_MMA(0, 1, At, B1); PG8_BAR;
            PG8_LDA(At, 0, 1); PG8_STAGE(PG8_SA(0, 0), a2, voffA);
            PG8_BAR; PG8_WAIT_L(0); PG8_MMA(1, 0, At, B0); PG8_BAR; PG8_SCHED;
            PG8_STAGE(PG8_SB(0, 1), b2 + hstep, voffB);
            PG8_WAIT_V(6); PG8_BAR; PG8_MMA(1, 1, At, B1); PG8_BAR;
            PG8_LDB(B0, 1, 0); PG8_SCHED; PG8_LDA(At, 1, 0); PG8_STAGE(PG8_SA(0, 1), a2 + hstep, voffA);
            PG8_WAIT_L(8); PG8_BAR; PG8_WAIT_L(0); PG8_MMA(0, 0, At, B0); PG8_BAR; PG8_SCHED;
            PG8_LDB(B1, 1, 1); PG8_STAGE(PG8_SB(1, 0), b3, voffB);
            PG8_BAR; PG8_WAIT_L(0); PG8_MMA(0, 1, At, B1); PG8_BAR;
            PG8_LDA(At, 1, 1); PG8_STAGE(PG8_SA(1, 0), a3, voffA);
            PG8_BAR; PG8_WAIT_L(0); PG8_MMA(1, 0, At, B0); PG8_BAR; PG8_SCHED;
            PG8_STAGE(PG8_SB(1, 1), b3 + hstep, voffB);
            PG8_WAIT_V(6); PG8_BAR; PG8_MMA(1, 1, At, B1); PG8_BAR;
            }
        }
        if constexpr (ALIGN_EPI) { if (wr == 0) PG8_BAR; }
        if constexpr (!Epi::AFTER_DRAIN) { E(acc, cur, wr, wc, fr, fq); S.done(cur); }
        if (!has_next) break;
#pragma unroll
        for (int a = 0; a < 2; ++a)
#pragma unroll
            for (int b = 0; b < 2; ++b)
#pragma unroll
                for (int m = 0; m < 4; ++m)
#pragma unroll
                    for (int n = 0; n < 2; ++n) acc[a][b][m][n] = (f32x4){0.f, 0.f, 0.f, 0.f};
        cur = nxt; cA = nA; cB = nB; ++ui;
        if constexpr (GATHER) { _Pragma("unroll") for (int _i = 0; _i < 2; ++_i) { gC0[_i] = gN0[_i]; gC1[_i] = gN1[_i]; } }
        if constexpr (ALIGN_EPI) { if (wr == 1) PG8_BAR; }
    }
    PG8_WAIT_V(0);
    if constexpr (!ALIGN_EPI) { if (wr == 0) PG8_BAR; }
    PG8_BAR;
    if constexpr (Epi::AFTER_DRAIN) { E.fused(acc, cur, wr, wc, fr, fq, lds, wid, lane); S.done(cur); }
#undef PG8_GROWS
#undef VA0C
#undef VA1C
#undef VA0X
#undef VA1X
#undef AH
#undef PG8_SA
#undef PG8_SB
#undef PG8_STAGE
#undef PG8_LDA
#undef PG8_LDB
#undef PG8_MMA
#undef PG8_WAIT_V
#undef PG8_WAIT_L
#undef PG8_BAR
#undef PG8_SCHED
}
}

constexpr int NWAVES = 8, NTHR = 512;
constexpr int BATCH = 8, T = 2048, D = 2048, M = BATCH * T, NL = 2;
constexpr int DIN = 9236, ZW = 9216, NZP = 9216;
constexpr int HD = 128, NH = 4;
constexpr int KO = 2048;
constexpr int NE = 32, DE = 512;
constexpr int SLOTS = 2 * M + NE * 256;
constexpr float EPS = 1e-6f;
constexpr float LOG2E = 1.4426950408889634f;
constexpr float SCALE = 0.088388347648318440f;
constexpr int Z_MQ = 0, Z_MK = 512, Z_MV = 1024, Z_MO = 1536, Z_BQ = 2048, Z_BK = 2560, Z_BV = 3072, Z_RQ = 3584, Z_RK = 4096, Z_RV = 4608, Z_RG = 5120,
              Z_NQ = 5632, Z_NKC = 6144, Z_NVC = 6656, Z_NKS = 7168, Z_NVS = 7680, Z_NKW = 8192, Z_NVW = 8704;
constexpr size_t MiB = 1u << 20;
constexpr size_t WS_CTL = 0, CTL_ZERO_BYTES = 1 * MiB;
constexpr size_t WS_MOD = 1 * MiB;
constexpr size_t WS_GT = 2 * MiB;
constexpr size_t WS_FQ = 4 * MiB;
constexpr size_t WS_GK = 4 * MiB + 512 * 1024;
constexpr size_t WS_EK = 4 * MiB + 768 * 1024;
constexpr size_t WS_KPART = 5 * MiB;
constexpr size_t WS_KCMP = 6 * MiB;
constexpr size_t WS_VCMP = 7 * MiB;
constexpr size_t WS_CB1 = 8 * MiB;
constexpr size_t WS_TOKE = 8 * MiB + 64 * 1024;
constexpr size_t WS_TOKP = WS_TOKE + 128 * 1024;
constexpr size_t WS_TOKG = WS_TOKP + 128 * 1024;
constexpr size_t WS_TOKS = WS_TOKG + 128 * 1024;
constexpr size_t WS_RTT = 9 * MiB;
constexpr size_t WS_GWF = 9 * MiB + 512 * 1024;
constexpr size_t WS_CW1T = 10 * MiB;
constexpr size_t WS_CW2T = 14 * MiB;
constexpr size_t WS_WINT = 16 * MiB;
constexpr size_t WS_WOUTT = 90 * MiB;
constexpr size_t WS_W13T = 110 * MiB;
constexpr size_t WS_W2T = 366 * MiB;
constexpr size_t WS_HB = 500 * MiB;
constexpr size_t WS_Z = 564 * MiB;
constexpr size_t WS_QKM = 852 * MiB;
constexpr size_t WS_YCAT = 884 * MiB;
constexpr size_t WS_XS = 564 * MiB;
constexpr size_t WS_HBUF = 724 * MiB;
constexpr size_t WS_Y = 764 * MiB;
constexpr size_t WS_TOKL = 964 * MiB;
constexpr size_t WS_X1 = 966 * MiB;
constexpr size_t WS_US = 1030 * MiB;
constexpr size_t WS_NS = 1058 * MiB;
constexpr size_t WS_END = 1060 * MiB;
constexpr int CW_BAR = 4096;
constexpr int CW_QUEUE = 8192;
constexpr int CW_CNT = 8192 + 4096;
constexpr int CW_RDY = 32768;
constexpr int RING_OFF = 0, RING_BYTES = 131072;
constexpr int LDSCTL_OFF = RING_BYTES, MISC_OFF = LDSCTL_OFF + 320;
constexpr int LDS_BYTES = 147456;

#define GAS __attribute__((address_space(1)))
#define LAS __attribute__((address_space(3)))
typedef unsigned short bf16;
typedef unsigned v4u __attribute__((ext_vector_type(4)));
typedef unsigned v2u __attribute__((ext_vector_type(2)));
typedef float f32x4 __attribute__((ext_vector_type(4)));
typedef float f32x16 __attribute__((ext_vector_type(16)));
typedef short bf16x8 __attribute__((ext_vector_type(8)));
typedef short s16x4 __attribute__((ext_vector_type(4)));
typedef GAS unsigned gu32;
#define RLX_AGENT __ATOMIC_RELAXED, __HIP_MEMORY_SCOPE_AGENT
#define LDS_WAIT() asm volatile("s_waitcnt lgkmcnt(0)" ::: "memory")
#define VM_WAIT() asm volatile("s_waitcnt vmcnt(0)" ::: "memory")
__device__ __forceinline__ unsigned f2bf(float f) { unsigned u = __builtin_bit_cast(unsigned, f); return (u + 0x7fffu + ((u >> 16) & 1u)) >> 16; }
__device__ __forceinline__ unsigned pk2(float lo, float hi) { return f2bf(lo) | (f2bf(hi) << 16); }
__device__ __forceinline__ float bflo(unsigned w) { return __uint_as_float(w << 16); }
__device__ __forceinline__ float bfhi(unsigned w) { return __uint_as_float(w & 0xffff0000u); }
__device__ __forceinline__ float bf2f(bf16 b) { return __uint_as_float(((unsigned)b) << 16); }
__device__ __forceinline__ float wave_sum(float v) {
#pragma unroll
    for (int o = 1; o < 64; o <<= 1) v += __shfl_xor(v, o);
    return v;
}
__device__ __forceinline__ float sigmoid_f(float v) { return __builtin_amdgcn_rcpf(1.0f + __expf(-v)); }
__device__ __forceinline__ float silu2_f(float v) { return v * sigmoid_f(v); }

#ifndef PH_MASK2
#define PH_MASK2 0xFFFFu
#endif
#define EN2(j) ((PH_MASK2 >> (j)) & 1u)
#ifndef DUP_MASK
#define DUP_MASK 0u
#endif
#define XB_TMO      128
#define XB_XCNT(j)  (256  + 64 * (j))
#define XB_XSUB(j)  (1280 + 64 * (j))
#define XB_XGEN(j)  (2304 + 64 * (j))
#define XB_TOP      3328
#define XB_TOPGEN   3392
#define XCD_BAR_WORDS 3456
#define XB_SPIN_CAP (1u << 18)

__device__ __forceinline__ unsigned xb_ld(unsigned* p)              { return __hip_atomic_load(p, __ATOMIC_RELAXED, __HIP_MEMORY_SCOPE_AGENT); }
__device__ __forceinline__ unsigned xb_add(unsigned* p, unsigned v) { return __hip_atomic_fetch_add(p, v, __ATOMIC_RELAXED, __HIP_MEMORY_SCOPE_AGENT); }
__device__ __forceinline__ unsigned xb_xcc_id() { return (unsigned)__builtin_amdgcn_s_getreg((3 << 11) | 20) & 0xFu; }
#define XB_SPIN(cond, bar) do { unsigned _sp = 0; while (cond) { __builtin_amdgcn_s_sleep(1); \
    if ((++_sp & 255u) == 0u) { if (xb_ld(&(bar)[XB_TMO])) break; if (_sp > XB_SPIN_CAP) { atomicAdd(&(bar)[XB_TMO], 1u); break; } } } } while (0)

struct XcdBarrier {
    unsigned* bar; unsigned x;
    volatile LAS unsigned* st;
};

__device__ __forceinline__ XcdBarrier xcd_barrier_post(unsigned* bar, volatile LAS unsigned* st) {
    XcdBarrier b; b.bar = bar; b.x = xb_xcc_id(); b.st = st;
    if (threadIdx.x == 0) (void)xb_add(&bar[XB_XCNT(b.x)], 1u);
    return b;
}
__device__ __forceinline__ void xcd_barrier_complete(unsigned* bar, unsigned x, unsigned& nloc, unsigned& nx) {
    const unsigned G = gridDim.x * gridDim.y * gridDim.z;
    unsigned sum, cnt, mine, sp = 0u;
    for (;;) {
        sum = 0u; cnt = 0u; mine = 0u;
#pragma unroll
        for (unsigned j = 0; j < 16; ++j) { const unsigned c = xb_ld(&bar[XB_XCNT(j)]); sum += c; cnt += (c > 0u) ? 1u : 0u; mine = (j == x) ? c : mine; }
        if (sum == G) break;
        __builtin_amdgcn_s_sleep(1);
        if ((++sp & 255u) == 0u) { if (xb_ld(&bar[XB_TMO])) break; if (sp > XB_SPIN_CAP) { atomicAdd(&bar[XB_TMO], 1u); break; } }
    }
    nloc = mine > 0u ? mine : 1u; nx = cnt > 0u ? cnt : 1u;
}

__device__ __forceinline__ void xcd_barrier(const XcdBarrier& b) {
    asm volatile("s_waitcnt vmcnt(0)" ::: "memory");
    __syncthreads();
    if (threadIdx.x == 0) {
        unsigned* bar = b.bar;
        __builtin_amdgcn_s_waitcnt(0);
        unsigned nloc = b.st[0], nx = b.st[1];
        if (nloc == 0u) { xcd_barrier_complete(bar, b.x, nloc, nx); b.st[0] = nloc; b.st[1] = nx; }
        const unsigned old = xb_add(&bar[XB_XSUB(b.x)], 1u);
        const unsigned gen = old / nloc;
        if (old + 1u == (gen + 1u) * nloc) {
            __builtin_amdgcn_fence(__ATOMIC_RELEASE, "agent");
            asm volatile("s_waitcnt vmcnt(0)" ::: "memory");
            const unsigned og = xb_add(&bar[XB_TOP], 1u);
            const unsigned tg = og / nx;
            if (og + 1u == (tg + 1u) * nx) xb_add(&bar[XB_TOPGEN], 1u);
            else XB_SPIN(xb_ld(&bar[XB_TOPGEN]) == tg, bar);
            __builtin_amdgcn_fence(__ATOMIC_ACQUIRE, "agent");
            xb_add(&bar[XB_XGEN(b.x)], 1u);
            asm volatile("s_waitcnt vmcnt(0)" ::: "memory");
        } else {
            XB_SPIN(xb_ld(&bar[XB_XGEN(b.x)]) == gen, bar);
            __builtin_amdgcn_fence(__ATOMIC_ACQUIRE, "agent");
            asm volatile("s_waitcnt vmcnt(0)" ::: "memory");
        }
    }
    __syncthreads();
}
namespace att {
constexpr int SHM_V = 64 * 128 * 2, SHM_K = 64 * 128 * 2;
constexpr int OFF_K = 3 * 16384;
constexpr int OFF_WS = 81920;
constexpr int OFF_GT = OFF_WS + 4096;
constexpr int OFF_KM = OFF_GT + 1024;
constexpr int OFF_UN = OFF_KM + 4096;
constexpr int OFF_HID = OFF_UN + 256;
constexpr float THR2 = 11.5f;
#define KSWZ(row, colB) ((row) * 256 + ((colB) ^ (((row) & 7) << 4)))
#define SBAR() __builtin_amdgcn_sched_barrier(0)
__device__ __forceinline__ constexpr int crc(int r) { return (r & 3) + 8 * (r >> 2); }
__device__ __forceinline__ int crow(int r, int hi) { return (r & 3) + 8 * (r >> 2) + 4 * hi; }
__device__ __forceinline__ unsigned cvtpk(float lo, float hi) { unsigned r; asm volatile("v_cvt_pk_bf16_f32 %0, %1, %2" : "=v"(r) : "v"(lo), "v"(hi)); return r; }
__device__ __forceinline__ float swap_max(float v) { auto rr = __builtin_amdgcn_permlane32_swap(__float_as_uint(v), __float_as_uint(v), false, false); return fmaxf(__uint_as_float(rr[0]), __uint_as_float(rr[1])); }
__device__ __forceinline__ float swap_sum(float v) { auto rr = __builtin_amdgcn_permlane32_swap(__float_as_uint(v), __float_as_uint(v), false, false); return __uint_as_float(rr[0]) + __uint_as_float(rr[1]); }

struct KAddr { int a[4]; };
__device__ __forceinline__ KAddr k_addr(int r32, int hi) { KAddr k; const int sw = (r32 & 7) << 4;
#pragma unroll
    for (int q = 0; q < 4; ++q) k.a[q] = r32 * 256 + ((q * 32 + hi * 16) ^ sw);
    return k; }
__device__ __forceinline__ void qkt(f32x16& p0, f32x16& p1, const LAS char* Ks, const bf16x8 (&qr)[8], const KAddr& ka) {
    p0 = f32x16{}; p1 = f32x16{};
#pragma unroll
    for (int d0 = 0; d0 < 8; ++d0) {
        const bf16x8 b0 = *(const LAS bf16x8*)(Ks + ka.a[d0 & 3] + (d0 >> 2) * 128);
        const bf16x8 b1 = *(const LAS bf16x8*)(Ks + ka.a[d0 & 3] + (d0 >> 2) * 128 + 8192);
        p0 = __builtin_amdgcn_mfma_f32_32x32x16_bf16(b0, qr[d0], p0, 0, 0, 0);
        p1 = __builtin_amdgcn_mfma_f32_32x32x16_bf16(b1, qr[d0], p1, 0, 0, 0); }
}
__device__ __forceinline__ int v_st(int k, int c) { const int kk = (k & ~0xC) | ((k & 4) << 1) | ((k & 8) >> 1); return ((kk >> 3) * 4 + (c >> 5)) * 512 + ((kk & 7) * 32 + (c & 31)) * 2; }
__device__ __forceinline__ int v_rd_base(int lane) { return ((lane & 3) << 3) | (((lane >> 2) & 3) << 6) | (((lane >> 4) & 1) << 5) | (((lane >> 5) & 1) << 8); }
constexpr int v_rd_off(int d0, int ks, int half) { return d0 * 512 + ks * 4096 + half * 2048; }
template <int OFF> __device__ __forceinline__ s16x4 tr_read(int vb) { s16x4 r; asm volatile("ds_read_b64_tr_b16 %0, %1 offset:%2" : "=&v"(r) : "v"(vb), "i"(OFF) : "memory"); return r; }
template <int D0> __device__ __forceinline__ void pv_one(f32x16& od, int vb, bf16x8 pa0, bf16x8 pa1, bf16x8 pa2, bf16x8 pa3) {
    const s16x4 l0 = tr_read<v_rd_off(D0, 0, 0)>(vb), h0 = tr_read<v_rd_off(D0, 0, 1)>(vb), l1 = tr_read<v_rd_off(D0, 1, 0)>(vb), h1 = tr_read<v_rd_off(D0, 1, 1)>(vb);
    const s16x4 l2 = tr_read<v_rd_off(D0, 2, 0)>(vb), h2 = tr_read<v_rd_off(D0, 2, 1)>(vb), l3 = tr_read<v_rd_off(D0, 3, 0)>(vb), h3 = tr_read<v_rd_off(D0, 3, 1)>(vb);
    asm volatile("s_waitcnt lgkmcnt(0)" ::: "memory"); SBAR();
#define PKV(L, H) (bf16x8){L[0], L[1], L[2], L[3], H[0], H[1], H[2], H[3]}
    od = __builtin_amdgcn_mfma_f32_32x32x16_bf16(pa0, PKV(l0, h0), od, 0, 0, 0);
    od = __builtin_amdgcn_mfma_f32_32x32x16_bf16(pa1, PKV(l1, h1), od, 0, 0, 0);
    od = __builtin_amdgcn_mfma_f32_32x32x16_bf16(pa2, PKV(l2, h2), od, 0, 0, 0);
    od = __builtin_amdgcn_mfma_f32_32x32x16_bf16(pa3, PKV(l3, h3), od, 0, 0, 0);
#undef PKV
}
#define PV_RD(D0, L0, H0, L1, H1, L2, H2, L3, H3) do { L0 = tr_read<v_rd_off(D0, 0, 0)>(vb); H0 = tr_read<v_rd_off(D0, 0, 1)>(vb); L1 = tr_read<v_rd_off(D0, 1, 0)>(vb); H1 = tr_read<v_rd_off(D0, 1, 1)>(vb); \
        L2 = tr_read<v_rd_off(D0, 2, 0)>(vb); H2 = tr_read<v_rd_off(D0, 2, 1)>(vb); L3 = tr_read<v_rd_off(D0, 3, 0)>(vb); H3 = tr_read<v_rd_off(D0, 3, 1)>(vb); } while (0)
#define PV_MM(OD, L0, H0, L1, H1, L2, H2, L3, H3) do { \
        OD = __builtin_amdgcn_mfma_f32_32x32x16_bf16(pa0, ((bf16x8){L0[0], L0[1], L0[2], L0[3], H0[0], H0[1], H0[2], H0[3]}), OD, 0, 0, 0); \
        OD = __builtin_amdgcn_mfma_f32_32x32x16_bf16(pa1, ((bf16x8){L1[0], L1[1], L1[2], L1[3], H1[0], H1[1], H1[2], H1[3]}), OD, 0, 0, 0); \
        OD = __builtin_amdgcn_mfma_f32_32x32x16_bf16(pa2, ((bf16x8){L2[0], L2[1], L2[2], L2[3], H2[0], H2[1], H2[2], H2[3]}), OD, 0, 0, 0); \
        OD = __builtin_amdgcn_mfma_f32_32x32x16_bf16(pa3, ((bf16x8){L3[0], L3[1], L3[2], L3[3], H3[0], H3[1], H3[2], H3[3]}), OD, 0, 0, 0); } while (0)
__device__ __forceinline__ void pv_d0(f32x16 (&o)[4], int vb, bf16x8 pa0, bf16x8 pa1, bf16x8 pa2, bf16x8 pa3) {
    s16x4 a0, a1, a2, a3, a4, a5, a6, a7, b0, b1, b2, b3, b4, b5, b6, b7;
    PV_RD(0, a0, a1, a2, a3, a4, a5, a6, a7);
    PV_RD(1, b0, b1, b2, b3, b4, b5, b6, b7);
    asm volatile("s_waitcnt lgkmcnt(8)" ::: "memory"); SBAR();
    PV_MM(o[0], a0, a1, a2, a3, a4, a5, a6, a7);
    SBAR(); PV_RD(2, a0, a1, a2, a3, a4, a5, a6, a7);
    asm volatile("s_waitcnt lgkmcnt(8)" ::: "memory"); SBAR();
    PV_MM(o[1], b0, b1, b2, b3, b4, b5, b6, b7);
    SBAR(); PV_RD(3, b0, b1, b2, b3, b4, b5, b6, b7);
    asm volatile("s_waitcnt lgkmcnt(8)" ::: "memory"); SBAR();
    PV_MM(o[2], a0, a1, a2, a3, a4, a5, a6, a7);
    asm volatile("s_waitcnt lgkmcnt(0)" ::: "memory"); SBAR();
    PV_MM(o[3], b0, b1, b2, b3, b4, b5, b6, b7);
}
#undef PV_RD
#undef PV_MM
__device__ __forceinline__ void pack_p(const f32x16& p0, const f32x16& p1, bf16x8& pa0, bf16x8& pa1, bf16x8& pa2, bf16x8& pa3) {
#define PK4(P, BASE, OUT) do { unsigned a0 = cvtpk(P[BASE + 0], P[BASE + 1]), a1 = cvtpk(P[BASE + 2], P[BASE + 3]);   \
    unsigned b0 = cvtpk(P[BASE + 4], P[BASE + 5]), b1 = cvtpk(P[BASE + 6], P[BASE + 7]);                              \
    auto r0 = __builtin_amdgcn_permlane32_swap(a0, b0, false, false); auto r1 = __builtin_amdgcn_permlane32_swap(a1, b1, false, false); \
    v4u w = {r0[0], r1[0], r0[1], r1[1]}; OUT = __builtin_bit_cast(bf16x8, w); } while (0)
    PK4(p0, 0, pa0); PK4(p0, 8, pa1); PK4(p1, 0, pa2); PK4(p1, 8, pa3);
#undef PK4
}
__device__ __forceinline__ void rescale_o(f32x16 (&o)[4], float a, LAS float* al_l, int r32, int hi) {
    if (hi == 0) al_l[r32] = a;
    asm volatile("s_waitcnt lgkmcnt(0)" ::: "memory");
#pragma unroll
    for (int r = 0; r < 16; ++r) { const float f = al_l[crow(r, hi)];
#pragma unroll
        for (int d = 0; d < 4; ++d) o[d][r] *= f; }
}
__device__ __forceinline__ void row_bcast(float v, float (&out)[16], LAS float* sl, int r32, int hi) {
    asm volatile("s_waitcnt lgkmcnt(0)" ::: "memory");
    if (hi == 0) sl[r32] = v;
    asm volatile("s_waitcnt lgkmcnt(0)" ::: "memory");
#pragma unroll
    for (int r = 0; r < 16; ++r) out[r] = sl[crow(r, hi)];
    asm volatile("s_waitcnt lgkmcnt(0)" ::: "memory");
}

enum { MD_MLSTM = 0, MD_MOBA = 1, MD_RET = 2, MD_SEL = 3, MD_WIN = 4 };
struct LaneCtx { int tq; float a; float slope2; unsigned qmask; };

__device__ __forceinline__ unsigned cvtpk_s(float lo, float hi) { typedef float f32x2_t __attribute__((ext_vector_type(2))); typedef __bf16 bf16x2_t __attribute__((ext_vector_type(2)));
    f32x2_t v = {lo, hi}; bf16x2_t b = __builtin_convertvector(v, bf16x2_t); return __builtin_bit_cast(unsigned, b); }
__device__ __forceinline__ void pack_p_s(const f32x16& p0, const f32x16& p1, bf16x8& pa0, bf16x8& pa1, bf16x8& pa2, bf16x8& pa3) {
#define PK4(P, BASE, OUT) do { unsigned a0 = cvtpk_s(P[BASE + 0], P[BASE + 1]), a1 = cvtpk_s(P[BASE + 2], P[BASE + 3]);   \
    unsigned b0 = cvtpk_s(P[BASE + 4], P[BASE + 5]), b1 = cvtpk_s(P[BASE + 6], P[BASE + 7]);                              \
    auto r0 = __builtin_amdgcn_permlane32_swap(a0, b0, false, false); auto r1 = __builtin_amdgcn_permlane32_swap(a1, b1, false, false); \
    v4u w = {r0[0], r1[0], r0[1], r1[1]}; OUT = __builtin_bit_cast(bf16x8, w); } while (0)
    PK4(p0, 0, pa0); PK4(p0, 8, pa1); PK4(p1, 0, pa2); PK4(p1, 8, pa3);
#undef PK4
}
#define QK_ISSUE(C0, C1) do { C0 = f32x16{}; C1 = f32x16{}; _Pragma("unroll") for (int d0 = 0; d0 < 8; ++d0) { \
        const bf16x8 b0_ = *(const LAS bf16x8*)(Kbuf + ka.a[d0 & 3] + (d0 >> 2) * 128); const bf16x8 b1_ = *(const LAS bf16x8*)(Kbuf + ka.a[d0 & 3] + (d0 >> 2) * 128 + 8192); \
        C0 = __builtin_amdgcn_mfma_f32_32x32x16_bf16(b0_, qr[d0], C0, 0, 0, 0); C1 = __builtin_amdgcn_mfma_f32_32x32x16_bf16(b1_, qr[d0], C1, 0, 0, 0); } } while (0)
#define MIX_SCHED(NV) do { _Pragma("unroll") for (int g_ = 0; g_ < 16; ++g_) { __builtin_amdgcn_sched_group_barrier(0x100, 1, 0); __builtin_amdgcn_sched_group_barrier(0x002, NV, 0); __builtin_amdgcn_sched_group_barrier(0x008, 1, 0); } } while (0)
template <int MODE>
__device__ __forceinline__ void tile_step(f32x16& c0, f32x16& c1, const LAS char* Kbuf, const bf16x8 (&qr)[8], const KAddr& ka,
                                          f32x16& p0, f32x16& p1, int vb0, LAS float* al_l, const LAS float* gtab, int j, int vbuf, int qb, int q0w, int r32, int hi,
                                          f32x16 (&o)[4], float& m_reg, float& l_reg, const LaneCtx& lc) {
    constexpr float C1 = SCALE * LOG2E;
    float sl2 = lc.slope2; asm volatile("" : "+v"(sl2));
    const int k0 = j * 64;
    const int base = lc.tq - k0 - 4 * hi;
    const float bias0 = -sl2 * (float)base;
    bf16x8 pa0, pa1, pa2, pa3;
    if (MODE == MD_MOBA || MODE == MD_SEL || MODE == MD_WIN) {
        bool lane_ok = true, chk_c = false, chk_w = false;
        if (MODE == MD_MOBA) { const int blk = j >> 2; if (blk == qb) chk_c = (k0 + 63 > q0w); else lane_ok = (lc.qmask >> blk) & 1u; }
        if (MODE == MD_SEL) { lane_ok = (lc.qmask >> j) & 1u; chk_c = (k0 + 63 > q0w); }
        if (MODE == MD_WIN) { chk_c = (k0 + 63 > q0w); chk_w = (q0w + 31 - k0 >= 512); }
        const float biasl = lane_ok ? bias0 : -1e30f;
        if (!(chk_c || chk_w)) {
#pragma unroll
            for (int r = 0; r < 16; ++r) { p0[r] = fmaf(p0[r], C1, fmaf(sl2, (float)crc(r), biasl)); p1[r] = fmaf(p1[r], C1, fmaf(sl2, (float)(crc(r) + 32), biasl)); }
        } else {
#pragma unroll
            for (int r = 0; r < 16; ++r) {
                const int cc0 = crc(r), cc1 = crc(r) + 32;
                const float s0 = fmaf(p0[r], C1, fmaf(sl2, (float)cc0, biasl)), s1 = fmaf(p1[r], C1, fmaf(sl2, (float)cc1, biasl));
                bool v0 = true, v1 = true;
                if (chk_c) { v0 = (cc0 <= base); v1 = (cc1 <= base); }
                if (chk_w) { v0 = v0 && (base - cc0 < 512); v1 = v1 && (base - cc1 < 512); }
                p0[r] = v0 ? s0 : -1e30f; p1[r] = v1 ? s1 : -1e30f;
            }
        }
        float pmax = p0[0];
#pragma unroll
        for (int r = 1; r < 16; ++r) pmax = fmaxf(pmax, p0[r]);
#pragma unroll
        for (int r = 0; r < 16; ++r) pmax = fmaxf(pmax, p1[r]);
        pmax = swap_max(pmax);
        float mn, alpha;
        if (__all(pmax - m_reg <= THR2)) { mn = m_reg; alpha = 1.f; }
        else { mn = fmaxf(m_reg, pmax); alpha = __builtin_amdgcn_exp2f(m_reg - mn); m_reg = mn; rescale_o(o, alpha, al_l, r32, hi); }
        __builtin_amdgcn_sched_barrier(0);
        QK_ISSUE(c0, c1);
        float ps = 0.f;
#pragma unroll
        for (int r = 0; r < 16; ++r) { p0[r] = __builtin_amdgcn_exp2f(p0[r] - mn); p1[r] = __builtin_amdgcn_exp2f(p1[r] - mn); ps += p0[r] + p1[r]; }
        l_reg = l_reg * alpha + ps;
        pack_p_s(p0, p1, pa0, pa1, pa2, pa3);
        MIX_SCHED(8);
        __builtin_amdgcn_sched_barrier(0);
    } else {
        const bool chk_c = (k0 + 63 > q0w);
        if (MODE == MD_MLSTM) {
            const LAS float* gt = gtab + vbuf * 80 + 4 * hi;
            const float B = __builtin_amdgcn_exp2f(lc.a + (-3.5f) + gtab[vbuf * 80 + 64]);
            f32x4 g0[4], g1[4];
#pragma unroll
            for (int a = 0; a < 4; ++a) { g0[a] = *(const LAS f32x4*)(gt + 8 * a); g1[a] = *(const LAS f32x4*)(gt + 32 + 8 * a); }
            asm volatile("s_waitcnt lgkmcnt(0)" ::: "memory");
            __builtin_amdgcn_sched_barrier(0);
            QK_ISSUE(c0, c1);
            float ps = 0.f;
#pragma unroll
            for (int a = 0; a < 4; ++a)
#pragma unroll
                for (int i = 0; i < 4; ++i) { const int r = 4 * a + i; const int cc0 = crc(r), cc1 = crc(r) + 32;
                    float w0 = B * g0[a][i], w1 = B * g1[a][i];
                    if (chk_c) { w0 = (cc0 <= base) ? w0 : 0.f; w1 = (cc1 <= base) ? w1 : 0.f; }
                    p0[r] *= w0; p1[r] *= w1; ps += p0[r] + p1[r]; }
            l_reg += ps;
            pack_p_s(p0, p1, pa0, pa1, pa2, pa3);
            MIX_SCHED(8);
            __builtin_amdgcn_sched_barrier(0);
        } else {
            __builtin_amdgcn_sched_barrier(0);
            QK_ISSUE(c0, c1);
            const float B = __builtin_amdgcn_exp2f(bias0 + (-3.5f)), e32 = __builtin_amdgcn_exp2f(sl2 * 32.0f);
            float e1[4], b8[4];
#pragma unroll
            for (int q = 0; q < 4; ++q) { e1[q] = __builtin_amdgcn_exp2f(sl2 * (float)q); b8[q] = B * __builtin_amdgcn_exp2f(sl2 * (float)(8 * q)); }
#pragma unroll
            for (int r = 0; r < 16; ++r) { const int cc0 = crc(r), cc1 = crc(r) + 32;
                float w0 = b8[r >> 2] * e1[r & 3], w1 = w0 * e32;
                if (chk_c) { w0 = (cc0 <= base) ? w0 : 0.f; w1 = (cc1 <= base) ? w1 : 0.f; }
                p0[r] *= w0; p1[r] *= w1; }
            pack_p_s(p0, p1, pa0, pa1, pa2, pa3);
            MIX_SCHED(6);
            __builtin_amdgcn_sched_barrier(0);
        }
    }
    pv_d0(o, vb0 + vbuf * SHM_V, pa0, pa1, pa2, pa3);
}
template <int MODE>
__device__ __forceinline__ void attn_pass(LAS char* lds, const bf16* __restrict__ Kh, int ldk, const bf16* __restrict__ Vh, int ldv, const float* __restrict__ Gk, const float* __restrict__ Ek,
                                          unsigned tmask, unsigned wmask, int qb, const bf16x8 (&qr)[8], f32x16 (&o)[4], float& m_reg, float& l_reg, const LaneCtx& lc) {
    int tid_ = threadIdx.x; asm volatile("" : "+v"(tid_));
    const int tid = tid_, wid = __builtin_amdgcn_readfirstlane(tid >> 6), lane = tid & 63, r32 = lane & 31, hi = lane >> 5;
    LAS char* V_lds = lds; LAS char* K_lds = lds + OFF_K;
    LAS float* al_l = (LAS float*)(lds + OFF_WS) + wid * 128;
    LAS float* gtab = (LAS float*)(lds + OFF_GT);
    const int vb0 = (int)(unsigned)(uintptr_t)V_lds + v_rd_base(lane);
    bf16x8 ks0, ks1, vs0, vs1; float gst = 0.f;
#define STG_IDS() int t2_ = tid; asm volatile("" : "+v"(t2_)); const int sr = t2_ >> 4, sc = (t2_ & 15) * 8
#define SLOAD(k0) do { STG_IDS(); ks0 = *(const bf16x8*)(Kh + (size_t)((k0) + sr) * ldk + sc); ks1 = *(const bf16x8*)(Kh + (size_t)((k0) + 32 + sr) * ldk + sc); \
        vs0 = *(const bf16x8*)(Vh + (size_t)((k0) + sr) * ldv + sc); vs1 = *(const bf16x8*)(Vh + (size_t)((k0) + 32 + sr) * ldv + sc); \
        if (MODE == MD_MLSTM) { if (t2_ < 65) gst = (t2_ < 64) ? Ek[(k0) + t2_] : Gk[(k0)]; } } while (0)
#define SWRITE(kb, vb) do { STG_IDS(); const int vst0 = v_st(sr, sc), vst1 = v_st(32 + sr, sc), kc = sc * 2; \
        *(LAS bf16x8*)(V_lds + (vb) * SHM_V + vst0) = vs0; *(LAS bf16x8*)(V_lds + (vb) * SHM_V + vst1) = vs1; \
        *(LAS bf16x8*)(K_lds + (kb) * SHM_K + KSWZ(sr, kc)) = ks0; *(LAS bf16x8*)(K_lds + (kb) * SHM_K + KSWZ(32 + sr, kc)) = ks1; \
        if (MODE == MD_MLSTM) { if (t2_ < 65) gtab[(vb) * 80 + t2_] = gst; } } while (0)
#define WG_BAR() do { asm volatile("s_waitcnt lgkmcnt(0)" ::: "memory"); __builtin_amdgcn_s_barrier(); asm volatile("" ::: "memory"); } while (0)
    if (tmask == 0u) return;
    (void)wmask;
    const int q0w = qb * 256 + wid * 32;
    unsigned rem = tmask; int jc = __builtin_ctz(rem); rem &= rem - 1u;
    const int jsafe = jc;
    SLOAD(jc * 64);
    int kb = 0, vb = 0, jp = 0, vp = 0;
    f32x16 pA0, pA1, pB0, pB1; const KAddr ka = k_addr(r32, hi);
    { SWRITE(kb, vb); WG_BAR();
      int jn = -1; if (rem) { jn = __builtin_ctz(rem); rem &= rem - 1u; }
      SLOAD((jn < 0 ? jsafe : jn) * 64);
      qkt(pA0, pA1, K_lds + kb * SHM_K, qr, ka);
      jp = jc; vp = vb; jc = jn; kb ^= 1; vb = 1; }
#define STEP(PC0, PC1, PP0, PP1) do { \
        SWRITE(kb, vb); WG_BAR(); \
        int jn = -1; if (rem) { jn = __builtin_ctz(rem); rem &= rem - 1u; } \
        SLOAD((jn < 0 ? jsafe : jn) * 64); \
        tile_step<MODE>(PC0, PC1, K_lds + kb * SHM_K, qr, ka, PP0, PP1, vb0, al_l, gtab, jp, vp, qb, q0w, r32, hi, o, m_reg, l_reg, lc); \
        last = (jc < 0); jp = jc; vp = vb; jc = jn; kb ^= 1; vb = (vb == 2) ? 0 : vb + 1; } while (0)
    for (;;) { bool last;
        STEP(pB0, pB1, pA0, pA1); if (last) break;
        STEP(pA0, pA1, pB0, pB1); if (last) break;
    }
    __syncthreads();
#undef STEP
#undef STG_IDS
#undef SLOAD
#undef SWRITE
#undef WG_BAR
}
template <bool ACCUM = false>
__device__ __forceinline__ void store_o(const f32x16 (&o)[4], const float (&fr)[16], bf16* Yp, int ldy, int r32, int hi) {
    bf16* Yl = Yp + (size_t)(4 * hi) * ldy + r32;
    float pv[16][4];
#pragma unroll
    for (int rg = 0; rg < 4; ++rg) { bf16* base = Yl; asm volatile("" : "+v"(base));
#pragma unroll
        for (int i = 0; i < 4; ++i)
#pragma unroll
            for (int d = 0; d < 4; ++d) pv[4 * rg + i][d] = ACCUM ? bf2f(base[(size_t)crc(4 * rg + i) * ldy + d * 32]) : 0.f; }
    if (ACCUM) __builtin_amdgcn_sched_barrier(0);
#pragma unroll
    for (int rg = 0; rg < 4; ++rg) { bf16* base = Yl; asm volatile("" : "+v"(base));
#pragma unroll
        for (int i = 0; i < 4; ++i) { const int r = 4 * rg + i;
#pragma unroll
            for (int d = 0; d < 4; ++d) base[(size_t)crc(r) * ldy + d * 32] = (bf16)f2bf(o[d][r] * fr[r] + pv[r][d]); } }
}
template <int GACT>
__device__ __forceinline__ void store_rms_gate(f32x16 (&o)[4], const float (&fr)[16], const float* __restrict__ gain, const bf16* __restrict__ gate, int ldg, bf16* Yp, int ldy, int r32, int hi) {
    float gn[4];
#pragma unroll
    for (int d = 0; d < 4; ++d) gn[d] = gain[d * 32 + r32];
    const bf16* Gl = gate + (size_t)(4 * hi) * ldg + r32; bf16* Yl = Yp + (size_t)(4 * hi) * ldy + r32;
    float gv[16][4];
#pragma unroll
    for (int rg = 0; rg < 4; ++rg) { const bf16* gp = Gl; asm volatile("" : "+v"(gp));
#pragma unroll
        for (int i = 0; i < 4; ++i)
#pragma unroll
            for (int d = 0; d < 4; ++d) gv[4 * rg + i][d] = bf2f(gp[(size_t)crc(4 * rg + i) * ldg + d * 32]); }
    __builtin_amdgcn_sched_barrier(0);
#pragma unroll
    for (int rg = 0; rg < 4; ++rg) { bf16* yp = Yl; asm volatile("" : "+v"(yp));
#pragma unroll
        for (int i = 0; i < 4; ++i) { const int r = 4 * rg + i;
            float ss = 0.f;
#pragma unroll
            for (int d = 0; d < 4; ++d) { o[d][r] *= fr[r]; ss += o[d][r] * o[d][r]; }
#pragma unroll
            for (int x = 1; x < 32; x <<= 1) ss += __shfl_xor(ss, x);
            const float rn = __builtin_amdgcn_rsqf(ss * (1.0f / 128.0f) + EPS);
#pragma unroll
            for (int d = 0; d < 4; ++d) { const float ga = GACT == 0 ? sigmoid_f(gv[r][d]) : silu2_f(gv[r][d]);
                yp[(size_t)crc(r) * ldy + d * 32] = (bf16)f2bf(o[d][r] * rn * gn[d] * ga); } } }
}
template <int KIND>
__device__ __forceinline__ void epi_store(const f32x16 (&o)[4], float srow, const float* gain, const bf16* gate, int ldg, bf16* Yp, int ldy, LAS float* stg, int lane_) {
    int lane = lane_; asm volatile("" : "+v"(lane));
    const int r32 = lane & 31, hi = lane >> 5, rowT = lane >> 3, ch = lane & 7;
    float one = 1.0f; asm volatile("" : "+v"(one));
    asm volatile("s_waitcnt lgkmcnt(0)" ::: "memory"); __builtin_amdgcn_sched_barrier(0);
#pragma unroll
    for (int rnd = 0; rnd < 4; ++rnd) {
#pragma unroll
        for (int rr = 0; rr < 4; ++rr) { const int r = 4 * rnd + rr; const int rl = rr + 4 * hi;
#pragma unroll
            for (int dd = 0; dd < 4; ++dd) stg[rl * 132 + dd * 32 + r32] = o[dd][r] * one; }
        asm volatile("s_waitcnt lgkmcnt(0)" ::: "memory");
        const int row = 8 * rnd + rowT;
        const float s = __builtin_bit_cast(float, __builtin_amdgcn_ds_bpermute(row << 2, __builtin_bit_cast(int, srow)));
        v4u gq[2];
        if (KIND >= 2) { gq[0] = *(const v4u*)(gate + (size_t)row * ldg + ch * 16); gq[1] = *(const v4u*)(gate + (size_t)row * ldg + ch * 16 + 8); }
        if (KIND == 1) { gq[0] = *(const v4u*)(Yp + (size_t)row * ldy + ch * 16); gq[1] = *(const v4u*)(Yp + (size_t)row * ldy + ch * 16 + 8); }
        f32x4 v[4];
#pragma unroll
        for (int k = 0; k < 4; ++k) v[k] = *(const LAS f32x4*)(stg + rowT * 132 + ch * 16 + 4 * k) * s;
        asm volatile("s_waitcnt lgkmcnt(0)" ::: "memory");
        if (KIND >= 2) {
            float ss = 0.f;
#pragma unroll
            for (int k = 0; k < 4; ++k) ss += (v[k].x * v[k].x + v[k].y * v[k].y) + (v[k].z * v[k].z + v[k].w * v[k].w);
            ss += __shfl_xor(ss, 1); ss += __shfl_xor(ss, 2); ss += __shfl_xor(ss, 4);
            const float rn = __builtin_amdgcn_rsqf(ss * (1.0f / 128.0f) + EPS);
#pragma unroll
            for (int k = 0; k < 4; ++k) { const f32x4 g = *(const f32x4*)(gain + ch * 16 + 4 * k); const unsigned w0 = (k & 1) ? gq[k >> 1].z : gq[k >> 1].x, w1 = (k & 1) ? gq[k >> 1].w : gq[k >> 1].y;
                const float a0 = bflo(w0), a1 = bfhi(w0), a2 = bflo(w1), a3 = bfhi(w1);
                f32x4 ga; ga.x = KIND == 2 ? sigmoid_f(a0) : silu2_f(a0); ga.y = KIND == 2 ? sigmoid_f(a1) : silu2_f(a1); ga.z = KIND == 2 ? sigmoid_f(a2) : silu2_f(a2); ga.w = KIND == 2 ? sigmoid_f(a3) : silu2_f(a3);
                v[k] = v[k] * rn * g * ga; }
        }
        if (KIND == 1) {
#pragma unroll
            for (int k = 0; k < 4; ++k) { const unsigned w0 = (k & 1) ? gq[k >> 1].z : gq[k >> 1].x, w1 = (k & 1) ? gq[k >> 1].w : gq[k >> 1].y;
                v[k] = v[k] + (f32x4){bflo(w0), bfhi(w0), bflo(w1), bfhi(w1)}; }
        }
#pragma unroll
        for (int k = 0; k < 2; ++k) { v4u w; w.x = pk2(v[2 * k].x, v[2 * k].y); w.y = pk2(v[2 * k].z, v[2 * k].w); w.z = pk2(v[2 * k + 1].x, v[2 * k + 1].y); w.w = pk2(v[2 * k + 1].z, v[2 * k + 1].w);
            *(v4u*)(Yp + (size_t)row * ldy + ch * 16 + 8 * k) = w; }
        __builtin_amdgcn_sched_barrier(0);
    }
    __syncthreads();
}
__device__ __forceinline__ void load_q(bf16x8 (&qr)[8], const bf16* Qw) {
#pragma unroll
    for (int d0 = 0; d0 < 8; ++d0) qr[d0] = *(const bf16x8*)(Qw + d0 * 16);
}
__device__ __forceinline__ unsigned wave_or(unsigned m) {
#pragma unroll
    for (int x = 1; x < 64; x <<= 1) m |= (unsigned)__shfl_xor((int)m, x);
    return m;
}
__device__ __forceinline__ unsigned causal_tiles(int qlast) { const int n = (qlast >> 6) + 1; return n >= 32 ? 0xffffffffu : ((1u << n) - 1u); }
}
struct Args { const float* in[25]; float* out; unsigned char* ws; int ph_lo, ph_hi; };
typedef const __attribute__((address_space(4))) Args* KArgs;
struct Frame {
    LAS unsigned char* lds; volatile LAS unsigned* MISC; gu32* ctl;
    int tid, lane, wave, G, bx;
    unsigned char* ws; float* out;
};
#define WSP(T, off) ((T*)(F.ws + (off)))

__device__ __forceinline__ int maprow(int mode, int n, int arg) {
    if (mode == 0) return n + arg;
    if (mode == 1) {
        if (n < 2048) return n;
        if (n < 2056) return -1;
        if (n < 9224) return n - 8;
        return -1;
    }
    return ((n >> 7) << 8) + (n & 127) + arg;
}
__device__ __forceinline__ void tr_item(const float* __restrict__ W, int N, int ldw, bf16* __restrict__ WT, int ldd, int koff, int mode, int arg, int noff, int smap, LAS float* scr, int item, int lane) {
    const int nblk = (N + 31) >> 5, kb = item / nblk, nb = item - kb * nblk, k0 = 64 * kb, n0 = 32 * nb;
    const int nn = n0 + (lane & 31); const bool nok = nn < N;
    const int ns = smap ? (nn < 8 ? 2048 + nn : 9224 + (nn - 8)) : nn;
#pragma unroll
    for (int i = 0; i < 32; ++i) { const int kk = 2 * i + (lane >> 5); scr[kk * 33 + (lane & 31)] = nok ? W[(size_t)(k0 + kk) * ldw + ns] : 0.f; }
    LDS_WAIT(); asm volatile("" ::: "memory");
    const int c = lane & 7;
#pragma unroll
    for (int j = 0; j < 4; ++j) { const int n = (lane >> 3) + 8 * j; const LAS float* s = scr + (8 * c) * 33 + n;
        v4u o; o.x = pk2(s[0 * 33], s[1 * 33]); o.y = pk2(s[2 * 33], s[3 * 33]); o.z = pk2(s[4 * 33], s[5 * 33]); o.w = pk2(s[6 * 33], s[7 * 33]);
        if (n0 + n < N) { const int nn2 = n0 + n + (mode == 3 ? noff : 0), kk2 = k0 + 8 * c;
            const int mr = mode == 3 ? 0 : maprow(mode, n0 + n, arg);
            const size_t off = mode == 3 ? ((size_t)(((kk2 >> 5) * arg + (nn2 >> 4)) * 64 + ((kk2 >> 3) & 3) * 16 + (nn2 & 15)) * 8) : ((size_t)mr * ldd + koff + kk2);
            if (mr >= 0) *(GAS v4u*)(WT + off) = o; } }
    LDS_WAIT(); asm volatile("" ::: "memory");
}
__device__ __forceinline__ void mod_item(const LAS float* sc, const float* __restrict__ aw, const float* __restrict__ ab, const float* __restrict__ gn1, const float* __restrict__ gn2, float* __restrict__ mod, int item, int lane) {
    const int l = item / 384, ch = item - l * 384, n0 = ch * 32, cg = lane & 7, rs = lane >> 3;
    const float* W = aw + (size_t)l * 2048 * 12288 + n0 + 4 * cg;
    f32x4 acc[8];
#pragma unroll
    for (int b = 0; b < 8; ++b) acc[b] = (f32x4){0.f, 0.f, 0.f, 0.f};
#pragma unroll 8
    for (int i = 0; i < 256; ++i) { const int k = rs + 8 * i;
        const f32x4 w = *(const f32x4*)(W + (size_t)k * 12288);
        const f32x4 s0 = *(const LAS f32x4*)(sc + k * 8), s1 = *(const LAS f32x4*)(sc + k * 8 + 4);
        acc[0] += w * s0.x; acc[1] += w * s0.y; acc[2] += w * s0.z; acc[3] += w * s0.w; acc[4] += w * s1.x; acc[5] += w * s1.y; acc[6] += w * s1.z; acc[7] += w * s1.w; }
#pragma unroll
    for (int b = 0; b < 8; ++b)
#pragma unroll
        for (int x = 8; x < 64; x <<= 1) { acc[b].x += __shfl_xor(acc[b].x, x); acc[b].y += __shfl_xor(acc[b].y, x); acc[b].z += __shfl_xor(acc[b].z, x); acc[b].w += __shfl_xor(acc[b].w, x); }
    if (rs == 0) { const f32x4 bv = *(const f32x4*)(ab + (size_t)l * 12288 + n0 + 4 * cg);
        const int slot = n0 >> 11; const bool isg = (slot == 1 || slot == 4);
        f32x4 gm = (f32x4){1.f, 1.f, 1.f, 1.f}; if (isg) gm = *(const f32x4*)((slot == 1 ? gn1 : gn2) + (size_t)l * 2048 + (n0 & 2047) + 4 * cg);
#pragma unroll
        for (int b = 0; b < 8; ++b) { const f32x4 t = acc[b] + bv; *(f32x4*)(mod + ((size_t)l * 8 + b) * 12288 + n0 + 4 * cg) = isg ? gm * (t + 1.0f) : t; } }
}
__device__ __forceinline__ void p0_prologue(Frame& F, KArgs A) {
    LAS float* scr = (LAS float*)(F.lds + RING_OFF + F.wave * 8448);
    const int gw = F.bx * NWAVES + F.wave, NGW = F.G * NWAVES;
    constexpr int J1 = 32 * 289, J2 = 32 * 64, J3 = 0, J4 = 32 * 512, J5 = J4, J6 = 32 * 512, J7 = 2 * 256, J8 = 2 * 8, J9 = 96;
    constexpr int JL = J1 + J2 + J3 + J4 + J5 + J6 + J7 + J8 + J9;
    constexpr int N_MOD = 768, NT = 2 * JL, PRE = 8;
    const int nmodw = (N_MOD < NGW) ? N_MOD : NGW;
    if (F.bx * NWAVES < N_MOD) {
        LAS float* sct = (LAS float*)(F.lds + RING_OFF);
        for (int i = F.tid; i < 2048 * 8; i += NTHR) { const int k = i >> 3, b = i & 7; sct[i] = silu2_f(A->in[1][b * 2048 + k]); }
        __syncthreads();
        if (gw < N_MOD) mod_item(sct, A->in[4], A->in[5], A->in[2], A->in[3], WSP(float, WS_MOD), gw, F.lane);
        __syncthreads();
    }
    const int npre = (NGW - nmodw) * PRE < NT ? (NGW - nmodw) * PRE : NT;
    for (int pass = 0; pass < 2; ++pass) {
      int it0, it1, step;
      if (pass == 0) { if (gw < nmodw) continue; it0 = gw - nmodw; it1 = npre; step = NGW - nmodw; }
      else { it0 = npre + gw; it1 = NT; step = NGW; }
      for (int it = it0; it < it1; it += step) {
        int r = it;
        const int l = r / JL; r -= l * JL;
        if (r < J1) { tr_item(A->in[6] + (size_t)l * 2048 * DIN, DIN, DIN, WSP(bf16, WS_WINT) + (size_t)l * NZP * 2048, 2048, 0, 1, 0, 0, 0, scr, r, F.lane); continue; } r -= J1;
        if (r < J2) { tr_item(A->in[17] + (size_t)l * 2048 * 2048, 2048, 2048, WSP(bf16, WS_WOUTT) + (size_t)l * 2048 * KO, KO, 0, 0, 0, 0, 0, scr, r, F.lane); continue; } r -= J2;
        if (r < J3) { tr_item(A->in[17] + (size_t)l * 2048 * 2048 + (size_t)1536 * 2048, 2048, 2048, WSP(bf16, WS_WOUTT) + (size_t)l * 2048 * KO, KO, 2048, 0, 0, 0, 0, scr, r, F.lane); continue; } r -= J3;
        if (r < J4) { const int e = r >> 9; tr_item(A->in[22] + ((size_t)l * NE + e) * 2048 * DE, DE, DE, WSP(bf16, WS_W13T) + ((size_t)l * NE + e) * 1024 * 2048, 2048, 0, 2, 0, 0, 0, scr, r & 511, F.lane); continue; } r -= J4;
        if (r < J5) { const int e = r >> 9; tr_item(A->in[23] + ((size_t)l * NE + e) * 2048 * DE, DE, DE, WSP(bf16, WS_W13T) + ((size_t)l * NE + e) * 1024 * 2048, 2048, 0, 2, 128, 0, 0, scr, r & 511, F.lane); continue; } r -= J5;
        if (r < J6) { const int e = r >> 9; tr_item(A->in[24] + ((size_t)l * NE + e) * DE * 2048, 2048, 2048, WSP(bf16, WS_W2T) + ((size_t)l * NE + e) * 2048 * DE, DE, 0, 0, 0, 0, 0, scr, r & 511, F.lane); continue; } r -= J6;
        if (r < J7) { const int kv = r >> 8; tr_item(A->in[15] + ((size_t)l * 2 + kv) * 4096 * 128, 128, 128, WSP(bf16, WS_CW1T) + ((size_t)l * 2 + kv) * 128 * 4096, 4096, 0, 3, 8, 0, 0, scr, r & 255, F.lane); continue; } r -= J7;
        if (r < J8) { const int kv = r >> 3; tr_item(A->in[16] + ((size_t)l * 2 + kv) * 128 * 128, 128, 128, WSP(bf16, WS_CW2T) + ((size_t)l * 2 + kv) * 128 * 128, 128, 0, 0, 0, 0, 0, scr, r & 7, F.lane); continue; } r -= J8;
        if (r < 32) { tr_item(A->in[18] + (size_t)l * 2048 * 4, 4, 4, WSP(bf16, WS_RTT) + (size_t)l * 48 * 2048, 2048, 0, 3, 3, 0, 0, scr, r, F.lane); continue; } r -= 32;
        if (r < 32) { tr_item(A->in[20] + (size_t)l * 2048 * 32, 32, 32, WSP(bf16, WS_RTT) + (size_t)l * 48 * 2048, 2048, 0, 3, 3, 4, 0, scr, r, F.lane); continue; } r -= 32;
        tr_item(A->in[6] + (size_t)l * 2048 * DIN, 20, DIN, WSP(bf16, WS_GWF) + (size_t)l * 32 * 2048, 2048, 0, 3, 2, 0, 1, scr, r, F.lane);
      }
    }
}

template <typename XT> struct XRow;
template <> struct XRow<float> { typedef f32x4 raw_t; static __device__ __forceinline__ raw_t ld(const float* row, int lane, int j) { return ((const f32x4*)row)[lane + 64 * j]; }
    static __device__ __forceinline__ f32x4 cv(raw_t r) { return r; } };
template <> struct XRow<bf16> { typedef v2u raw_t; static __device__ __forceinline__ raw_t ld(const bf16* row, int lane, int j) { return ((const v2u*)row)[lane + 64 * j]; }
    static __device__ __forceinline__ f32x4 cv(raw_t r) { return (f32x4){bflo(r.x), bfhi(r.x), bflo(r.y), bfhi(r.y)}; } };
template <bool COMBINE, bool NORM, typename XT>
__device__ __forceinline__ void norm_phase(Frame& F, const XT* xin, float* xout, const float* gain, const float* modsh, const float* modsc, const float* modg2) {
    const int gw = F.bx * NWAVES + F.wave, NGW = F.G * NWAVES, lane = F.lane;
    static_assert(COMBINE && !NORM, "only the final MoE combine uses this phase");
    (void)gain; (void)modsh; (void)modsc;
    for (int m = gw; m < M; m += 2 * NGW) {
        const int m1 = (m + NGW < M) ? m + NGW : m;
        const LAS int* est = (const LAS int*)(F.lds + LDSCTL_OFF);
        const int* te = WSP(int, WS_TOKE); const int* tp = WSP(int, WS_TOKP); const float* tg = WSP(float, WS_TOKG);
        const int ea0 = te[2 * m], eb0 = te[2 * m + 1], pa0 = tp[2 * m], pb0 = tp[2 * m + 1], ea1 = te[2 * m1], eb1 = te[2 * m1 + 1], pa1 = tp[2 * m1], pb1 = tp[2 * m1 + 1];
        const float ga0 = tg[2 * m], gb0 = tg[2 * m + 1], ga1 = tg[2 * m1], gb1 = tg[2 * m1 + 1];
        typename XRow<XT>::raw_t x0[8], x1[8];
#pragma unroll
        for (int j = 0; j < 8; ++j) { x0[j] = XRow<XT>::ld(xin + (size_t)m * D, lane, j); x1[j] = XRow<XT>::ld(xin + (size_t)m1 * D, lane, j); }
        const int sa0 = est[ea0] + pa0, sb0 = est[eb0] + pb0, sa1 = est[ea1] + pa1, sb1 = est[eb1] + pb1;
        const v2u* ya0 = (const v2u*)(WSP(bf16, WS_Y) + (size_t)sa0 * D) + lane; const v2u* yb0 = (const v2u*)(WSP(bf16, WS_Y) + (size_t)sb0 * D) + lane;
        const v2u* ya1 = (const v2u*)(WSP(bf16, WS_Y) + (size_t)sa1 * D) + lane; const v2u* yb1 = (const v2u*)(WSP(bf16, WS_Y) + (size_t)sb1 * D) + lane;
        v2u a0[8], b0[8], a1[8], b1[8];
#pragma unroll
        for (int j = 0; j < 8; ++j) { a0[j] = ya0[64 * j]; b0[j] = yb0[64 * j]; a1[j] = ya1[64 * j]; b1[j] = yb1[64 * j]; }
        const f32x4* g20 = (const f32x4*)(modg2 + (size_t)(m >> 11) * 12288) + lane; const f32x4* g21 = (const f32x4*)(modg2 + (size_t)(m1 >> 11) * 12288) + lane;
        f32x4* xo0 = (f32x4*)(xout + (size_t)m * D) + lane; f32x4* xo1 = (f32x4*)(xout + (size_t)m1 * D) + lane;
        __builtin_amdgcn_sched_barrier(0);
#pragma unroll
        for (int j = 0; j < 8; ++j) { const f32x4 g0 = g20[64 * j], g1 = g21[64 * j];
            f32x4 y; y.x = ga0 * bflo(a0[j].x) + gb0 * bflo(b0[j].x); y.y = ga0 * bfhi(a0[j].x) + gb0 * bfhi(b0[j].x); y.z = ga0 * bflo(a0[j].y) + gb0 * bflo(b0[j].y); y.w = ga0 * bfhi(a0[j].y) + gb0 * bfhi(b0[j].y);
            xo0[64 * j] = XRow<XT>::cv(x0[j]) + g0 * y;
            f32x4 z; z.x = ga1 * bflo(a1[j].x) + gb1 * bflo(b1[j].x); z.y = ga1 * bfhi(a1[j].x) + gb1 * bfhi(b1[j].x); z.z = ga1 * bflo(a1[j].y) + gb1 * bflo(b1[j].y); z.w = ga1 * bfhi(a1[j].y) + gb1 * bfhi(b1[j].y);
            xo1[64 * j] = XRow<XT>::cv(x1[j]) + g1 * z; }
    }
}

#ifdef TPROBE
#define SUBSTAMP(id, var) do { if (TPROBE == (id) && l == 0) var = __builtin_amdgcn_s_memrealtime(); } while (0)
#else
#define SUBSTAMP(id, var) do {} while (0)
#endif
template <bool COMBINE, int MODE, typename XT>
__device__ __forceinline__ void normgemm_phase(Frame& F, KArgs A, int l, const XT* xin, float* xout, const float* gain, const float* modsh, const float* modsc, const float* modg2, unsigned long long& tpa, unsigned long long& tpb) {
#define LBAR() do { asm volatile("s_waitcnt lgkmcnt(0)" ::: "memory"); __builtin_amdgcn_s_barrier(); asm volatile("" ::: "memory"); } while (0)
    constexpr int NT = MODE == 0 ? 2 : 3, TP = 4112;
    const int lane = F.lane, w = F.wave, lr = lane & 15, lq = lane >> 4;
    LAS unsigned char* tile = F.lds;
    LAS float* part = (LAS float*)(F.lds + 66560);
    LAS float* lgt = (LAS float*)(F.lds + 66560 + 24576);
    LAS float* lgt_all = (LAS float*)(F.lds + 100352);
    LAS int* hist = (LAS int*)(F.lds + 66560 + 24576 + 4096);
    LAS int* tke = hist + 64; LAS int* tkp = tke + 256; LAS float* tkg = (LAS float*)(tkp + 256);
    bf16* HB = WSP(bf16, WS_HB);
    const bf16* WF = MODE == 0 ? WSP(bf16, WS_GWF) + (size_t)l * 32 * 2048 : WSP(bf16, WS_RTT) + (size_t)l * 48 * 2048;
    LAS float* rb = (LAS float*)(tkg + 256);
    if (MODE == 1) { if (F.tid < 64) hist[F.tid] = 0; if (F.tid < 4) rb[F.tid] = A->in[19][l * 4 + F.tid]; if (F.tid >= 64 && F.tid < 96) rb[4 + F.tid - 64] = A->in[21][l * 32 + F.tid - 64]; }
    int ntok = 0;
    typename XRow<XT>::raw_t pf0[8], pf1[8];
    if (F.bx < M / 16) {
#pragma unroll
        for (int j = 0; j < 8; ++j) { pf0[j] = XRow<XT>::ld(xin + (size_t)(F.bx * 16 + 2 * w) * D, lane, j); pf1[j] = XRow<XT>::ld(xin + (size_t)(F.bx * 16 + 2 * w + 1) * D, lane, j); } }
    for (int grp = F.bx; grp < M / 16; grp += F.G, ntok += 16) {
        if (MODE == 1 && grp == F.bx) { SUBSTAMP(120, tpa); }

        {
            const int r0 = 2 * w, m0 = grp * 16 + r0, b = m0 >> 11;
            f32x4 v0[8], v1[8];
#pragma unroll
            for (int j = 0; j < 8; ++j) { v0[j] = XRow<XT>::cv(pf0[j]); v1[j] = XRow<XT>::cv(pf1[j]); }
            if (COMBINE) {
                const LAS int* est = (const LAS int*)(F.lds + LDSCTL_OFF);
                const f32x4* g2 = (const f32x4*)(modg2 + (size_t)b * 12288) + lane;
                f32x4 gv[8];
#pragma unroll
                for (int j = 0; j < 8; ++j) gv[j] = g2[64 * j];
                const int* te = WSP(int, WS_TOKE); const int* tp = WSP(int, WS_TOKP); const float* tg = WSP(float, WS_TOKG);
                const v4u tev = *(const v4u*)(te + 2 * m0), tpv = *(const v4u*)(tp + 2 * m0); const f32x4 tgv = *(const f32x4*)(tg + 2 * m0);
                const int sa0 = est[tev.x] + (int)tpv.x, sb0 = est[tev.y] + (int)tpv.y, sa1 = est[tev.z] + (int)tpv.z, sb1 = est[tev.w] + (int)tpv.w;
                const v2u* ya0 = (const v2u*)(WSP(bf16, WS_Y) + (size_t)sa0 * D) + lane; const v2u* yb0 = (const v2u*)(WSP(bf16, WS_Y) + (size_t)sb0 * D) + lane;
                const v2u* ya1 = (const v2u*)(WSP(bf16, WS_Y) + (size_t)sa1 * D) + lane; const v2u* yb1 = (const v2u*)(WSP(bf16, WS_Y) + (size_t)sb1 * D) + lane;
                v2u a0[8], b0[8], a1[8], b1[8];
#pragma unroll
                for (int j = 0; j < 8; ++j) { a0[j] = ya0[64 * j]; b0[j] = yb0[64 * j]; a1[j] = ya1[64 * j]; b1[j] = yb1[64 * j]; }
                __builtin_amdgcn_sched_barrier(0);
                f32x4* xo0 = (f32x4*)(xout + (size_t)m0 * D) + lane; f32x4* xo1 = xo0 + D / 4;
                const float ga0 = tgv[0], gb0 = tgv[1], ga1 = tgv[2], gb1 = tgv[3];
#pragma unroll
                for (int j = 0; j < 8; ++j) {
                    f32x4 y; y.x = ga0 * bflo(a0[j].x) + gb0 * bflo(b0[j].x); y.y = ga0 * bfhi(a0[j].x) + gb0 * bfhi(b0[j].x); y.z = ga0 * bflo(a0[j].y) + gb0 * bflo(b0[j].y); y.w = ga0 * bfhi(a0[j].y) + gb0 * bfhi(b0[j].y);
                    v0[j] = v0[j] + gv[j] * y; xo0[64 * j] = v0[j];
                    f32x4 z; z.x = ga1 * bflo(a1[j].x) + gb1 * bflo(b1[j].x); z.y = ga1 * bfhi(a1[j].x) + gb1 * bfhi(b1[j].x); z.z = ga1 * bflo(a1[j].y) + gb1 * bflo(b1[j].y); z.w = ga1 * bfhi(a1[j].y) + gb1 * bfhi(b1[j].y);
                    v1[j] = v1[j] + gv[j] * z; xo1[64 * j] = v1[j]; }
            }
            float ss0 = 0.f, ss1 = 0.f;
#pragma unroll
            for (int j = 0; j < 8; ++j) { ss0 += (v0[j].x * v0[j].x + v0[j].y * v0[j].y) + (v0[j].z * v0[j].z + v0[j].w * v0[j].w); ss1 += (v1[j].x * v1[j].x + v1[j].y * v1[j].y) + (v1[j].z * v1[j].z + v1[j].w * v1[j].w); }
#pragma unroll
            for (int o = 1; o < 64; o <<= 1) { ss0 += __shfl_xor(ss0, o); ss1 += __shfl_xor(ss1, o); }
            const float rstd0 = __builtin_amdgcn_rsqf(ss0 * (1.0f / D) + EPS), rstd1 = __builtin_amdgcn_rsqf(ss1 * (1.0f / D) + EPS);
            (void)gain;
            const f32x4* sc = (const f32x4*)(modsc + (size_t)b * 12288) + lane; const f32x4* sh = (const f32x4*)(modsh + (size_t)b * 12288) + lane;
            v2u* o8 = (v2u*)(HB + (size_t)m0 * D) + lane; LAS v2u* t8 = (LAS v2u*)(tile + r0 * TP) + lane;
#pragma unroll
            for (int j = 0; j < 8; ++j) { const f32x4 s = sc[64 * j], h = sh[64 * j];
                const f32x4 y0 = v0[j] * rstd0 * s + h, y1 = v1[j] * rstd1 * s + h;
                v2u pw; pw.x = pk2(y0.x, y0.y); pw.y = pk2(y0.z, y0.w); o8[64 * j] = pw; t8[64 * j] = pw;
                v2u qw; qw.x = pk2(y1.x, y1.y); qw.y = pk2(y1.z, y1.w); o8[D / 4 + 64 * j] = qw; *(LAS v2u*)((LAS unsigned char*)(t8 + 64 * j) + TP) = qw; }
        }
        bf16x8 bw[8][NT];
#pragma unroll
        for (int u = 0; u < 8; ++u)
#pragma unroll
            for (int nt = 0; nt < NT; ++nt) bw[u][nt] = *(const bf16x8*)(WF + ((size_t)((8 * w + u) * NT + nt) * 64 + lane) * 8);
        __builtin_amdgcn_sched_barrier(0);
        { const int gn_ = grp + F.G < M / 16 ? grp + F.G : grp;
#pragma unroll
          for (int j = 0; j < 8; ++j) pf0[j] = XRow<XT>::ld(xin + (size_t)(gn_ * 16 + 2 * w) * D, lane, j); }
        __builtin_amdgcn_sched_barrier(0);
        LBAR();
        if (MODE == 1 && grp == F.bx) { SUBSTAMP(120, tpb); SUBSTAMP(121, tpa); }
        {
            f32x4 acc[NT];
#pragma unroll
            for (int nt = 0; nt < NT; ++nt) acc[nt] = (f32x4){0.f, 0.f, 0.f, 0.f};
#pragma unroll
            for (int u = 0; u < 8; ++u) { const bf16x8 a = *(const LAS bf16x8*)(tile + lr * TP + ((8 * w + u) * 32 + 8 * lq) * 2);
#pragma unroll
                for (int nt = 0; nt < NT; ++nt) acc[nt] = __builtin_amdgcn_mfma_f32_16x16x32_bf16(a, bw[u][nt], acc[nt], 0, 0, 0); }
#pragma unroll
            for (int nt = 0; nt < NT; ++nt)
#pragma unroll
                for (int g = 0; g < 4; ++g) part[(w * 16 + 4 * lq + g) * 48 + nt * 16 + lr] = acc[nt][g];
        }
        LBAR();
        if (MODE == 1 && grp == F.bx) { SUBSTAMP(121, tpb); SUBSTAMP(122, tpa); }
        for (int i = F.tid; i < 16 * NT * 16; i += NTHR) { const int row = i / (NT * 16), col = i - row * (NT * 16); float sum = 0.f;
#pragma unroll
            for (int ww = 0; ww < 8; ++ww) sum += part[(ww * 16 + row) * 48 + col];
            (MODE == 1 ? lgt_all + (ntok >> 4) * (16 * 52) : lgt)[row * 52 + col] = sum; }
        if (MODE == 0) LBAR();
        { const int gn_ = grp + F.G < M / 16 ? grp + F.G : grp;
#pragma unroll
          for (int j = 0; j < 8; ++j) pf1[j] = XRow<XT>::ld(xin + (size_t)(gn_ * 16 + 2 * w + 1) * D, lane, j); }
        if (MODE == 0) {
            if (F.tid < 20 * 16) { const int col = F.tid >> 4, row = F.tid & 15; WSP(float, WS_GT)[(size_t)col * M + grp * 16 + row] = lgt[row * 52 + col]; }
        }
        if (MODE == 1 && grp == F.bx) { SUBSTAMP(122, tpb); }
    }
    if (MODE == 1) {
        __syncthreads();
        if (F.tid < ntok) {
            const LAS float* bg = rb; const LAS float* be = rb + 4;
            const LAS float* row = lgt_all + F.tid * 52;
            float g4[4]; int gi = 0; float gm = -3.0e38f;
#pragma unroll
            for (int i = 0; i < 4; ++i) { g4[i] = row[i] + bg[i]; if (g4[i] > gm) { gm = g4[i]; gi = i; } }
            float gs = 0.f;
#pragma unroll
            for (int i = 0; i < 4; ++i) gs += __expf(g4[i] - gm);
            const float pgrp = 1.0f / gs;
            float la = -3.0e38f, lb = -3.0e38f; int ia = 0, ib = 0;
#pragma unroll
            for (int i = 0; i < 8; ++i) { const float v = row[4 + gi * 8 + i] + be[gi * 8 + i];
                if (v > la) { lb = la; ib = ia; la = v; ia = i; } else if (v > lb) { lb = v; ib = i; } }
            float one = 1.0f; asm volatile("" : "+v"(one));
            const float eb = __expf(lb - la), inv = one / (one + eb);
            const int e0 = gi * 8 + ia, e1 = gi * 8 + ib, t = F.tid;
            tke[2 * t] = e0; tke[2 * t + 1] = e1; tkg[2 * t] = pgrp * inv; tkg[2 * t + 1] = pgrp * eb * inv;
            tkp[2 * t] = __hip_atomic_fetch_add(hist + e0, 1, __ATOMIC_RELAXED, __HIP_MEMORY_SCOPE_WORKGROUP);
            tkp[2 * t + 1] = __hip_atomic_fetch_add(hist + e1, 1, __ATOMIC_RELAXED, __HIP_MEMORY_SCOPE_WORKGROUP);
        }
        __syncthreads();
        if (F.tid < 32) { const int c = hist[F.tid]; int base = 0; if (c) base = (int)__hip_atomic_fetch_add((unsigned*)(F.ctl + CW_CNT + l * 32 + F.tid), (unsigned)c, RLX_AGENT); hist[32 + F.tid] = base; }
        __syncthreads();
        for (int i = F.tid; i < 2 * ntok; i += NTHR) { const int t = i >> 1, j = i & 1, step = t >> 4, r = t & 15;
            const int m = (F.bx + step * F.G) * 16 + r; const int e = tke[i];
            const int pos = hist[32 + e] + tkp[i];
            WSP(int, WS_TOKE)[2 * m + j] = e; WSP(int, WS_TOKP)[2 * m + j] = pos; WSP(float, WS_TOKG)[2 * m + j] = tkg[i]; WSP(int, WS_TOKL)[e * 16384 + pos] = m; }
        __syncthreads();
    }
}

__device__ __forceinline__ float gelu_tanh(float x) { const float u = 0.7978845608028654f * (x + 0.044715f * x * x * x); const float e = __expf(2.0f * u); const float t = 1.0f - 2.0f * __builtin_amdgcn_rcpf(e + 1.0f); return 0.5f * x * (1.0f + t); }
__device__ __forceinline__ void compress_item(Frame& F, KArgs A, int l, int item) {
    const int b = item >> 5, h = (item >> 3) & 3, kv = (item >> 2) & 1, qr4 = item & 3, lane = F.lane, w = F.wave;
    const bf16* Z = WSP(bf16, WS_Z) + (size_t)b * T * ZW + (kv ? Z_NVC : Z_NKC) + h * HD;
    const bf16* W1 = WSP(bf16, WS_CW1T) + ((size_t)l * 2 + kv) * 128 * 4096;
    const bf16* W2 = WSP(bf16, WS_CW2T) + ((size_t)l * 2 + kv) * 128 * 128;
    const float* pe = A->in[14] + ((size_t)l * 2 + kv) * 4096;
    const int lr = lane & 15, lq = lane >> 4, kq = w;
    const int n = qr4 * 32 + lr;
    f32x4 acc[8], acd[8];
#pragma unroll
    for (int i = 0; i < 8; ++i) { acc[i] = (f32x4){0.f, 0.f, 0.f, 0.f}; acd[i] = (f32x4){0.f, 0.f, 0.f, 0.f}; }
    v4u ar, as, arn, asn; f32x4 e0, e1, e0n, e1n; bf16x8 bw[8], bwn[8];
#define CMP_LOAD(AR, AS, E0, E1, BW, KS) do { const int ks_ = (KS); const int p_ = ks_ >> 2, d_ = (ks_ & 3) * 32 + 8 * lq; int tok_ = 16 * n + p_, tok2_ = tok_ + 256; tok_ = tok_ > T - 1 ? T - 1 : tok_; tok2_ = tok2_ > T - 1 ? T - 1 : tok2_; \
        AR = *(const v4u*)(Z + (size_t)tok_ * ZW + d_); AS = *(const v4u*)(Z + (size_t)tok2_ * ZW + d_); E0 = *(const f32x4*)(pe + ks_ * 32 + 8 * lq); E1 = *(const f32x4*)(pe + ks_ * 32 + 8 * lq + 4); \
        _Pragma("unroll") for (int nt = 0; nt < 8; ++nt) BW[nt] = *(const bf16x8*)(W1 + ((size_t)(ks_ * 8 + nt) * 64 + lane) * 8); } while (0)
#define CMP_PK(AR, E0, E1) ({ v4u ap; ap.x = pk2(bflo(AR.x) + E0.x, bfhi(AR.x) + E0.y); ap.y = pk2(bflo(AR.y) + E0.z, bfhi(AR.y) + E0.w); \
        ap.z = pk2(bflo(AR.z) + E1.x, bfhi(AR.z) + E1.y); ap.w = pk2(bflo(AR.w) + E1.z, bfhi(AR.w) + E1.w); __builtin_bit_cast(bf16x8, ap); })
#define CMP_MMA(AR, AS, E0, E1, BW) do { const bf16x8 a = CMP_PK(AR, E0, E1), a2 = CMP_PK(AS, E0, E1); \
        _Pragma("unroll") for (int nt = 0; nt < 8; ++nt) { acc[nt] = __builtin_amdgcn_mfma_f32_16x16x32_bf16(a, BW[nt], acc[nt], 0, 0, 0); acd[nt] = __builtin_amdgcn_mfma_f32_16x16x32_bf16(a2, BW[nt], acd[nt], 0, 0, 0); } } while (0)
    CMP_LOAD(ar, as, e0, e1, bw, kq * 16);
#pragma unroll 1
    for (int k2 = 0; k2 < 16; k2 += 2) {
        CMP_LOAD(arn, asn, e0n, e1n, bwn, kq * 16 + k2 + 1);
        __builtin_amdgcn_sched_barrier(0);
        CMP_MMA(ar, as, e0, e1, bw);
        __builtin_amdgcn_sched_barrier(0);
        CMP_LOAD(ar, as, e0, e1, bw, kq * 16 + ((k2 + 2) & 15));
        __builtin_amdgcn_sched_barrier(0);
        CMP_MMA(arn, asn, e0n, e1n, bwn);
        __builtin_amdgcn_sched_barrier(0);
    }
#undef CMP_LOAD
#undef CMP_MMA
#undef CMP_PK
    LAS float* part = (LAS float*)(F.lds + RING_OFF);
    { LAS float* pw = part + (size_t)((w & 3) * 32) * 132;
      if (w >= 4) {
#pragma unroll
        for (int nt = 0; nt < 8; ++nt)
#pragma unroll
            for (int g = 0; g < 4; ++g) { pw[(4 * lq + g) * 132 + nt * 16 + lr] = acc[nt][g]; pw[(16 + 4 * lq + g) * 132 + nt * 16 + lr] = acd[nt][g]; } }
      __syncthreads();
      if (w < 4) {
#pragma unroll
        for (int nt = 0; nt < 8; ++nt)
#pragma unroll
            for (int g = 0; g < 4; ++g) { const int o0 = (4 * lq + g) * 132 + nt * 16 + lr, o1 = (16 + 4 * lq + g) * 132 + nt * 16 + lr; pw[o0] += acc[nt][g]; pw[o1] += acd[nt][g]; } }
      __syncthreads(); }
    if (w < 2) {
        LAS bf16* hid = (LAS bf16*)(F.lds + 73728 + w * 4352);
#pragma unroll
        for (int nt = 0; nt < 8; ++nt)
#pragma unroll
            for (int g = 0; g < 4; ++g) { const int o = (w * 16 + 4 * lq + g) * 132 + nt * 16 + lr;
                const float s = (part[o] + part[32 * 132 + o]) + (part[64 * 132 + o] + part[96 * 132 + o]);
                hid[(4 * lq + g) * 136 + nt * 16 + lr] = (bf16)f2bf(gelu_tanh(s)); }
        LDS_WAIT(); asm volatile("" ::: "memory");
        f32x4 ac2[8];
#pragma unroll
        for (int i = 0; i < 8; ++i) ac2[i] = (f32x4){0.f, 0.f, 0.f, 0.f};
#pragma unroll
        for (int ks = 0; ks < 4; ++ks) { const bf16x8 a = *(const LAS bf16x8*)(hid + lr * 136 + ks * 32 + 8 * lq);
#pragma unroll
            for (int nt = 0; nt < 8; ++nt) { const bf16x8 bw = *(const bf16x8*)(W2 + (size_t)(nt * 16 + lr) * 128 + ks * 32 + 8 * lq);
                ac2[nt] = __builtin_amdgcn_mfma_f32_16x16x32_bf16(a, bw, ac2[nt], 0, 0, 0); } }
        bf16* O = WSP(bf16, kv ? WS_VCMP : WS_KCMP) + (size_t)(b * 4 + h) * 128 * 128;
        float rn[4] = {1.f, 1.f, 1.f, 1.f};
        if (kv == 0) {
#pragma unroll
            for (int g = 0; g < 4; ++g) { float ss = 0.f;
#pragma unroll
                for (int nt = 0; nt < 8; ++nt) ss += ac2[nt][g] * ac2[nt][g];
#pragma unroll
                for (int x = 1; x < 16; x <<= 1) ss += __shfl_xor(ss, x);
                rn[g] = __builtin_amdgcn_rsqf(ss * (1.0f / 128.0f) + EPS); }
        }
        const float* kg = A->in[13] + (size_t)l * 3 * 128;
#pragma unroll
        for (int nt = 0; nt < 8; ++nt) { const float g0 = kv == 0 ? kg[nt * 16 + lr] : 1.0f;
#pragma unroll
            for (int g = 0; g < 4; ++g) O[(size_t)(qr4 * 32 + w * 16 + 4 * lq + g) * 128 + nt * 16 + lr] = (bf16)f2bf(ac2[nt][g] * rn[g] * g0); }
    }
}
__device__ __forceinline__ void cumsum_item(Frame& F, KArgs A, int l, int b) {
    if (F.wave >= 4) return;
    const int h = F.wave, lane = F.lane;
    const float* Gf = WSP(float, WS_GT) + (size_t)(4 + h) * M + (size_t)b * T + lane * 32;
    const float* Gi = WSP(float, WS_GT) + (size_t)h * M + (size_t)b * T + lane * 32;
    const float bi = A->in[7][(l * 2 + 0) * 4 + h], bf_ = A->in[7][(l * 2 + 1) * 4 + h];
    float lf[32]; float run = 0.f;
#pragma unroll
    for (int i4 = 0; i4 < 8; ++i4) { const f32x4 xv = *(const f32x4*)(Gf + 4 * i4);
#pragma unroll
        for (int j = 0; j < 4; ++j) { const float x = xv[j] + bf_; const float ls = fminf(x, 0.f) - __logf(1.0f + __expf(-fabsf(x))); run += ls; lf[4 * i4 + j] = run; } }
    float tot = run, inc = run;
#pragma unroll
    for (int x = 1; x < 64; x <<= 1) { const float t = __shfl_up(inc, x); if (lane >= x) inc += t; }
    const float excl = inc - tot;
    float* Fq = WSP(float, WS_FQ) + (size_t)(b * 4 + h) * T + lane * 32; float* Gk = WSP(float, WS_GK) + (size_t)(b * 4 + h) * T + lane * 32;
#pragma unroll
    for (int i4 = 0; i4 < 8; ++i4) { const f32x4 iv = *(const f32x4*)(Gi + 4 * i4); f32x4 fo, go;
#pragma unroll
        for (int j = 0; j < 4; ++j) { const float f = excl + lf[4 * i4 + j]; fo[j] = f * LOG2E; go[j] = (iv[j] + bi - f) * LOG2E; lf[4 * i4 + j] = go[j]; }
        *(f32x4*)(Fq + 4 * i4) = fo; *(f32x4*)(Gk + 4 * i4) = go; }
    const float oth = __shfl_xor(lf[0], 1); const float ref = (lane & 1) ? oth : lf[0];
    float* Ek = WSP(float, WS_EK) + (size_t)(b * 4 + h) * T + lane * 32;
#pragma unroll
    for (int i4 = 0; i4 < 8; ++i4) { f32x4 eo;
#pragma unroll
        for (int j = 0; j < 4; ++j) eo[j] = __builtin_amdgcn_exp2f(lf[4 * i4 + j] - ref);
        *(f32x4*)(Ek + 4 * i4) = eo; }
}
__device__ __forceinline__ void rms_seg(bf16* p, const v4u w, const float* __restrict__ g, int lane, float (&y)[8], bool wr = true) {
    float x[8] = {bflo(w.x), bfhi(w.x), bflo(w.y), bfhi(w.y), bflo(w.z), bfhi(w.z), bflo(w.w), bfhi(w.w)};
    float ss = 0.f;
#pragma unroll
    for (int i = 0; i < 8; ++i) ss += x[i] * x[i];
#pragma unroll
    for (int s = 1; s < 16; s <<= 1) ss += __shfl_xor(ss, s);
    const float rn = __builtin_amdgcn_rsqf(ss * (1.0f / 128.0f) + EPS);
    const f32x4 g0 = *(const f32x4*)(g + 8 * (lane & 15)), g1 = *(const f32x4*)(g + 8 * (lane & 15) + 4);
    y[0] = x[0] * rn * g0.x; y[1] = x[1] * rn * g0.y; y[2] = x[2] * rn * g0.z; y[3] = x[3] * rn * g0.w;
    y[4] = x[4] * rn * g1.x; y[5] = x[5] * rn * g1.y; y[6] = x[6] * rn * g1.z; y[7] = x[7] * rn * g1.w;
    v4u o; o.x = pk2(y[0], y[1]); o.y = pk2(y[2], y[3]); o.z = pk2(y[4], y[5]); o.w = pk2(y[6], y[7]);
    if (wr) *(v4u*)(p + 8 * lane) = o;
}
__device__ __forceinline__ void token_item(Frame& F, KArgs A, int l, int item, bool wr = true) {
    const int lane = F.lane, w = F.wave;
    const int m0 = item * 64 + w * 8, b = m0 >> 11, t0 = m0 & (T - 1);
    bf16* Z = WSP(bf16, WS_Z); bf16* QKM = WSP(bf16, WS_QKM);
    const float* cw = A->in[8] + (size_t)l * 4 * 1024;
    float wq[4][8], wk[4][8];
#pragma unroll
    for (int j = 0; j < 4; ++j)
#pragma unroll
        for (int i = 0; i < 8; ++i) { wq[j][i] = cw[j * 1024 + 8 * lane + i]; wk[j][i] = cw[j * 1024 + 512 + 8 * lane + i]; }
    float hq[3][8], hk[3][8];
#pragma unroll
    for (int j = 0; j < 3; ++j) { const int tt = t0 - 3 + j;
        if (tt >= 0) { const v4u a = *(const v4u*)(Z + (size_t)(m0 - 3 + j) * ZW + Z_MQ + 8 * lane), c = *(const v4u*)(Z + (size_t)(m0 - 3 + j) * ZW + Z_MK + 8 * lane);
            hq[j][0] = bflo(a.x); hq[j][1] = bfhi(a.x); hq[j][2] = bflo(a.y); hq[j][3] = bfhi(a.y); hq[j][4] = bflo(a.z); hq[j][5] = bfhi(a.z); hq[j][6] = bflo(a.w); hq[j][7] = bfhi(a.w);
            hk[j][0] = bflo(c.x); hk[j][1] = bfhi(c.x); hk[j][2] = bflo(c.y); hk[j][3] = bfhi(c.y); hk[j][4] = bflo(c.z); hk[j][5] = bfhi(c.z); hk[j][6] = bflo(c.w); hk[j][7] = bfhi(c.w); }
        else {
#pragma unroll
            for (int i = 0; i < 8; ++i) { hq[j][i] = 0.f; hk[j][i] = 0.f; } } }
    float ksum[8];
#pragma unroll
    for (int i = 0; i < 8; ++i) ksum[i] = 0.f;
#pragma unroll 8
    for (int tk = 0; tk < 8; ++tk) {
        const int m = m0 + tk; bf16* zr = Z + (size_t)m * ZW;
        const v4u a = *(const v4u*)(zr + Z_MQ + 8 * lane), c = *(const v4u*)(zr + Z_MK + 8 * lane);
        const v4u s_bk = *(const v4u*)(zr + Z_BK + 8 * lane);
        float cq[8] = {bflo(a.x), bfhi(a.x), bflo(a.y), bfhi(a.y), bflo(a.z), bfhi(a.z), bflo(a.w), bfhi(a.w)};
        float ck[8] = {bflo(c.x), bfhi(c.x), bflo(c.y), bfhi(c.y), bflo(c.z), bfhi(c.z), bflo(c.w), bfhi(c.w)};
        float oq[8], ok[8];
#pragma unroll
        for (int i = 0; i < 8; ++i) { oq[i] = silu2_f(wq[0][i] * hq[0][i] + wq[1][i] * hq[1][i] + wq[2][i] * hq[2][i] + wq[3][i] * cq[i]);
            ok[i] = silu2_f(wk[0][i] * hk[0][i] + wk[1][i] * hk[1][i] + wk[2][i] * hk[2][i] + wk[3][i] * ck[i]);
            hq[0][i] = hq[1][i]; hq[1][i] = hq[2][i]; hq[2][i] = cq[i]; hk[0][i] = hk[1][i]; hk[1][i] = hk[2][i]; hk[2][i] = ck[i]; }
        v4u o; o.x = pk2(oq[0], oq[1]); o.y = pk2(oq[2], oq[3]); o.z = pk2(oq[4], oq[5]); o.w = pk2(oq[6], oq[7]);
        if (wr) *(v4u*)(QKM + (size_t)m * 1024 + 8 * lane) = o;
        o.x = pk2(ok[0], ok[1]); o.y = pk2(ok[2], ok[3]); o.z = pk2(ok[4], ok[5]); o.w = pk2(ok[6], ok[7]);
        if (wr) *(v4u*)(QKM + (size_t)m * 1024 + 512 + 8 * lane) = o;
        ksum[0] += bflo(s_bk.x); ksum[1] += bfhi(s_bk.x); ksum[2] += bflo(s_bk.y); ksum[3] += bfhi(s_bk.y); ksum[4] += bflo(s_bk.z); ksum[5] += bfhi(s_bk.z); ksum[6] += bflo(s_bk.w); ksum[7] += bfhi(s_bk.w);
    }
    LAS float* ka = (LAS float*)(F.lds + RING_OFF);
#pragma unroll
    for (int i = 0; i < 8; ++i) ka[w * 512 + 8 * lane + i] = ksum[i];
    __syncthreads();
    { const int col = F.tid; float s = 0.f;
#pragma unroll
      for (int ww = 0; ww < 8; ++ww) s += ka[ww * 512 + col];
      const int t64 = (item * 64) & (T - 1), blk = t64 >> 8, sub = (t64 >> 6) & 3, h = col >> 7, d = col & 127;
      if (wr) WSP(float, WS_KPART)[((((size_t)(item >> 5) * 4 + h) * 8 + blk) * 4 + sub) * 128 + d] = s; }
    __syncthreads();
}
__device__ __forceinline__ void prep_phase(Frame& F, KArgs A, int l, unsigned long long& tpa, unsigned long long& tpb) {
    constexpr int N_CMP = 256, N_CUM = 8, N_TOK = M / 64;
    SUBSTAMP(100, tpa);
    for (int rep = 0; rep < (((DUP_MASK >> 12) & 1u) ? 2 : 1); ++rep)
    if (EN2(0)) for (int it = F.bx; it < N_CMP; it += F.G) { compress_item(F, A, l, it); __syncthreads(); }
    SUBSTAMP(100, tpb); SUBSTAMP(101, tpa);
    if (EN2(1)) for (int it = F.bx; it < N_CUM; it += F.G) cumsum_item(F, A, l, it);
    SUBSTAMP(101, tpb); SUBSTAMP(102, tpa);
    if (EN2(2)) for (int it = F.G - 1 - F.bx; it < N_TOK; it += F.G) token_item(F, A, l, it);
    SUBSTAMP(102, tpb);
    if ((DUP_MASK >> 13) & 1u) { __syncthreads(); for (int it = F.G - 1 - F.bx; it < N_TOK; it += F.G) token_item(F, A, l, it, A->ph_hi == 12345); }
}
__device__ __forceinline__ unsigned range_mask(int lo, int hi) {
    const unsigned a = hi >= 31 ? 0xffffffffu : ((1u << (hi + 1)) - 1u); return a & ~((1u << lo) - 1u);
}
#define ATT_IDS() int tid_ = threadIdx.x; asm volatile("" : "+v"(tid_)); const int tid = tid_, wid = __builtin_amdgcn_readfirstlane(tid >> 6), lane = tid & 63, r32 = lane & 31, hi = lane >> 5; (void)tid; (void)lane
#define ATT_IDS_B() int tidb_ = threadIdx.x; asm volatile("" : "+v"(tidb_)); const int wb = __builtin_amdgcn_readfirstlane(tidb_ >> 6), r32b = tidb_ & 31, hib = (tidb_ >> 5) & 1
template <int TYPE>
__device__ __forceinline__ void unit_state(Frame& F, KArgs A, int l, int b, int h, int blk) {
    using namespace att; ATT_IDS();
    LAS char* lds = (LAS char*)F.lds;
    const bf16* Z = WSP(bf16, WS_Z) + (size_t)b * T * ZW;
    const bf16* QKM = WSP(bf16, WS_QKM) + (size_t)b * T * 1024;
    const bf16 *Kh, *Vh; int ldk; const float* G2 = nullptr; float fend = 0.f, sl2 = 0.f;
    if (TYPE == 0) { Kh = QKM + 512 + h * HD; ldk = 1024; Vh = Z + Z_MV + h * HD; G2 = WSP(float, WS_GK) + (size_t)(b * 4 + h) * T; fend = WSP(float, WS_FQ)[(size_t)(b * 4 + h) * T + blk * 256 + 255]; }
    else { Kh = Z + Z_RK + h * HD; ldk = ZW; Vh = Z + Z_RV + h * HD; sl2 = -log2f(1.0f - exp2f(-5.0f - (float)h)); }
    const int sr = tid >> 4, sc = (tid & 15) * 8;
    const int D0 = wid & 3, D1 = (wid >> 2) * 2;
    const int kbase = (int)(unsigned)(uintptr_t)lds + v_rd_base(lane) + D0 * 512, vbase = (int)(unsigned)(uintptr_t)(lds + SHM_V) + v_rd_base(lane) + D1 * 512;
    f32x16 acc0 = {}, acc1 = {};
    float nacc[8] = {};
#pragma unroll 1
    for (int i = 0; i < 4; ++i) {
        const int k0 = blk * 256 + i * 64;
        const v4u kq0 = *(const v4u*)(Kh + (size_t)(k0 + sr) * ldk + sc), kq1 = *(const v4u*)(Kh + (size_t)(k0 + 32 + sr) * ldk + sc);
        const v4u vq0 = *(const v4u*)(Vh + (size_t)(k0 + sr) * ZW + sc), vq1 = *(const v4u*)(Vh + (size_t)(k0 + 32 + sr) * ZW + sc);
        float w0, w1;
        if (TYPE == 0) { w0 = exp2f(G2[k0 + sr] + fend); w1 = exp2f(G2[k0 + 32 + sr] + fend); }
        else { w0 = exp2f(-sl2 * (float)(255 - (i * 64 + sr))); w1 = exp2f(-sl2 * (float)(255 - (i * 64 + 32 + sr))); }
        v4u ks0, ks1;
#pragma unroll
        for (int j = 0; j < 4; ++j) { const float a0 = bflo(kq0[j]) * w0, a1 = bfhi(kq0[j]) * w0, c0 = bflo(kq1[j]) * w1, c1 = bfhi(kq1[j]) * w1;
            nacc[2 * j] += a0 + c0; nacc[2 * j + 1] += a1 + c1; ks0[j] = pk2(a0, a1); ks1[j] = pk2(c0, c1); }
        __syncthreads();
        *(LAS v4u*)(lds + v_st(sr, sc)) = ks0; *(LAS v4u*)(lds + v_st(32 + sr, sc)) = ks1;
        *(LAS v4u*)(lds + SHM_V + v_st(sr, sc)) = vq0; *(LAS v4u*)(lds + SHM_V + v_st(32 + sr, sc)) = vq1;
        __syncthreads();
#define ST_F(BASE, D, KS) ({ const s16x4 lo_ = tr_read<v_rd_off(D, KS, 0)>(BASE), hi_ = tr_read<v_rd_off(D, KS, 1)>(BASE); asm volatile("s_waitcnt lgkmcnt(0)" ::: "memory"); (bf16x8){lo_[0], lo_[1], lo_[2], lo_[3], hi_[0], hi_[1], hi_[2], hi_[3]}; })
#define ST_KS(KS) do { const bf16x8 fa = ST_F(kbase, 0, KS), fb0 = ST_F(vbase, 0, KS), fb1 = ST_F(vbase, 1, KS); \
        acc0 = __builtin_amdgcn_mfma_f32_32x32x16_bf16(fa, fb0, acc0, 0, 0, 0); acc1 = __builtin_amdgcn_mfma_f32_32x32x16_bf16(fa, fb1, acc1, 0, 0, 0); } while (0)
        ST_KS(0); ST_KS(1); ST_KS(2); ST_KS(3);
#undef ST_KS
#undef ST_F
    }
    float* U = WSP(float, WS_US) + ((size_t)((TYPE == 0 ? 0 : 32) + b * 4 + h) * 7 + blk) * 16384 + (size_t)(D0 * 32) * 128 + D1 * 32 + r32;
#pragma unroll
    for (int r = 0; r < 16; ++r) { U[(size_t)crow(r, hi) * 128] = acc0[r]; U[(size_t)crow(r, hi) * 128 + 32] = acc1[r]; }
    if (TYPE == 0) {
        LAS float* nr = (LAS float*)(lds + OFF_KM);
        __syncthreads();
#pragma unroll
        for (int j = 0; j < 8; ++j) { float v = nacc[j]; v += __shfl_xor(v, 16); v += __shfl_xor(v, 32); if (lane < 16) nr[wid * 128 + sc + j] = v; }
        __syncthreads();
        if (tid < 128) { float v = 0.f;
#pragma unroll
            for (int w = 0; w < 8; ++w) v += nr[w * 128 + tid];
            WSP(float, WS_NS)[((size_t)(b * 4 + h) * 7 + blk) * 128 + tid] = v; }
    }
    __syncthreads();
    if (tid == 0) { __builtin_amdgcn_fence(__ATOMIC_RELEASE, "agent");
        __hip_atomic_fetch_add((unsigned*)(F.ctl + CW_QUEUE + 64 * (l * 8 + 6)), 1u, RLX_AGENT); }
}
template <int TYPE>
__device__ __forceinline__ void unit_linear(Frame& F, KArgs A, int l, int b, int h, int qb, unsigned long long& tpa, unsigned long long& tpb) {
    using namespace att; ATT_IDS();
    unsigned long long t_acc0 = 0ull; (void)t_acc0;
#ifdef TPROBE
#define ACC_BEGIN(id) do { if (TPROBE == (id) && l == 0) t_acc0 = __builtin_amdgcn_s_memrealtime(); } while (0)
#define ACC_END(id) do { if (TPROBE == (id) && l == 0) tpb += __builtin_amdgcn_s_memrealtime() - t_acc0; } while (0)
#else
#define ACC_BEGIN(id) do {} while (0)
#define ACC_END(id) do {} while (0)
#endif
    ACC_BEGIN(130 + 3 * TYPE / 2);
    LAS char* lds = (LAS char*)F.lds;
    const int q0 = qb * 256, q0w = q0 + wid * 32;
    bf16* Z = WSP(bf16, WS_Z) + (size_t)b * T * ZW;
    const bf16* QKM = WSP(bf16, WS_QKM) + (size_t)b * T * 1024;
    bf16x8 qr[8]; LaneCtx lc; lc.tq = q0w + r32; lc.qmask = 0u; lc.a = 0.f; lc.slope2 = 0.f;
    const bf16 *Kh, *Vh; int ldk; const float* Gk = nullptr;
    if (TYPE == 0) { load_q(qr, QKM + (size_t)lc.tq * 1024 + h * HD + hi * 8); Kh = QKM + 512 + h * HD; ldk = 1024; Vh = Z + Z_MV + h * HD;
        Gk = WSP(float, WS_GK) + (size_t)(b * 4 + h) * T; lc.a = WSP(float, WS_FQ)[(size_t)(b * 4 + h) * T + lc.tq]; }
    else { load_q(qr, Z + (size_t)lc.tq * ZW + Z_RQ + h * HD + hi * 8); Kh = Z + Z_RK + h * HD; ldk = ZW; Vh = Z + Z_RV + h * HD;
        lc.slope2 = -log2f(1.0f - exp2f(-5.0f - (float)h)); }
    f32x16 o[4] = {}; float m_reg = -1e29f, l_reg = 0.f;
    if (qb > 0) {
        const float* US = WSP(float, WS_US) + ((size_t)((TYPE == 0 ? 0 : 32) + b * 4 + h) * 7) * 16384;
        const float* F2 = WSP(float, WS_FQ) + (size_t)(b * 4 + h) * T;
        const float fprev = TYPE == 0 ? F2[q0 - 1] : 0.f;
        const int sr = tid >> 4, sc = (tid & 15) * 8;
        f32x4 sa[4][2] = {}; float nt = 0.f;
#pragma unroll 1
        for (int B = 0; B < qb; ++B) {
            const float cf = TYPE == 0 ? exp2f(fprev - F2[B * 256 + 255]) : exp2f(-lc.slope2 * 256.0f * (float)(qb - 1 - B));
            const float* Ub = US + (size_t)B * 16384 + (size_t)sr * 128 + sc;
#pragma unroll
            for (int r4 = 0; r4 < 4; ++r4) { sa[r4][0] += cf * *(const f32x4*)(Ub + r4 * 32 * 128); sa[r4][1] += cf * *(const f32x4*)(Ub + r4 * 32 * 128 + 4); }
            if (TYPE == 0 && tid < 128) nt += cf * WSP(float, WS_NS)[((size_t)(b * 4 + h) * 7 + B) * 128 + tid];
        }
#pragma unroll
        for (int r4 = 0; r4 < 4; ++r4) { v4u w; w.x = pk2(sa[r4][0][0], sa[r4][0][1]); w.y = pk2(sa[r4][0][2], sa[r4][0][3]); w.z = pk2(sa[r4][1][0], sa[r4][1][1]); w.w = pk2(sa[r4][1][2], sa[r4][1][3]);
            *(LAS v4u*)(lds + (r4 >> 1) * SHM_V + v_st((r4 & 1) * 32 + sr, sc)) = w; }
        LAS float* ntab = (LAS float*)(lds + OFF_KM);
        if (TYPE == 0 && tid < 128) ntab[tid] = nt;
        __syncthreads();
        const int vbs = (int)(unsigned)(uintptr_t)lds + v_rd_base(lane);
        pv_d0(o, vbs, qr[0], qr[1], qr[2], qr[3]); pv_d0(o, vbs + SHM_V, qr[4], qr[5], qr[6], qr[7]);
        const float rowfac = SCALE * (TYPE == 0 ? exp2f(lc.a - fprev) : exp2f(-lc.slope2 * (float)(lc.tq - q0 + 1)));
        rescale_o(o, rowfac, (LAS float*)(lds + OFF_WS) + wid * 128, r32, hi);
        if (TYPE == 0) { float dn = 0.f;
#pragma unroll
            for (int d0 = 0; d0 < 8; ++d0) { const f32x4 n0 = *(const LAS f32x4*)(ntab + 16 * d0 + 8 * hi), n1 = *(const LAS f32x4*)(ntab + 16 * d0 + 8 * hi + 4);
                const v4u qw = __builtin_bit_cast(v4u, qr[d0]);
                dn += bflo(qw.x) * n0[0] + bfhi(qw.x) * n0[1] + bflo(qw.y) * n0[2] + bfhi(qw.y) * n0[3] + bflo(qw.z) * n1[0] + bfhi(qw.z) * n1[1] + bflo(qw.w) * n1[2] + bfhi(qw.w) * n1[3]; }
            l_reg = dn * rowfac; }
        __syncthreads();
    }
    const unsigned tmask = 0xFu << (4 * qb), wmask = tmask;
    ACC_END(130 + 3 * TYPE / 2); ACC_BEGIN(131 + 3 * TYPE / 2);
    attn_pass<TYPE == 0 ? MD_MLSTM : MD_RET>(lds, Kh, ldk, Vh, ZW, Gk, Gk ? Gk + (WS_EK - WS_GK) / 4 : nullptr, tmask, wmask, qb, qr, o, m_reg, l_reg, lc);
    ACC_END(131 + 3 * TYPE / 2); ACC_BEGIN(132 + 3 * TYPE / 2);
    ATT_IDS_B(); const int q0wb = q0 + wb * 32;
    LAS float* sl = (LAS float*)(lds + OFF_WS) + wb * 128 + 64;
    float fr[16];
    if (TYPE == 0) { const float den = l_reg + __shfl_xor(l_reg, 32); const float inv = __builtin_amdgcn_rcpf(fmaxf(fabsf(den), 1.0f)); row_bcast(inv, fr, sl, r32b, hib); }
    else { float one = 1.0f; asm volatile("" : "+v"(one)); row_bcast(one, fr, sl, r32b, hib); }
    bf16* Yp = WSP(bf16, WS_YCAT) + ((size_t)b * T + q0wb) * KO + (TYPE == 0 ? 0 : 1024) + h * HD;
    const bf16* gate = Z + (size_t)q0wb * ZW + (TYPE == 0 ? Z_MO : Z_RG) + h * HD;
    const float* gain = (TYPE == 0 ? A->in[9] : A->in[11]) + (size_t)l * HD;
    store_rms_gate<TYPE == 0 ? 0 : 1>(o, fr, gain, gate, ZW, Yp, KO, r32b, hib);
    ACC_END(132 + 3 * TYPE / 2);
#undef ACC_BEGIN
#undef ACC_END
}
__device__ __forceinline__ void unit_moba(Frame& F, KArgs A, int l, int b, int h, int qb) {
    using namespace att; ATT_IDS();
    LAS char* lds = (LAS char*)F.lds;
    const int q0 = qb * 256, q0w = q0 + wid * 32;
    const bf16* Z = WSP(bf16, WS_Z) + (size_t)b * T * ZW;
    bf16x8 qr[8]; LaneCtx lc; lc.tq = q0w + r32; lc.a = 0.f; lc.slope2 = exp2f(-(float)(2 * h + 1)) * LOG2E; lc.qmask = 0u;
    load_q(qr, Z + (size_t)lc.tq * ZW + Z_BQ + h * HD + hi * 8);
    LAS float* km = (LAS float*)(lds + OFF_KM); LAS unsigned* un = (LAS unsigned*)(lds + OFF_UN);
    const float* kp = WSP(float, WS_KPART) + (size_t)(b * 4 + h) * 8 * 4 * 128;
    for (int idx = tid; idx < qb * 128; idx += NTHR) { const int blk = idx >> 7, d = idx & 127; const float* p = kp + (size_t)blk * 512 + d;
        km[idx] = ((p[0] + p[128]) + (p[256] + p[384])) * (1.0f / 256.0f); }
    if (tid == 0) un[0] = 0u;
    __syncthreads();
    float gv[7];
#pragma unroll
    for (int blk = 0; blk < 7; ++blk) { float g = 0.f;
        if (blk < qb) {
#pragma unroll
            for (int d0 = 0; d0 < 8; ++d0) { const f32x4 k0 = *(const LAS f32x4*)(km + blk * 128 + d0 * 16 + hi * 8), k1 = *(const LAS f32x4*)(km + blk * 128 + d0 * 16 + hi * 8 + 4);
                g += bf2f((bf16)qr[d0][0]) * k0.x + bf2f((bf16)qr[d0][1]) * k0.y + bf2f((bf16)qr[d0][2]) * k0.z + bf2f((bf16)qr[d0][3]) * k0.w
                   + bf2f((bf16)qr[d0][4]) * k1.x + bf2f((bf16)qr[d0][5]) * k1.y + bf2f((bf16)qr[d0][6]) * k1.z + bf2f((bf16)qr[d0][7]) * k1.w; }
            g += __shfl_xor(g, 32); }
        gv[blk] = g; }
    unsigned sel = 0u;
#pragma unroll
    for (int pass = 0; pass < 3; ++pass) { float best = -3.0e38f; int bi = -1;
#pragma unroll
        for (int blk = 0; blk < 7; ++blk) if (blk < qb && !((sel >> blk) & 1u) && gv[blk] > best) { best = gv[blk]; bi = blk; }
        if (bi >= 0) sel |= 1u << bi; }
    lc.qmask = sel;
    const unsigned wsel = wave_or(sel);
    if (lane == 0 && wsel) __hip_atomic_fetch_or(un, wsel, __ATOMIC_RELAXED, __HIP_MEMORY_SCOPE_WORKGROUP);
    __syncthreads();
    const unsigned usel = un[0];
    unsigned tmask = 0xFu << (4 * qb), wmask = causal_tiles(q0w + 31) & (0xFu << (4 * qb));
#pragma unroll
    for (int blk = 0; blk < 7; ++blk) { if ((usel >> blk) & 1u) tmask |= 0xFu << (4 * blk); if ((wsel >> blk) & 1u) wmask |= 0xFu << (4 * blk); }
    f32x16 o[4] = {}; float m_reg = -1e29f, l_reg = 0.f;
    attn_pass<MD_MOBA>(lds, Z + Z_BK + h * HD, ZW, Z + Z_BV + h * HD, ZW, nullptr, nullptr, tmask, wmask, qb, qr, o, m_reg, l_reg, lc);
    const float lsum = l_reg + __shfl_xor(l_reg, 32);
    epi_store<0>(o, __builtin_amdgcn_rcpf(lsum), nullptr, nullptr, 0, WSP(bf16, WS_YCAT) + ((size_t)b * T + q0w) * KO + 512 + h * HD, KO, (LAS float*)(lds + wid * 8448), lane);
}
__device__ __forceinline__ void unit_nsa_cs(Frame& F, KArgs A, int l, int b, int h, int qb) {
    using namespace att; ATT_IDS();
    LAS char* lds = (LAS char*)F.lds;
    const int q0 = qb * 256, q0w = q0 + wid * 32;
    const bf16* Z = WSP(bf16, WS_Z) + (size_t)b * T * ZW;
    bf16x8 qr[8]; LaneCtx lc; lc.tq = q0w + r32; lc.a = 0.f; lc.slope2 = exp2f(-(float)(2 * h + 2)) * LOG2E; lc.qmask = 0u;
    load_q(qr, Z + (size_t)lc.tq * ZW + Z_NQ + h * HD + hi * 8);
    LAS char* V_lds = lds; LAS char* K_lds = lds + OFF_K; LAS unsigned* un = (LAS unsigned*)(lds + OFF_UN);
    LAS float* sl = (LAS float*)(lds + OFF_WS) + wid * 128 + 64;
    const float* gt = WSP(float, WS_GT) + (size_t)(8 + h) * M + (size_t)b * T + lc.tq;
    const float g0 = sigmoid_f(gt[0]), g1 = sigmoid_f(gt[(size_t)4 * M]);
    f32x16 o[4] = {};
    bf16* Yn = WSP(bf16, WS_YCAT) + ((size_t)b * T + q0w) * KO + 1536 + h * HD;
    {
        const bf16* Kc = WSP(bf16, WS_KCMP) + (size_t)(b * 4 + h) * 128 * 128; const bf16* Vc = WSP(bf16, WS_VCMP) + (size_t)(b * 4 + h) * 128 * 128;
        const int sr = tid >> 4, sc = (tid & 15) * 8, vst0 = v_st(sr, sc), vst1 = v_st(32 + sr, sc), kc = sc * 2;
        if (tid == 0) un[0] = 0u;
#pragma unroll
        for (int t2 = 0; t2 < 2; ++t2) {
            const bf16x8 ks0 = *(const bf16x8*)(Kc + (size_t)(t2 * 64 + sr) * 128 + sc), ks1 = *(const bf16x8*)(Kc + (size_t)(t2 * 64 + 32 + sr) * 128 + sc);
            const bf16x8 vs0 = *(const bf16x8*)(Vc + (size_t)(t2 * 64 + sr) * 128 + sc), vs1 = *(const bf16x8*)(Vc + (size_t)(t2 * 64 + 32 + sr) * 128 + sc);
            *(LAS bf16x8*)(V_lds + t2 * SHM_V + vst0) = vs0; *(LAS bf16x8*)(V_lds + t2 * SHM_V + vst1) = vs1;
            *(LAS bf16x8*)(K_lds + t2 * SHM_K + KSWZ(sr, kc)) = ks0; *(LAS bf16x8*)(K_lds + t2 * SHM_K + KSWZ(32 + sr, kc)) = ks1; }
        __syncthreads();
        f32x16 sA0, sA1, sB0, sB1;
        { const KAddr ka = k_addr(r32, hi); qkt(sA0, sA1, K_lds, qr, ka); qkt(sB0, sB1, K_lds + SHM_K, qr, ka); }
        constexpr float C1 = SCALE * LOG2E;
        const int basec = lc.tq - 31 - 64 * hi;
        const float biasc = -lc.slope2 * (float)basec;
        float mx = -1e30f;
#pragma unroll
        for (int r = 0; r < 16; ++r) { const int c = crc(r);
            const float s0 = fmaf(sA0[r], C1, fmaf(lc.slope2, 16.0f * (float)c, biasc)), s1 = fmaf(sA1[r], C1, fmaf(lc.slope2, 16.0f * (float)(c + 32), biasc));
            const float s2 = fmaf(sB0[r], C1, fmaf(lc.slope2, 16.0f * (float)(c + 64), biasc)), s3 = fmaf(sB1[r], C1, fmaf(lc.slope2, 16.0f * (float)(c + 96), biasc));
            sA0[r] = (16 * c <= basec) ? s0 : -1e30f; sA1[r] = (16 * (c + 32) <= basec) ? s1 : -1e30f;
            sB0[r] = (16 * (c + 64) <= basec) ? s2 : -1e30f; sB1[r] = (16 * (c + 96) <= basec && (c + 96 + 4 * hi) < 127) ? s3 : -1e30f;
            mx = fmaxf(fmaxf(mx, fmaxf(sA0[r], sA1[r])), fmaxf(sB0[r], sB1[r])); }
        mx = fmaxf(swap_max(mx), -1e29f);
        float ps = 0.f;
#pragma unroll
        for (int r = 0; r < 16; ++r) { sA0[r] = __builtin_amdgcn_exp2f(sA0[r] - mx); sA1[r] = __builtin_amdgcn_exp2f(sA1[r] - mx); sB0[r] = __builtin_amdgcn_exp2f(sB0[r] - mx); sB1[r] = __builtin_amdgcn_exp2f(sB1[r] - mx);
            ps += (sA0[r] + sA1[r]) + (sB0[r] + sB1[r]); }
        const float lc_sum = swap_sum(ps);
        const int vb0 = (int)(unsigned)(uintptr_t)V_lds + v_rd_base(lane);
        float Gs[16], last[16];
#pragma unroll
        for (int a = 0; a < 4; ++a) {
            Gs[a] = (sA0[4 * a] + sA0[4 * a + 1]) + (sA0[4 * a + 2] + sA0[4 * a + 3]); last[a] = sA0[4 * a + 3];
            Gs[4 + a] = (sA1[4 * a] + sA1[4 * a + 1]) + (sA1[4 * a + 2] + sA1[4 * a + 3]); last[4 + a] = sA1[4 * a + 3];
            Gs[8 + a] = (sB0[4 * a] + sB0[4 * a + 1]) + (sB0[4 * a + 2] + sB0[4 * a + 3]); last[8 + a] = sB0[4 * a + 3];
            Gs[12 + a] = (sB1[4 * a] + sB1[4 * a + 1]) + (sB1[4 * a + 2] + sB1[4 * a + 3]); last[12 + a] = sB1[4 * a + 3]; }
        bf16x8 pA0, pA1, pA2, pA3, pB0, pB1, pB2, pB3;
        pack_p(sA0, sA1, pA0, pA1, pA2, pA3); pack_p(sB0, sB1, pB0, pB1, pB2, pB3);
        asm volatile("" : "+v"(pA0), "+v"(pA1), "+v"(pA2), "+v"(pA3), "+v"(pB0), "+v"(pB1), "+v"(pB2), "+v"(pB3));
        const int cur = lc.tq >> 6;
        float val[16]; float prevo = 0.f;
#pragma unroll
        for (int i = 0; i < 16; ++i) { const float ol = __shfl_xor(last[i], 32); const float add = hi ? ol : prevo; prevo = ol;
            val[i] = (2 * i + hi < cur) ? (Gs[i] + add) : -1.0f; }
        float cv[6]; int cj[6];
#pragma unroll
        for (int pass = 0; pass < 3; ++pass) { float best = -0.5f; int bi = 64;
#pragma unroll
            for (int i = 0; i < 16; ++i) if (val[i] > best) { best = val[i]; bi = 2 * i + hi; }
            cv[pass] = bi < 64 ? best : -1.0f; cj[pass] = bi;
#pragma unroll
            for (int i = 0; i < 16; ++i) if (2 * i + hi == bi) val[i] = -2.0f; }
#pragma unroll
        for (int k = 0; k < 3; ++k) { cv[3 + k] = __shfl_xor(cv[k], 32); cj[3 + k] = __shfl_xor(cj[k], 32); }
        unsigned sel = 0u;
#pragma unroll
        for (int pass = 0; pass < 3; ++pass) { float best = -0.5f; int bj = 64;
#pragma unroll
            for (int k = 0; k < 6; ++k) if (cv[k] > best || (cv[k] == best && cv[k] >= 0.f && cj[k] < bj)) { best = cv[k]; bj = cj[k]; }
            if (bj < 64) { sel |= 1u << bj;
#pragma unroll
                for (int k = 0; k < 6; ++k) if (cj[k] == bj) cv[k] = -2.0f; } }
        lc.qmask = sel | (1u << cur);
        pv_d0(o, vb0, pA0, pA1, pA2, pA3); pv_d0(o, vb0 + SHM_V, pB0, pB1, pB2, pB3);
        __syncthreads();
        epi_store<0>(o, lc_sum > 0.f ? g0 * __builtin_amdgcn_rcpf(lc_sum) : 0.f, nullptr, nullptr, 0, Yn, KO, (LAS float*)(lds + wid * 8448), lane);
    }
    const unsigned wsel = wave_or(lc.qmask);
    if (lane == 0) __hip_atomic_fetch_or(un, wsel, __ATOMIC_RELAXED, __HIP_MEMORY_SCOPE_WORKGROUP);
    __syncthreads();
    const unsigned usel = un[0];
#pragma unroll
    for (int d = 0; d < 4; ++d) o[d] = f32x16{};
    float m_reg = -1e29f, l_reg = 0.f;
    attn_pass<MD_SEL>(lds, Z + Z_NKS + h * HD, ZW, Z + Z_NVS + h * HD, ZW, nullptr, nullptr, usel, wsel, qb, qr, o, m_reg, l_reg, lc);
    const float lsum = l_reg + __shfl_xor(l_reg, 32);
    epi_store<1>(o, g1 * __builtin_amdgcn_rcpf(lsum), nullptr, nullptr, 0, Yn, KO, (LAS float*)(lds + wid * 8448), lane);
    {
        const int tlo = q0 >= 511 ? (q0 - 511) >> 6 : 0;
        const unsigned tmw = range_mask(tlo, (q0 + 255) >> 6);
#pragma unroll
        for (int d = 0; d < 4; ++d) o[d] = f32x16{};
        m_reg = -1e29f; l_reg = 0.f; lc.qmask = 0u;
        attn_pass<MD_WIN>(lds, Z + Z_NKW + h * HD, ZW, Z + Z_NVW + h * HD, ZW, nullptr, nullptr, tmw, tmw, qb, qr, o, m_reg, l_reg, lc);
        const float lw = l_reg + __shfl_xor(l_reg, 32);
        const float g2 = sigmoid_f(gt[(size_t)8 * M]);
        epi_store<1>(o, g2 * __builtin_amdgcn_rcpf(lw), nullptr, nullptr, 0, Yn, KO, (LAS float*)(lds + wid * 8448), lane);
    }
}
#define MIXER_QUEUE(kind, CALL) do { for (;;) { __syncthreads(); \
        if (F.tid == 0) uq[0] = (int)__hip_atomic_fetch_add((unsigned*)(F.ctl + CW_QUEUE + 64 * (qset * 16 + l * 8 + (kind))), 1u, RLX_AGENT); \
        __syncthreads(); const int u = __builtin_amdgcn_readfirstlane(uq[0]); if (u >= 256) break; \
        const int qb = 7 - (u >> 5), bh = u & 31, b = bh >> 2, h = bh & 3; CALL; } } while (0)
#define STATE_QUEUE(kind, CALL) do { for (;;) { __syncthreads(); \
        if (F.tid == 0) uq[0] = (int)__hip_atomic_fetch_add((unsigned*)(F.ctl + CW_QUEUE + 64 * (qset * 16 + l * 8 + (kind))), 1u, RLX_AGENT); \
        __syncthreads(); const int u = __builtin_amdgcn_readfirstlane(uq[0]); if (u >= 224) break; \
        const int bh = u / 7, blk = u - bh * 7, b = bh >> 2, h = bh & 3; CALL; } } while (0)
__device__ __forceinline__ void mixer_phase(Frame& F, KArgs A, int l, int qset, unsigned long long& tpa, unsigned long long& tpb) {
    LAS int* uq = (LAS int*)(F.lds + att::OFF_UN + 64);
    SUBSTAMP(110, tpa); SUBSTAMP(111, tpa); SUBSTAMP(112, tpa); SUBSTAMP(113, tpa); SUBSTAMP(114, tpa);
    STATE_QUEUE(4, unit_state<0>(F, A, l, b, h, blk));
    STATE_QUEUE(5, unit_state<2>(F, A, l, b, h, blk));
    if (EN2(6)) MIXER_QUEUE(3, unit_nsa_cs(F, A, l, b, h, qb));
    { if (F.tid == 0) { while (__hip_atomic_load((unsigned*)(F.ctl + CW_QUEUE + 64 * (l * 8 + 6)), RLX_AGENT) < 448u) __builtin_amdgcn_s_sleep(4); }
      __syncthreads(); __builtin_amdgcn_fence(__ATOMIC_ACQUIRE, "agent"); }
    SUBSTAMP(110, tpb);
    if (EN2(3)) MIXER_QUEUE(0, unit_linear<0>(F, A, l, b, h, qb, tpa, tpb));
    SUBSTAMP(111, tpb);
    if (EN2(4)) MIXER_QUEUE(1, unit_moba(F, A, l, b, h, qb));
    SUBSTAMP(112, tpb);
    if (EN2(5)) MIXER_QUEUE(2, unit_linear<2>(F, A, l, b, h, qb, tpa, tpb));
    SUBSTAMP(113, tpb);
    SUBSTAMP(114, tpb);
}
__device__ __forceinline__ void expert_starts(Frame& F, int l, LAS int* st, int shift) {
    if (F.tid == 0) { int run = 0;
        for (int e = 0; e < NE; ++e) { st[e] = run; const int c = (int)__hip_atomic_load(F.ctl + CW_CNT + l * 32 + e, RLX_AGENT); st[33 + e] = c; run += ((c + 255) >> 8) << (8 - shift); }
        st[NE] = run; }
    __syncthreads();
}
constexpr int NPHASE = 22;
#ifndef PH_MASK
#define PH_MASK 0xFFFFu
#endif
#define EN(j) ((PH_MASK >> (j)) & 1u)
#ifndef DUP_MASK
#define DUP_MASK 0u
#endif
#define REPS(j, l) ((((DUP_MASK) >> (j)) & 1u) && ((l) == 0 || !(((DUP_MASK) >> 16) & 1u)) ? 2 : 1)
#define DUPBAR(rep) do { if (rep) { SITE_FRAME(); XcdBarrier bar; bar.bar = (unsigned*)(F.ctl + CW_BAR); bar.x = xb_xcc_id(); bar.st = F.MISC + 8; xcd_barrier(bar); } } while (0)
#define SITE_FRAME() KArgs A = (KArgs)__builtin_amdgcn_kernarg_segment_ptr(); asm volatile("" : "+s"(A)); Frame F; \
    F.lds = (LAS unsigned char*)lds; F.MISC = (volatile LAS unsigned*)(F.lds + MISC_OFF); F.tid = threadIdx.x; asm volatile("" : "+v"(F.tid)); F.lane = F.tid & 63; F.wave = __builtin_amdgcn_readfirstlane(F.tid >> 6); \
    F.G = gridDim.x; F.bx = blockIdx.x; F.ws = A->ws; F.out = A->out; F.ctl = (gu32*)(F.ws + WS_CTL)
__global__ void __launch_bounds__(NTHR, 2) fwd_kernel(Args args) {
    extern __shared__ __attribute__((aligned(16))) unsigned char lds[];
    int lo, hi;
    unsigned long long tp_a = 0ull, tp_b = 0ull;
#ifdef TPROBE
#define TP_STAMP(k) do { if ((k) == TPROBE) tp_a = __builtin_amdgcn_s_memrealtime(); if ((k) == TPROBE + 1) tp_b = __builtin_amdgcn_s_memrealtime(); } while (0)
#else
#define TP_STAMP(k) do {} while (0)
#endif
    {
        SITE_FRAME();
        for (int u = F.tid; u < (LDS_BYTES - LDSCTL_OFF) / 4; u += NTHR) ((LAS unsigned*)(F.lds + LDSCTL_OFF))[u] = 0u;
        __syncthreads();
        lo = A->ph_lo; hi = A->ph_hi;
        if (hi - lo > 1) (void)xcd_barrier_post((unsigned*)(F.ctl + CW_BAR), F.MISC + 8);
    }
#define IN(k) (lo <= (k) && (k) < hi)
#define SEAM(k) do { if (IN(k) && IN((k) + 1)) { { SITE_FRAME(); XcdBarrier bar; bar.bar = (unsigned*)(F.ctl + CW_BAR); bar.x = xb_xcc_id(); bar.st = F.MISC + 8; xcd_barrier(bar); } TP_STAMP((k) + 1); } } while (0)
    TP_STAMP(0);
    for (int rep = 0; rep < REPS(10, 0); ++rep) { DUPBAR(rep); if (EN(10) && IN(0)) { SITE_FRAME(); p0_prologue(F, A); __syncthreads(); } }
    SEAM(0);
    for (int l = 0; l < NL; ++l) {
        const int pb = 1 + 10 * l;
        for (int rep = 0; rep < REPS(0, l); ++rep) { DUPBAR(rep); if (EN(0) && IN(pb + 0)) {
            SITE_FRAME(); const float* modl = WSP(float, WS_MOD) + (size_t)l * 8 * 12288;
            if (l == 0) normgemm_phase<false, 0, float>(F, A, l, A->in[0], nullptr, A->in[2], modl, modl + 2048, nullptr, tp_a, tp_b);
            else { expert_starts(F, l - 1, (LAS int*)(F.lds + LDSCTL_OFF), 0); normgemm_phase<true, 0, bf16>(F, A, l, WSP(bf16, WS_X1), F.out, A->in[2] + (size_t)l * D, modl, modl + 2048, modl - 8 * 12288 + 5 * 2048, tp_a, tp_b); }
        }
        }
        SEAM(pb + 0);
        for (int rep = 0; rep < REPS(1, l); ++rep) { DUPBAR(rep); if (EN(1) && IN(pb + 1)) {
            SITE_FRAME();
            pg8::Gemm g{WSP(bf16, WS_HB), WSP(bf16, WS_WINT) + (size_t)l * NZP * 2048, M, NZP, D}; pg8::StaticOrder S; S.init(M, NZP, F.G, F.bx);
            pg8::EpiZ E{WSP(bf16, WS_Z), WSP(float, WS_GT), A->in[10] + (size_t)l * 256, A->in[12] + (size_t)l * 128, A->in[13] + (size_t)l * 384, (LAS float*)(F.lds + MISC_OFF + 1024)};
            pg8::gemm_phase<pg8::EpiZ, pg8::StaticOrder, true, true>(F.lds + RING_OFF, g, S, E);
        }
        }
        SEAM(pb + 1);
        for (int rep = 0; rep < REPS(2, l); ++rep) { DUPBAR(rep); if (EN(2) && IN(pb + 2)) { SITE_FRAME(); prep_phase(F, A, l, tp_a, tp_b); }
        }
        SEAM(pb + 2);
        for (int rep = 0; rep < REPS(3, l); ++rep) { DUPBAR(rep); if (EN(3) && IN(pb + 3)) { SITE_FRAME(); mixer_phase(F, A, l, rep, tp_a, tp_b); }
        }
        SEAM(pb + 3);
        for (int rep = 0; rep < REPS(4, l); ++rep) { DUPBAR(rep); if (EN(4) && IN(pb + 4)) {
            SITE_FRAME(); const float* modl = WSP(float, WS_MOD) + (size_t)l * 8 * 12288;
            pg8::Gemm g{WSP(bf16, WS_YCAT), WSP(bf16, WS_WOUTT) + (size_t)l * 2048 * KO, M, D, KO}; pg8::StaticOrder S; S.init(M, D, F.G, F.bx);
            pg8::EpiX1 E{l == 0 ? A->in[0] : (const float*)F.out, WSP(bf16, WS_X1), modl + 2 * 2048};
            pg8::gemm_phase<pg8::EpiX1, pg8::StaticOrder, true, true>(F.lds + RING_OFF, g, S, E);
        }
        }
        SEAM(pb + 4);
        for (int rep = 0; rep < REPS(5, l); ++rep) { DUPBAR(rep); if (EN(5) && IN(pb + 5)) { SITE_FRAME(); const float* modl = WSP(float, WS_MOD) + (size_t)l * 8 * 12288;
            normgemm_phase<false, 1, bf16>(F, A, l, WSP(bf16, WS_X1), nullptr, A->in[3] + (size_t)l * D, modl + 3 * 2048, modl + 4 * 2048, nullptr, tp_a, tp_b); }
        }
        SEAM(pb + 5);
        for (int rep = 0; rep < REPS(6, l); ++rep) { DUPBAR(rep); if (EN(6) && IN(pb + 6)) {   }
        }
        for (int rep = 0; rep < REPS(7, l); ++rep) { DUPBAR(rep); if (EN(7) && IN(pb + 7)) {   }
        }
        for (int rep = 0; rep < REPS(8, l); ++rep) { DUPBAR(rep); if (EN(8) && IN(pb + 8)) {
            SITE_FRAME();
            LAS int* st = (LAS int*)(F.lds + LDSCTL_OFF); expert_starts(F, l, st, 8);
            const int nrt = st[NE];
            pg8::Gemm g{WSP(bf16, WS_HB), WSP(bf16, WS_W13T) + (size_t)l * NE * 1024 * 2048, SLOTS, NE * 1024, D};
            pg8::GroupedOrder S{nrt * 4, 4, F.G, F.bx, (const LAS int*)st, WSP(int, WS_TOKL)};
            pg8::EpiH E{WSP(bf16, WS_HBUF)};
            pg8::gemm_phase<pg8::EpiH, pg8::GroupedOrder, true, true, true>(F.lds + RING_OFF, g, S, E);
            __syncthreads();
        }
        }
        SEAM(pb + 8);
        for (int rep = 0; rep < REPS(9, l); ++rep) { DUPBAR(rep); if (EN(9) && IN(pb + 9)) {
            SITE_FRAME();
            LAS int* st = (LAS int*)(F.lds + LDSCTL_OFF); expert_starts(F, l, st, 8);
            const int nrt = st[NE];
            pg8::Gemm g{WSP(bf16, WS_HBUF), WSP(bf16, WS_W2T) + (size_t)l * NE * 2048 * DE, SLOTS, NE * 2048, DE};
            pg8::GroupedOrder S{nrt * 8, 8, F.G, F.bx, (const LAS int*)st, nullptr};
            pg8::EpiY E{WSP(bf16, WS_Y)};
            pg8::gemm_phase<pg8::EpiY, pg8::GroupedOrder, true, true>(F.lds + RING_OFF, g, S, E);
            __syncthreads();
        }
        }
        SEAM(pb + 9);
    }
    if (EN(11) && IN(21)) { SITE_FRAME(); expert_starts(F, NL - 1, (LAS int*)(F.lds + LDSCTL_OFF), 0); norm_phase<true, false, bf16>(F, WSP(bf16, WS_X1), F.out, nullptr, nullptr, nullptr, WSP(float, WS_MOD) + (size_t)1 * 8 * 12288 + 5 * 2048); }
#ifdef TPROBE
    if (TPROBE == 21) tp_b = __builtin_amdgcn_s_memrealtime();
    if (blockIdx.x == 0) { const unsigned long long dt = (tp_b - tp_a) * 20ull, t0 = __builtin_amdgcn_s_memrealtime(); while (__builtin_amdgcn_s_memrealtime() - t0 < dt) __builtin_amdgcn_s_sleep(8); }
#endif
#undef IN
#undef SEAM
}

#ifndef MK_PER_PHASE
#define MK_PER_PHASE 0
#endif
extern "C" void kernel_launch(void* const* d_in, const int* in_sizes, int n_in, void* d_out, int out_size, void* d_ws, size_t ws_size, hipStream_t stream) {
    static int grid = 0;
    if (grid == 0) {
        if (n_in != 25 || in_sizes[0] != M * D || out_size != M * D || ws_size < WS_END) { fprintf(stderr, "kernel_launch: shape/workspace mismatch (n_in %d, ws %zu, need %zu)\n", n_in, ws_size, (size_t)WS_END); grid = -1; return; }
        int dev = 0, cus = 0, per_cu = 0;
        if (hipGetDevice(&dev) != hipSuccess || hipDeviceGetAttribute(&cus, hipDeviceAttributeMultiprocessorCount, dev) != hipSuccess) { grid = -1; return; }
        if (hipFuncSetAttribute((const void*)fwd_kernel, hipFuncAttributeMaxDynamicSharedMemorySize, LDS_BYTES) != hipSuccess) { fprintf(stderr, "kernel_launch: hipFuncSetAttribute failed\n"); grid = -1; return; }
        if (hipOccupancyMaxActiveBlocksPerMultiprocessor(&per_cu, (const void*)fwd_kernel, NTHR, LDS_BYTES) != hipSuccess || per_cu < 1) { fprintf(stderr, "kernel_launch: occupancy query says %d\n", per_cu); }
        (void)hipGetLastError();
        grid = cus;
    }
    if (grid < 0) return;
    if (hipMemsetAsync((char*)d_ws + WS_CTL, 0, CTL_ZERO_BYTES, stream) != hipSuccess) { fprintf(stderr, "kernel_launch: memset failed\n"); return; }
    Args a{};
    for (int i = 0; i < 25; ++i) a.in[i] = (const float*)d_in[i];
    a.out = (float*)d_out; a.ws = (unsigned char*)d_ws;
#if MK_PER_PHASE
    for (int p = 0; p < NPHASE; ++p) { a.ph_lo = p; a.ph_hi = p + 1; hipLaunchKernelGGL(fwd_kernel, dim3(grid), dim3(NTHR), LDS_BYTES, stream, a); }
#else
    a.ph_lo = 0; a.ph_hi = NPHASE;
    hipLaunchKernelGGL(fwd_kernel, dim3(grid), dim3(NTHR), LDS_BYTES, stream, a);
#endif
    const hipError_t le = hipPeekAtLastError();
    if (le != hipSuccess) fprintf(stderr, "kernel_launch: launch failed: %s\n", hipGetErrorName(le));
}
```
